# Optimizing an MI355X kernel written in HIP

```python
import jax, jax.numpy as jnp
from jax import lax
import numpy as np

D_MODEL = 1024
BATCH = 4
SEQ = 4096
DEPTH = 1

GRID_W = 64
CTX_LEN = 256
D_MIX = D_MODEL
GDN_WIDTH = D_MIX // 2
GDN_HEADS = 4
GDN_DK = GDN_WIDTH // GDN_HEADS
GDN_DV = GDN_WIDTH // GDN_HEADS
GDN_CHUNK = 64
CONV_W = 4
CONV_PAD_L = 2
CONV_PAD_R = 1
LRU_WIDTH = D_MIX - GDN_WIDTH
LRU_BLOCKS = 8
LRU_BW = LRU_WIDTH // LRU_BLOCKS
LRU_C = 8.0
D_FF = 2816
N_MOD = 9
FFN_RESIDUAL = 0.5
EPS = 1e-6

OFF_Z = 3 * GDN_WIDTH
OFF_BA = 4 * GDN_WIDTH
OFF_RX = OFF_BA + 4 * GDN_HEADS
OFF_RG = OFF_RX + LRU_WIDTH
IN_COLS = OFF_RG + LRU_WIDTH

kernel_name = "hybrid_gdn_rglru_macaron_dit_layer"


def rms_norm(x, g):
    xf = x.astype(jnp.float32)
    y = xf * lax.rsqrt(jnp.mean(xf * xf, axis=-1, keepdims=True) + EPS)
    return (y * g.astype(jnp.float32)).astype(x.dtype)


def modulate(h, shift, scale):
    return h * (1.0 + scale) + shift


def adaln(cvec, w_ada, b_ada):
    m = jax.nn.silu(cvec) @ w_ada + b_ada
    return jnp.split(m[:, None, :], N_MOD, axis=-1)


def ffn_sublayer(h, mods, g, w1, w3, w2):
    shift, scale, gate = mods
    u = modulate(rms_norm(h, g), shift, scale)
    return h + FFN_RESIDUAL * gate * ((jax.nn.silu(u @ w1) * (u @ w3)) @ w2)


def centred_dwconv(x, w, b=None):
    T = x.shape[1]
    xp = jnp.pad(x, ((0, 0), (CONV_PAD_L, CONV_PAD_R), (0, 0)))
    y = xp[:, 0:T] * w[0]
    for k in range(1, CONV_W):
        y = y + xp[:, k:k + T] * w[k]
    return y if b is None else y + b


def l2norm(t):
    return t * lax.rsqrt(jnp.sum(t * t, axis=-1, keepdims=True) + EPS)


def _ident(t):
    return t


def _flip(t):
    return jnp.flip(t, axis=1)


def to_column_major(t):
    B, T, C = t.shape
    rows = T // GRID_W
    return t.reshape(B, rows, GRID_W, C).transpose(0, 2, 1, 3).reshape(B, T, C)


def from_column_major(t):
    B, T, C = t.shape
    rows = T // GRID_W
    return t.reshape(B, GRID_W, rows, C).transpose(0, 2, 1, 3).reshape(B, T, C)


def gdn_chunk_scan(q, k, v, g, beta, s0, with_output):
    B, T, H, DK = q.shape
    DV = v.shape[-1]
    N = T // GDN_CHUNK

    def chunks(t):
        t = t.reshape((B, N, GDN_CHUNK, H) + t.shape[3:])
        return jnp.moveaxis(t, (1, 3), (0, 2))

    qc, kc, vc, gc, bc = chunks(q), chunks(k), chunks(v), chunks(g), chunks(beta)
    gcum = jnp.cumsum(gc, axis=-1)
    idx = jnp.arange(GDN_CHUNK)
    incl = idx[:, None] >= idx[None, :]
    strict = idx[:, None] > idx[None, :]
    diff = gcum[..., :, None] - gcum[..., None, :]
    decay = jnp.exp(jnp.where(incl, diff, -jnp.inf))
    kb = kc * bc[..., None]
    kk = jnp.einsum('nbhid,nbhjd->nbhij', kb, kc)
    a_mat = jnp.where(strict, kk * decay, 0.0) + jnp.eye(GDN_CHUNK, dtype=jnp.float32)
    rhs = jnp.concatenate([vc * bc[..., None], kb * jnp.exp(gcum)[..., None]], axis=-1)
    sol = lax.linalg.triangular_solve(a_mat, rhs, left_side=True, lower=True, unit_diagonal=True)
    u, w = sol[..., :DV], sol[..., DV:]

    if with_output:
        attn = jnp.where(incl, jnp.einsum('nbhid,nbhjd->nbhij', qc, kc) * decay, 0.0)

        def step_out(s, inp):
            q_n, k_n, u_n, w_n, g_n, attn_n = inp
            v_new = u_n - jnp.einsum('bhcd,bhde->bhce', w_n, s)
            g_last = g_n[..., -1:]
            out = (jnp.einsum('bhcd,bhde->bhce', q_n * jnp.exp(g_n)[..., None], s)
                   + jnp.einsum('bhij,bhje->bhie', attn_n, v_new))
            k_dec = k_n * jnp.exp(g_last - g_n)[..., None]
            s = s * jnp.exp(g_last)[..., None] + jnp.einsum('bhcd,bhce->bhde', k_dec, v_new)
            return s, out

        s_fin, out = lax.scan(step_out, s0, (qc, kc, u, w, gcum, attn))
        out = jnp.moveaxis(out, (0, 2), (1, 3)).reshape(B, T, H, DV)
        return out, s_fin

    def step_state(s, inp):
        k_n, u_n, w_n, g_n = inp
        v_new = u_n - jnp.einsum('bhcd,bhde->bhce', w_n, s)
        g_last = g_n[..., -1:]
        k_dec = k_n * jnp.exp(g_last - g_n)[..., None]
        s = s * jnp.exp(g_last)[..., None] + jnp.einsum('bhcd,bhce->bhde', k_dec, v_new)
        return s, None

    s_fin, _ = lax.scan(step_state, s0, (kc, u, w, gcum))
    return None, s_fin


def gdn_prepare(p, conv_w, a_log, dt_bias):
    B, T, _ = p.shape
    qkv = jax.nn.silu(centred_dwconv(p[..., :OFF_Z], conv_w)).astype(jnp.float32)
    q, k, v = jnp.split(qkv, 3, axis=-1)
    q = l2norm(q.reshape(B, T, GDN_HEADS, GDN_DK)) * (GDN_DK ** -0.5)
    k = l2norm(k.reshape(B, T, GDN_HEADS, GDN_DK))
    v = v.reshape(B, T, GDN_HEADS, GDN_DV)
    z = p[..., OFF_Z:OFF_BA]
    ba = p[..., OFF_BA:OFF_RX].astype(jnp.float32).reshape(B, T, 4, GDN_HEADS)
    beta = jax.nn.sigmoid(ba[:, :, 0:2])
    g = -jnp.exp(a_log.astype(jnp.float32)) * jax.nn.softplus(ba[:, :, 2:4] + dt_bias)
    return q, k, v, z, beta, g


def gdn_gated_norm(o, z, norm_w):
    B, T = o.shape[:2]
    zf = z.astype(jnp.float32).reshape(B, T, GDN_HEADS, GDN_DV)
    y = o * lax.rsqrt(jnp.mean(o * o, axis=-1, keepdims=True) + EPS) * norm_w.astype(jnp.float32) * jax.nn.silu(zf)
    return y.reshape(B, T, GDN_WIDTH)


def gdn_group(p_lat, p_ctx, conv_w, a_log, dt_bias, norm_w, with_ctx_out):
    q_l, k_l, v_l, z_l, beta_l, g_l = gdn_prepare(p_lat, conv_w, a_log, dt_bias)
    q_c, k_c, v_c, z_c, beta_c, g_c = gdn_prepare(p_ctx, conv_w, a_log, dt_bias)
    B = p_lat.shape[0]
    o_l, o_c = None, None
    for d in range(2):
        f = _flip if d else _ident
        s0 = jnp.zeros((B, GDN_HEADS, GDN_DK, GDN_DV), jnp.float32)
        oc, s_ctx = gdn_chunk_scan(f(q_c), f(k_c), f(v_c), f(g_c[:, :, d]), f(beta_c[:, :, d]), s0, with_ctx_out)
        ol, _ = gdn_chunk_scan(f(q_l), f(k_l), f(v_l), f(g_l[:, :, d]), f(beta_l[:, :, d]), s_ctx, True)
        o_l = f(ol) if o_l is None else o_l + f(ol)
        if with_ctx_out:
            o_c = f(oc) if o_c is None else o_c + f(oc)
    y_l = gdn_gated_norm(o_l, z_l, norm_w)
    y_c = gdn_gated_norm(o_c, z_c, norm_w) if with_ctx_out else None
    return y_l, y_c


def _lin_combine(e1, e2):
    a1, b1 = e1
    a2, b2 = e2
    return a1 * a2, a2 * b1 + b2


def rglru_scan(xs, w_gate, b_gate, lam, h0, reset_first):
    B, T, C = xs.shape
    xg = xs.reshape(B, T, LRU_BLOCKS, LRU_BW)
    gates = jax.nn.sigmoid(jnp.einsum('btnc,gncd->gbtnd', xg, w_gate.astype(jnp.float32)).reshape(2, B, T, C)
                           + b_gate.astype(jnp.float32)[:, None, None, :])
    r, i = gates[0], gates[1]
    log_a = -LRU_C * jax.nn.softplus(-lam.astype(jnp.float32)) * r
    a = jnp.exp(log_a)
    mult = jnp.sqrt(-jnp.expm1(2.0 * log_a))
    if reset_first:
        mult = mult.at[:, 0].set(1.0)
    b = mult * (i * xs)
    a_cum, h = lax.associative_scan(_lin_combine, (a, b), axis=1)
    return h + a_cum * h0[:, None, :]


def lru_group(p_lat, p_ctx, conv_w, conv_b, w_gate, b_gate, lam, with_ctx_out):
    x_l = centred_dwconv(to_column_major(p_lat[..., OFF_RX:OFF_RG]), conv_w, conv_b).astype(jnp.float32)
    x_c = centred_dwconv(p_ctx[..., OFF_RX:OFF_RG], conv_w, conv_b).astype(jnp.float32)
    B = p_lat.shape[0]
    h_l, h_c = None, None
    for d in range(2):
        f = _flip if d else _ident
        hc = rglru_scan(f(x_c), w_gate[d], b_gate[d], lam[d], jnp.zeros((B, LRU_WIDTH), jnp.float32), True)
        hl = rglru_scan(f(x_l), w_gate[d], b_gate[d], lam[d], hc[:, -1], False)
        h_l = f(hl) if h_l is None else h_l + f(hl)
        if with_ctx_out:
            h_c = f(hc) if h_c is None else h_c + f(hc)
    y_l = from_column_major(h_l) * jax.nn.gelu(p_lat[..., OFF_RG:].astype(jnp.float32))
    y_c = h_c * jax.nn.gelu(p_ctx[..., OFF_RG:].astype(jnp.float32)) if with_ctx_out else None
    return y_l, y_c


def token_mixing(p_lat, p_ctx, w_out, gdn_conv_w, gdn_a_log, gdn_dt_bias, gdn_norm_w,
                 lru_conv_w, lru_conv_b, lru_w_gate, lru_b_gate, lru_lambda, with_ctx_out):
    dt = p_lat.dtype
    a_l, a_c = gdn_group(p_lat, p_ctx, gdn_conv_w, gdn_a_log, gdn_dt_bias, gdn_norm_w, with_ctx_out)
    b_l, b_c = lru_group(p_lat, p_ctx, lru_conv_w, lru_conv_b, lru_w_gate, lru_b_gate, lru_lambda, with_ctx_out)
    y_l = jnp.concatenate([a_l, b_l], axis=-1).astype(dt) @ w_out
    y_c = jnp.concatenate([a_c, b_c], axis=-1).astype(dt) @ w_out if with_ctx_out else None
    return y_l, y_c


def setup_inputs(seed: int = 0) -> dict:
    key = jax.random.key(seed)
    ks = jax.random.split(key, 24)
    nrm = jax.random.normal
    f32 = jnp.float32
    x = nrm(ks[0], (BATCH, SEQ, D_MODEL), f32)
    c = nrm(ks[1], (BATCH, D_MODEL), f32)
    ctx = nrm(ks[2], (BATCH, CTX_LEN, D_MODEL), f32)
    c_ctx = nrm(ks[3], (D_MODEL,), f32)
    w_ada = nrm(ks[4], (DEPTH, D_MODEL, N_MOD * D_MODEL), f32) * (0.5 * D_MODEL ** -0.5)
    b_ada = nrm(ks[5], (DEPTH, N_MOD * D_MODEL), f32) * 0.01
    norm_g = 1.0 + 0.1 * nrm(ks[6], (DEPTH, 3, D_MODEL), f32)
    ffn_w1 = nrm(ks[7], (DEPTH, 2, D_MODEL, D_FF), f32) * D_MODEL ** -0.5
    ffn_w3 = nrm(ks[8], (DEPTH, 2, D_MODEL, D_FF), f32) * D_MODEL ** -0.5
    ffn_w2 = nrm(ks[9], (DEPTH, 2, D_FF, D_MODEL), f32) * D_FF ** -0.5
    w_in = nrm(ks[10], (DEPTH, D_MODEL, IN_COLS), f32) * D_MODEL ** -0.5
    w_out = nrm(ks[11], (DEPTH, D_MIX, D_MODEL), f32) * D_MIX ** -0.5
    gdn_conv_w = nrm(ks[12], (DEPTH, CONV_W, 3 * GDN_WIDTH), f32) * CONV_W ** -0.5
    gdn_a_log = jnp.log(jax.random.uniform(ks[13], (DEPTH, 2, GDN_HEADS), f32, 1.0, 16.0))
    dt = jnp.exp(jax.random.uniform(ks[14], (DEPTH, 2, GDN_HEADS), f32, np.log(1e-3), np.log(1e-1)))
    gdn_dt_bias = dt + jnp.log(-jnp.expm1(-dt))
    gdn_norm_w = 1.0 + 0.1 * nrm(ks[15], (DEPTH, GDN_DV), f32)
    lru_conv_w = nrm(ks[16], (DEPTH, CONV_W, LRU_WIDTH), f32) * CONV_W ** -0.5
    lru_conv_b = nrm(ks[17], (DEPTH, LRU_WIDTH), f32) * 0.01
    lru_w_gate = nrm(ks[18], (DEPTH, 2, 2, LRU_BLOCKS, LRU_BW, LRU_BW), f32) * LRU_BW ** -0.5
    lru_b_gate = nrm(ks[19], (DEPTH, 2, 2, LRU_WIDTH), f32) * 0.1
    a_pow = jax.random.uniform(ks[20], (DEPTH, 2, LRU_WIDTH), f32, 0.9, 0.999) ** (1.0 / LRU_C)
    lru_lambda = jnp.log(a_pow) - jnp.log1p(-a_pow)
    final_norm_g = 1.0 + 0.1 * nrm(ks[21], (D_MODEL,), f32)
    return {"x": x, "c": c, "ctx": ctx, "c_ctx": c_ctx, "w_ada": w_ada, "b_ada": b_ada,
            "norm_g": norm_g, "ffn_w1": ffn_w1, "ffn_w3": ffn_w3, "ffn_w2": ffn_w2,
            "w_in": w_in, "w_out": w_out, "gdn_conv_w": gdn_conv_w, "gdn_a_log": gdn_a_log,
            "gdn_dt_bias": gdn_dt_bias, "gdn_norm_w": gdn_norm_w, "lru_conv_w": lru_conv_w,
            "lru_conv_b": lru_conv_b, "lru_w_gate": lru_w_gate, "lru_b_gate": lru_b_gate,
            "lru_lambda": lru_lambda, "final_norm_g": final_norm_g}


def reference(x, c, ctx, c_ctx, w_ada, b_ada, norm_g, ffn_w1, ffn_w3, ffn_w2, w_in, w_out,
              gdn_conv_w, gdn_a_log, gdn_dt_bias, gdn_norm_w, lru_conv_w, lru_conv_b,
              lru_w_gate, lru_b_gate, lru_lambda, final_norm_g):
    h_lat, h_ctx = x, ctx
    for l in range(DEPTH):
        last = l == DEPTH - 1
        m_lat = adaln(c, w_ada[l], b_ada[l])
        m_ctx = adaln(c_ctx[None, :], w_ada[l], b_ada[l])
        h_lat = ffn_sublayer(h_lat, m_lat[0:3], norm_g[l, 0], ffn_w1[l, 0], ffn_w3[l, 0], ffn_w2[l, 0])
        h_ctx = ffn_sublayer(h_ctx, m_ctx[0:3], norm_g[l, 0], ffn_w1[l, 0], ffn_w3[l, 0], ffn_w2[l, 0])
        p_lat = modulate(rms_norm(h_lat, norm_g[l, 1]), m_lat[3], m_lat[4]) @ w_in[l]
        p_ctx = modulate(rms_norm(h_ctx, norm_g[l, 1]), m_ctx[3], m_ctx[4]) @ w_in[l]
        y_lat, y_ctx = token_mixing(p_lat, p_ctx, w_out[l], gdn_conv_w[l], gdn_a_log[l], gdn_dt_bias[l],
                                    gdn_norm_w[l], lru_conv_w[l], lru_conv_b[l], lru_w_gate[l],
                                    lru_b_gate[l], lru_lambda[l], not last)
        h_lat = h_lat + m_lat[5] * y_lat
        h_lat = ffn_sublayer(h_lat, m_lat[6:9], norm_g[l, 2], ffn_w1[l, 1], ffn_w3[l, 1], ffn_w2[l, 1])
        if not last:
            h_ctx = h_ctx + m_ctx[5] * y_ctx
            h_ctx = ffn_sublayer(h_ctx, m_ctx[6:9], norm_g[l, 2], ffn_w1[l, 1], ffn_w3[l, 1], ffn_w2[l, 1])
    return rms_norm(h_lat, final_norm_g)
```

```cpp
#include <hip/hip_runtime.h>
#include <hip/hip_cooperative_groups.h>
#include <cstdio>
#include <cstdint>
namespace cg = cooperative_groups;

#ifndef ONE_LAUNCH
#define ONE_LAUNCH 1
#endif

#define LAS __attribute__((address_space(3)))
typedef unsigned short bf16_t;
typedef short bf16x8 __attribute__((ext_vector_type(8)));
typedef float f32x4 __attribute__((ext_vector_type(4)));
typedef float f32x2 __attribute__((ext_vector_type(2)));
typedef unsigned u32x4 __attribute__((ext_vector_type(4)));
typedef unsigned u32x2 __attribute__((ext_vector_type(2)));

constexpr int D = 1024, NB = 4, SEQ = 4096, CTXL = 256, FF = 2816;
constexpr int M_LAT = NB * SEQ, M_CTX = NB * CTXL, M_TOT = M_LAT + M_CTX;
constexpr int NMOD = 9 * D;
constexpr int IN_COLS = 3088, NIN = 3328;
constexpr int NCH = 68;
constexpr float EPS = 1e-6f;

constexpr size_t MiB = 1u << 20;
constexpr size_t WS_MODS = 1 * MiB, WS_BA = 2 * MiB, WS_GC = 4 * MiB, WS_LSUM = 5 * MiB, WS_LCAR = 7 * MiB + MiB / 2;
constexpr size_t WS_WOUT = 10 * MiB, WS_W1B = 12 * MiB, WS_W2B = 23 * MiB;
constexpr size_t WS_PA = 29 * MiB, WS_PB = 80 * MiB, WS_HID = 29 * MiB, WS_OF = 29 * MiB, WS_OB = 45 * MiB;
constexpr size_t WS_U = 131 * MiB, WS_W1A = 165 * MiB, WS_W2A = 176 * MiB, WS_WIN = 182 * MiB, WS_H1CTX = 189 * MiB;
constexpr size_t WS_QG = 131 * MiB, WS_KG = 148 * MiB, WS_WB = 165 * MiB, WS_UB = 199 * MiB, WS_ATT = 233 * MiB, WS_MIX = 131 * MiB;
constexpr size_t WS_END = 256 * MiB;
constexpr int LDS_BYTES = 147456;

__device__ __forceinline__ unsigned f2bf(float f) { unsigned u = __builtin_bit_cast(unsigned, f); return (u + 0x7fffu + ((u >> 16) & 1u)) >> 16; }
__device__ __forceinline__ unsigned pk2(float lo, float hi) { return f2bf(lo) | (f2bf(hi) << 16); }
__device__ __forceinline__ float bf2f(unsigned h) { return __builtin_bit_cast(float, h << 16); }
__device__ __forceinline__ float wave_sum(float v) {
#pragma unroll
    for (int o = 1; o < 64; o <<= 1) v += __shfl_xor(v, o);
    return v;
}
__device__ __forceinline__ float sigmoidf_(float x) { return 1.f / (1.f + __expf(-x)); }
__device__ __forceinline__ float siluf_(float x) { return x / (1.f + __expf(-x)); }
__device__ __forceinline__ float softplusf_(float x) { return x > 20.f ? x : log1pf(__expf(x)); }
__device__ __forceinline__ float geluf_(float x) { const float t = 0.7978845608f * (x + 0.044715f * x * x * x); return 0.5f * x * (1.f + tanhf(t)); }
#define LDS_WAIT() asm volatile("s_waitcnt lgkmcnt(0)" ::: "memory")

namespace pg8 {
constexpr int BM = 256, BK = 64, HALF = 128, HTB = HALF * BK * 2, NXCD = 8, WGM = 8;
__host__ __device__ __forceinline__ int lds_byte(int r, int c) { const int st = (r >> 4) * 2 + (c >> 5), rr = r & 15, cc = c & 31, ob = rr * 64 + cc * 2; return st * 1024 + (ob ^ (((ob >> 9) & 1) << 5)); }
__host__ __device__ __forceinline__ void stage_rc(int b, int& R, int& C) { const int st = b / 1024, sb = b % 1024, swz = sb ^ (((sb >> 9) & 1) << 5); R = (st >> 1) * 16 + swz / 64; C = (st & 1) * 32 + (swz % 64) / 2; }
struct Unit { int pm, pn; };
struct Gemm { const bf16_t* A; const bf16_t* Bt; int M, N, K; };
struct StaticOrder {
    int nM, nN, nwg, G, c;
    __device__ void init(int M, int N, int G_, int c_) { nM = M / BM; nN = N / BM; nwg = nM * nN; G = G_; c = c_; }
    __device__ bool next(int i, Unit& u) const {
        const long L = (long)i * G + c; if (L >= nwg) return false;
        int wgid = (int)L; { const int q = nwg / NXCD, r = nwg % NXCD, xcd = wgid % NXCD, off = wgid / NXCD; wgid = (xcd < r ? xcd * (q + 1) : r * (q + 1) + (xcd - r) * q) + off; }
        const int nig = WGM * nN, gid = wgid / nig, fm = gid * WGM, gsz = (nM - fm) < WGM ? (nM - fm) : WGM;
        u.pm = fm + ((wgid % nig) % gsz); u.pn = (wgid % nig) / gsz; return true;
    }
};
template <class Epi, bool ALIGN_EPI>
__device__ __forceinline__ void gemm_phase(LAS unsigned char* lds, const Gemm g, const StaticOrder& S, const Epi& E) {
    const int tid = threadIdx.x, wid = __builtin_amdgcn_readfirstlane(tid >> 6), lane = tid & 63, wr = wid >> 2, wc = wid & 3, fr = lane & 15, fq = lane >> 4;
    const int K = g.K, nt = K / BK;
    unsigned voffA[2];
#pragma unroll
    for (int i = 0; i < 2; ++i) { int R, C; stage_rc(tid * 16 + i * 8192, R, C); voffA[i] = (unsigned)(R * K + C) * 2u; }
    const size_t kstep = (size_t)(BK * 2);
    const size_t hstep = (size_t)HALF * K * 2;
    const size_t tstep = 2 * hstep;
    const unsigned ldsw = (unsigned)wid * 1024u;
    const int aoff = lds_byte(wr * 64 + fr, fq * 8), boff = lds_byte(wc * 32 + fr, fq * 8);
#define PG8_SA(b, h) (((b) * 2 + (h)) * HTB)
#define PG8_SB(b, h) ((4 + (b) * 2 + (h)) * HTB)
#define PG8_STAGE(bufoff, gbase, voff) do { _Pragma("unroll") for (int _i = 0; _i < 2; ++_i) \
        __builtin_amdgcn_global_load_lds((const unsigned*)((const char*)(gbase) + (voff)[_i]), (LAS unsigned*)(lds + (bufoff) + ldsw + _i * 8192), 16, 0, 0); } while (0)
#define PG8_LDA(dst, b, h) do { _Pragma("unroll") for (int m = 0; m < 4; ++m) _Pragma("unroll") for (int k = 0; k < 2; ++k) dst[m][k] = *(const LAS bf16x8*)(lds + PG8_SA(b, h) + aoff + m * 2048 + k * 1024); } while (0)
#define PG8_LDB(dst, b, h) do { _Pragma("unroll") for (int n = 0; n < 2; ++n) _Pragma("unroll") for (int k = 0; k < 2; ++k) dst[n][k] = *(const LAS bf16x8*)(lds + PG8_SB(b, h) + boff + n * 2048 + k * 1024); } while (0)
#define PG8_MMA(ai, bj, At, Bt) do { __builtin_amdgcn_s_setprio(1); _Pragma("unroll") for (int m = 0; m < 4; ++m) _Pragma("unroll") for (int n = 0; n < 2; ++n) _Pragma("unroll") for (int k = 0; k < 2; ++k) \
        acc[ai][bj][m][n] = __builtin_amdgcn_mfma_f32_16x16x32_bf16(Bt[n][k], At[m][k], acc[ai][bj][m][n], 0, 0, 0); __builtin_amdgcn_s_setprio(0); } while (0)
#define PG8_WAIT_V(n) asm volatile("s_waitcnt vmcnt(" #n ")" ::: "memory")
#define PG8_WAIT_L(n) asm volatile("s_waitcnt lgkmcnt(" #n ")" ::: "memory")
#define PG8_BAR __builtin_amdgcn_s_barrier()
#define PG8_SCHED __builtin_amdgcn_sched_barrier(0)
    Unit cur, nxt; int ui = 0;
    if (!S.next(0, cur)) return;
    f32x4 acc[2][2][4][2];
#pragma unroll
    for (int a = 0; a < 2; ++a)
#pragma unroll
        for (int b = 0; b < 2; ++b)
#pragma unroll
            for (int m = 0; m < 4; ++m)
#pragma unroll
                for (int n = 0; n < 2; ++n) acc[a][b][m][n] = (f32x4){0.f, 0.f, 0.f, 0.f};
    bf16x8 At[4][2], B0[2][2], B1[2][2];
    const char* cA = (const char*)g.A + (size_t)cur.pm * tstep; const char* cB = (const char*)g.Bt + (size_t)cur.pn * tstep;
    PG8_STAGE(PG8_SB(0, 0), cB, voffA); PG8_STAGE(PG8_SB(0, 1), cB + hstep, voffA); PG8_STAGE(PG8_SA(0, 0), cA, voffA); PG8_STAGE(PG8_SA(0, 1), cA + hstep, voffA);
    if (wr == 1) PG8_BAR;
    PG8_WAIT_V(2); PG8_BAR;
    PG8_STAGE(PG8_SB(1, 0), cB + kstep, voffA); PG8_STAGE(PG8_SA(1, 0), cA + kstep, voffA); PG8_STAGE(PG8_SB(1, 1), cB + hstep + kstep, voffA);
    PG8_WAIT_V(6); PG8_BAR;
    for (;;) {
        const bool has_next = S.next(ui + 1, nxt);
        const char* nA = has_next ? (const char*)g.A + (size_t)nxt.pm * tstep : cA; const char* nB = has_next ? (const char*)g.Bt + (size_t)nxt.pn * tstep : cB;
        for (int t = 0; t < nt; t += 2) {
            const bool last = (t == nt - 2);
            const char* a1 = cA + (size_t)(t + 1) * kstep;
            const char* a2 = last ? nA : cA + (size_t)(t + 2) * kstep; const char* b2 = last ? nB : cB + (size_t)(t + 2) * kstep;
            const char* a3 = a2 + kstep; const char* b3 = b2 + kstep;
            PG8_LDB(B0, 0, 0); PG8_LDB(B1, 0, 1); PG8_SCHED; PG8_LDA(At, 0, 0); PG8_STAGE(PG8_SA(1, 1), a1 + hstep, voffA);
            PG8_WAIT_V(8); PG8_WAIT_L(0); PG8_BAR; PG8_MMA(0, 0, At, B0); PG8_MMA(0, 1, At, B1); PG8_BAR; PG8_SCHED;
            PG8_LDA(At, 0, 1); PG8_STAGE(PG8_SB(0, 0), b2, voffA); PG8_STAGE(PG8_SB(0, 1), b2 + hstep, voffA); PG8_STAGE(PG8_SA(0, 0), a2, voffA);
            PG8_WAIT_V(8); PG8_WAIT_L(0); PG8_BAR; PG8_MMA(1, 0, At, B0); PG8_MMA(1, 1, At, B1); PG8_BAR; PG8_SCHED;
            PG8_LDB(B0, 1, 0); PG8_LDB(B1, 1, 1); PG8_SCHED; PG8_LDA(At, 1, 0); PG8_STAGE(PG8_SA(0, 1), a2 + hstep, voffA);
            PG8_WAIT_V(8); PG8_WAIT_L(0); PG8_BAR; PG8_MMA(0, 0, At, B0); PG8_MMA(0, 1, At, B1); PG8_BAR; PG8_SCHED;
            PG8_LDA(At, 1, 1); PG8_STAGE(PG8_SB(1, 0), b3, voffA); PG8_STAGE(PG8_SB(1, 1), b3 + hstep, voffA); PG8_STAGE(PG8_SA(1, 0), a3, voffA);
            PG8_WAIT_V(8); PG8_WAIT_L(0); PG8_BAR; PG8_MMA(1, 0, At, B0); PG8_MMA(1, 1, At, B1); PG8_BAR; PG8_SCHED;
        }
        if constexpr (ALIGN_EPI) { if (wr == 0) PG8_BAR; }
        E(acc, cur, wr, wc, fr, fq);
        if (!has_next) break;
#pragma unroll
        for (int a = 0; a < 2; ++a)
#pragma unroll
            for (int b = 0; b < 2; ++b)
#pragma unroll
                for (int m = 0; m < 4; ++m)
#pragma unroll
                    for (int n = 0; n < 2; ++n) acc[a][b][m][n] = (f32x4){0.f, 0.f, 0.f, 0.f};
        cur = nxt; cA = nA; cB = nB; ++ui;
        if constexpr (ALIGN_EPI) { if (wr == 1) PG8_BAR; }
    }
    PG8_WAIT_V(0);
    if constexpr (!ALIGN_EPI) { if (wr == 0) PG8_BAR; }
    PG8_BAR;
#undef PG8_SA
#undef PG8_SB
#undef PG8_STAGE
#undef PG8_LDA
#undef PG8_LDB
#undef PG8_MMA
#undef PG8_WAIT_V
#undef PG8_WAIT_L
#undef PG8_BAR
#undef PG8_SCHED
}

struct EpiSwiglu {
    bf16_t* H;
    __device__ __forceinline__ void operator()(const f32x4 (&acc)[2][2][4][2], const Unit& u, int wr, int wc, int fr, int fq) const {
        const int row0 = u.pm * BM + wr * 64 + fr, col0 = u.pn * 128 + wc * 32 + 4 * fq;
#pragma unroll
        for (int ai = 0; ai < 2; ++ai)
#pragma unroll
            for (int m = 0; m < 4; ++m) { bf16_t* rowp = H + (size_t)(row0 + ai * HALF + m * 16) * FF + col0;
#pragma unroll
                for (int n = 0; n < 2; ++n) { const f32x4 gt = acc[ai][0][m][n], up = acc[ai][1][m][n];
                    u32x2 w; w.x = pk2(siluf_(gt[0]) * up[0], siluf_(gt[1]) * up[1]); w.y = pk2(siluf_(gt[2]) * up[2], siluf_(gt[3]) * up[3]);
                    *(u32x2*)(rowp + n * 16) = w; } }
    }
};
struct EpiRes {
    const float* res_lat; const float* res_ctx; float* out_lat; float* out_ctx; const float* gate; float coef;
    __device__ __forceinline__ void operator()(const f32x4 (&acc)[2][2][4][2], const Unit& u, int wr, int wc, int fr, int fq) const {
        const bool isctx = u.pm >= 64; const int mr = isctx ? 4 : (u.pm >> 4);
        const int lrow0 = (isctx ? (u.pm - 64) : u.pm) * BM + wr * 64 + fr, col0 = u.pn * BM + wc * 32 + 4 * fq;
        const float* res = isctx ? res_ctx : res_lat; float* out = isctx ? out_ctx : out_lat;
        const float* gp = gate + (size_t)mr * NMOD + col0;
        f32x4 gv[2][2];
#pragma unroll
        for (int bj = 0; bj < 2; ++bj)
#pragma unroll
            for (int n = 0; n < 2; ++n) gv[bj][n] = *(const f32x4*)(gp + bj * HALF + n * 16) * coef;
#pragma unroll
        for (int ai = 0; ai < 2; ++ai)
#pragma unroll
            for (int m = 0; m < 4; ++m) { const size_t ro = (size_t)(lrow0 + ai * HALF + m * 16) * D + col0;
#pragma unroll
                for (int bj = 0; bj < 2; ++bj)
#pragma unroll
                    for (int n = 0; n < 2; ++n) { const f32x4 r = *(const f32x4*)(res + ro + bj * HALF + n * 16);
                        *(f32x4*)(out + ro + bj * HALF + n * 16) = r + gv[bj][n] * acc[ai][bj][m][n]; } }
    }
};
struct EpiIn {
    bf16_t* PA; bf16_t* PB; float* BA;
    __device__ __forceinline__ void operator()(const f32x4 (&acc)[2][2][4][2], const Unit& u, int wr, int wc, int fr, int fq) const {
        const int row0 = u.pm * BM + wr * 64 + fr;
        if (u.pn == 12) {
            if (wc == 0) {
#pragma unroll
                for (int ai = 0; ai < 2; ++ai)
#pragma unroll
                    for (int m = 0; m < 4; ++m) *(f32x4*)(BA + (size_t)(row0 + ai * HALF + m * 16) * 16 + 4 * fq) = acc[ai][0][m][0];
            }
            return;
        }
        bf16_t* base = (u.pn < 6) ? PA : PB; const int col0 = (u.pn % 6) * BM + wc * 32 + 4 * fq;
#pragma unroll
        for (int ai = 0; ai < 2; ++ai)
#pragma unroll
            for (int m = 0; m < 4; ++m) { bf16_t* rowp = base + (size_t)(row0 + ai * HALF + m * 16) * 1536 + col0;
#pragma unroll
                for (int bj = 0; bj < 2; ++bj)
#pragma unroll
                    for (int n = 0; n < 2; ++n) { const f32x4 v = acc[ai][bj][m][n]; u32x2 w; w.x = pk2(v[0], v[1]); w.y = pk2(v[2], v[3]); *(u32x2*)(rowp + bj * HALF + n * 16) = w; } }
    }
};
}

__device__ __forceinline__ void transpose_item(const float* W, int N, int k0, int src_col0, int nvalid, bf16_t* WT, int Kp, int dst_row0, float* scr, int lane) {
#pragma unroll 8
    for (int i = 0; i < 32; ++i) { const int kk = 2 * i + (lane >> 5), n = lane & 31; scr[kk * 33 + n] = (n < nvalid) ? W[(size_t)(k0 + kk) * N + src_col0 + n] : 0.f; }
    LDS_WAIT();
    const int c = lane & 7;
#pragma unroll
    for (int j = 0; j < 4; ++j) { const int n = (lane >> 3) + 8 * j; const float* s = scr + (8 * c) * 33 + n;
        u32x4 o; o.x = pk2(s[0 * 33], s[1 * 33]); o.y = pk2(s[2 * 33], s[3 * 33]); o.z = pk2(s[4 * 33], s[5 * 33]); o.w = pk2(s[6 * 33], s[7 * 33]);
        *(u32x4*)(WT + (size_t)(dst_row0 + n) * Kp + k0 + 8 * c) = o; }
    LDS_WAIT();
}

struct Ptrs {
    const float *x, *c, *ctx, *cctx, *w_ada, *b_ada, *norm_g, *w1, *w3, *w2, *w_in, *w_out, *gconv, *galog, *gdtb, *gnormw, *lconv, *lconvb, *lwg, *lbg, *llam, *fng;
    float* out; unsigned char* ws;
};

__device__ __forceinline__ void phase_prologue(const Ptrs& P, unsigned char* lds, int tid, int lane, int wave, int bid, int G) {
    float* mods = (float*)(P.ws + WS_MODS);
    {
        float* sc = (float*)lds;
        for (int i = tid; i < 5 * D; i += 512) { const int r = i >> 10, k = i & 1023; const float v = (r < 4) ? P.c[r * D + k] : P.cctx[k]; sc[i] = siluf_(v); }
        __syncthreads();
        float* red = (float*)(lds + 20480);
        for (int it = bid; it < NMOD / 64; it += G) {
            const int n0 = it * 64, cq = tid & 15, kl = tid >> 4;
            float acc[5][4];
#pragma unroll
            for (int r = 0; r < 5; ++r)
#pragma unroll
                for (int j = 0; j < 4; ++j) acc[r][j] = 0.f;
#pragma unroll 4
            for (int i = 0; i < 32; ++i) { const int k = kl + 32 * i; const f32x4 w = *(const f32x4*)(P.w_ada + (size_t)k * NMOD + n0 + 4 * cq);
#pragma unroll
                for (int r = 0; r < 5; ++r) { const float s = sc[r * D + k];
#pragma unroll
                    for (int j = 0; j < 4; ++j) acc[r][j] += s * w[j]; } }
#pragma unroll
            for (int r = 0; r < 5; ++r)
#pragma unroll
                for (int j = 0; j < 4; ++j) red[(kl * 16 + cq) * 20 + r * 4 + j] = acc[r][j];
            __syncthreads();
            if (tid < 320) { const int cq2 = tid / 20, rj = tid % 20; float s = 0.f;
                for (int k2 = 0; k2 < 32; ++k2) s += red[(k2 * 16 + cq2) * 20 + rj];
                const int r = rj >> 2, n = n0 + 4 * cq2 + (rj & 3); mods[r * NMOD + n] = s + P.b_ada[n]; }
            __syncthreads();
        }
        __syncthreads();
    }
    {
        float* scr = (float*)(lds + wave * 16384);
        const int gw = bid * 8 + wave, NGW = G * 8;
        bf16_t* W1A = (bf16_t*)(P.ws + WS_W1A); bf16_t* W2A = (bf16_t*)(P.ws + WS_W2A); bf16_t* W1B = (bf16_t*)(P.ws + WS_W1B); bf16_t* W2B = (bf16_t*)(P.ws + WS_W2B);
        bf16_t* WIN = (bf16_t*)(P.ws + WS_WIN); bf16_t* WOUT = (bf16_t*)(P.ws + WS_WOUT);
        constexpr int I_UP = 16 * 88, I_DN = 44 * 32, I_IN = 16 * 97, I_OUT = 16 * 32;
        constexpr int NITEMS = 6 * I_UP + I_IN + I_OUT;
        static_assert(I_UP == I_DN, "item counts");
        for (int it = gw; it < NITEMS; it += NGW) {
            int r = it;
            if (r < 6 * I_UP) {
                const int seg = r / I_UP; r -= seg * I_UP; const int layer = seg / 3, kind = seg % 3;
                if (kind < 2) { const int kb = r / 88, nbk = r % 88, sc0 = 32 * nbk; const float* W = (kind == 0 ? P.w1 : P.w3) + (size_t)layer * D * FF;
                    transpose_item(W, FF, 64 * kb, sc0, 32, layer ? W1B : W1A, D, 256 * (sc0 / 128) + (sc0 % 128) + (kind ? 128 : 0), scr, lane); }
                else { const int kb = r / 32, nbk = r % 32; transpose_item(P.w2 + (size_t)layer * FF * D, D, 64 * kb, 32 * nbk, 32, layer ? W2B : W2A, FF, 32 * nbk, scr, lane); }
                continue;
            }
            r -= 6 * I_UP;
            if (r < I_IN) { const int kb = r / 97, g = r % 97;
                if (g < 64) transpose_item(P.w_in, IN_COLS, 64 * kb, 32 * g, 32, WIN, D, 32 * g, scr, lane);
                else if (g < 96) transpose_item(P.w_in, IN_COLS, 64 * kb, 2064 + 32 * (g - 64), 32, WIN, D, 2048 + 32 * (g - 64), scr, lane);
                else transpose_item(P.w_in, IN_COLS, 64 * kb, 2048, 16, WIN, D, 3072, scr, lane);
                continue; }
            r -= I_IN;
            { const int kb = r / 32, nbk = r % 32; transpose_item(P.w_out, D, 64 * kb, 32 * nbk, 32, WOUT, D, 32 * nbk, scr, lane); }
        }
        u32x4* z = (u32x4*)(WIN + (size_t)3104 * D);
        for (int i = bid * 512 + tid; i < 224 * D * 2 / 16; i += G * 512) z[i] = (u32x4){0u, 0u, 0u, 0u};
    }
}

__device__ __forceinline__ void phase_norm_mod(const float* src_lat, const float* src_ctx, int nrows, const float* g, const float* mods, int shift_idx, int scale_idx, bf16_t* U, int gw, int NGW, int lane) {
    for (int m = gw; m < nrows; m += NGW) {
        const float* xrow = (m < M_LAT) ? src_lat + (size_t)m * D : src_ctx + (size_t)(m - M_LAT) * D;
        const int mr = (m < M_LAT) ? (m >> 12) : 4;
        const float* sh = mods + (size_t)mr * NMOD + shift_idx * D; const float* sc = mods + (size_t)mr * NMOD + scale_idx * D;
        f32x4 v[4]; float ss = 0.f;
#pragma unroll
        for (int j = 0; j < 4; ++j) { v[j] = *(const f32x4*)(xrow + 4 * lane + 256 * j); ss += (v[j][0] * v[j][0] + v[j][1] * v[j][1]) + (v[j][2] * v[j][2] + v[j][3] * v[j][3]); }
        const float rstd = rsqrtf(wave_sum(ss) * (1.f / D) + EPS);
#pragma unroll
        for (int j = 0; j < 4; ++j) { const int col = 4 * lane + 256 * j;
            const f32x4 gv = *(const f32x4*)(g + col), sv = *(const f32x4*)(sc + col), hv = *(const f32x4*)(sh + col);
            const f32x4 y = v[j] * rstd * gv * (sv + 1.f) + hv;
            u32x2 w; w.x = pk2(y[0], y[1]); w.y = pk2(y[2], y[3]); *(u32x2*)(U + (size_t)m * D + col) = w; }
    }
}

constexpr int KP = 132;
__device__ __forceinline__ void gdn_solve(const float* src, const float* scl, const float* A, bf16_t* dst, int base, int stride) {
    float x[64];
#pragma unroll
    for (int i = 0; i < 64; ++i) x[i] = 0.f;
#pragma unroll
    for (int i = 0; i < 64; ++i) {
        float s0 = src[base + i * stride] * scl[i], s1 = 0.f, s2 = 0.f, s3 = 0.f;
#pragma unroll
        for (int j4 = 0; j4 < (i + 3) / 4; ++j4) { const f32x4 av = *(const f32x4*)(A + i * 64 + 4 * j4);
            s0 -= av[0] * x[4 * j4]; s1 -= av[1] * x[4 * j4 + 1]; s2 -= av[2] * x[4 * j4 + 2]; s3 -= av[3] * x[4 * j4 + 3]; }
        x[i] = (s0 + s1) + (s2 + s3);
        dst[i * 128] = (bf16_t)f2bf(x[i]);
    }
}
__device__ __forceinline__ void gdn_prep_item(const Ptrs& P, unsigned char* lds, int item, int tid, int lane, int wave) {
    const int b = item / (4 * NCH), h = (item / NCH) & 3, cn = item % NCH;
    const bool isctx = cn < 4; const int cl = isctx ? cn : cn - 4, L = isctx ? CTXL : SEQ;
    const int rowbase = isctx ? M_LAT + b * CTXL : b * SEQ;
    const bf16_t* PA = (const bf16_t*)(P.ws + WS_PA); const float* BA = (const float*)(P.ws + WS_BA);
    int lo_ = 0; asm volatile("" : "+v"(lo_));
    float* KF = (float*)(lds + lo_); float* QF = (float*)(lds + lo_ + 33792); float* VF = (float*)(lds + lo_ + 67584);
    float* KKN = (float*)(lds + lo_ + 101376); float* QKN = (float*)(lds + lo_ + 118016);
    float* GS = (float*)(lds + lo_ + 134656);
    float* RB = GS + 128;
    float* RBE = GS + 256;
    float* AD = QF;
    {
        const int c = tid & 127, tg = tid >> 7;
#pragma unroll
        for (int mat = 0; mat < 3; ++mat) {
            const int ch = mat * 512 + h * 128 + c;
            const float w0 = P.gconv[ch], w1 = P.gconv[1536 + ch], w2 = P.gconv[2 * 1536 + ch], w3 = P.gconv[3 * 1536 + ch];
            const int t0 = cl * 64 + tg * 16;
            const bf16_t* src = PA + (size_t)rowbase * 1536 + ch;
            float xm2 = (t0 - 2 >= 0) ? bf2f(src[(size_t)(t0 - 2) * 1536]) : 0.f;
            float xm1 = (t0 - 1 >= 0) ? bf2f(src[(size_t)(t0 - 1) * 1536]) : 0.f;
            float x0 = bf2f(src[(size_t)t0 * 1536]);
            float* dst = (mat == 0 ? QF : (mat == 1 ? KF : VF)) + (tg * 16) * KP + c;
#pragma unroll 4
            for (int i = 0; i < 16; ++i) { const int t = t0 + i; const float xp1 = (t + 1 < L) ? bf2f(src[(size_t)(t + 1) * 1536]) : 0.f;
                const float y = w0 * xm2 + w1 * xm1 + w2 * x0 + w3 * xp1; dst[i * KP] = siluf_(y); xm2 = xm1; xm1 = x0; x0 = xp1; }
        }
    }
    if (tid < 128) {
        const int d = tid >> 6, i = lane, r = d ? 63 - i : i;
        const float* ba = BA + (size_t)(rowbase + cl * 64 + r) * 16;
        const float beta = sigmoidf_(ba[d * 4 + h]);
        float gg = -__expf(P.galog[d * 4 + h]) * softplusf_(ba[(2 + d) * 4 + h] + P.gdtb[d * 4 + h]);
#pragma unroll
        for (int o = 1; o < 64; o <<= 1) { const float t = __shfl_up(gg, o); if (lane >= o) gg += t; }
        GS[d * 64 + i] = gg; RB[d * 64 + i] = beta; RBE[d * 64 + i] = beta * __expf(gg);
        ((float*)(P.ws + WS_GC))[((size_t)((d * 4 + b) * 4 + h) * NCH + cn) * 64 + i] = gg;
    }
    __syncthreads();
    {
        bf16_t* QG = (bf16_t*)(P.ws + WS_QG) + ((size_t)((b * 4 + h) * NCH + cn) * 64) * 128;
        bf16_t* KG = (bf16_t*)(P.ws + WS_KG) + ((size_t)((b * 4 + h) * NCH + cn) * 64) * 128;
#pragma unroll
        for (int tt = 0; tt < 8; ++tt) { const int tok = wave * 8 + tt;
            f32x2 q = *(f32x2*)(QF + tok * KP + 2 * lane), k = *(f32x2*)(KF + tok * KP + 2 * lane);
            const float sq = wave_sum(q[0] * q[0] + q[1] * q[1]), sk = wave_sum(k[0] * k[0] + k[1] * k[1]);
            q = q * (rsqrtf(sq + EPS) * 0.08838834764831845f); k = k * rsqrtf(sk + EPS);
            *(f32x2*)(QF + tok * KP + 2 * lane) = q; *(f32x2*)(KF + tok * KP + 2 * lane) = k;
            *(unsigned*)(QG + tok * 128 + 2 * lane) = pk2(q[0], q[1]); *(unsigned*)(KG + tok * 128 + 2 * lane) = pk2(k[0], k[1]); }
    }
    __syncthreads();
    {
        const int tp = tid & 255, ti = tp >> 4, tj = tp & 15; const float* X = (tid < 256) ? KF : QF; float* OUT = (tid < 256) ? KKN : QKN;
        float acc[4][4];
#pragma unroll
        for (int a = 0; a < 4; ++a)
#pragma unroll
            for (int c = 0; c < 4; ++c) acc[a][c] = 0.f;
#pragma unroll 2
        for (int kq = 0; kq < 32; ++kq) {
            f32x4 av[4], bv[4];
#pragma unroll
            for (int a = 0; a < 4; ++a) { av[a] = *(const f32x4*)(X + (ti + 16 * a) * KP + 4 * kq); bv[a] = *(const f32x4*)(KF + (tj + 16 * a) * KP + 4 * kq); }
#pragma unroll
            for (int a = 0; a < 4; ++a)
#pragma unroll
                for (int c = 0; c < 4; ++c) acc[a][c] += (av[a][0] * bv[c][0] + av[a][1] * bv[c][1]) + (av[a][2] * bv[c][2] + av[a][3] * bv[c][3]);
        }
#pragma unroll
        for (int a = 0; a < 4; ++a)
#pragma unroll
            for (int c = 0; c < 4; ++c) OUT[(ti + 16 * a) * 65 + tj + 16 * c] = acc[a][c];
    }
    __syncthreads();
    {
        const int d = tid >> 8, tp = tid & 255;
        bf16_t* ATT = (bf16_t*)(P.ws + WS_ATT) + ((size_t)((d * 4 + b) * 4 + h) * NCH + cn) * 4096;
#pragma unroll 4
        for (int e = 0; e < 16; ++e) { const int idx = tp + 256 * e, i = idx >> 6, j = idx & 63, ri = d ? 63 - i : i, rj = d ? 63 - j : j;
            const float dec = (i >= j) ? __expf(GS[d * 64 + i] - GS[d * 64 + j]) : 0.f;
            AD[d * 4096 + idx] = (i > j) ? RB[d * 64 + i] * KKN[ri * 65 + rj] * dec : 0.f;
            ATT[idx] = (bf16_t)f2bf(QKN[ri * 65 + rj] * dec); }
    }
    __syncthreads();
    {
        const int d = tid >> 8, c = tid & 255;
        const float* src = (c < 128) ? VF + c : KF + (c - 128); const float* scl = ((c < 128) ? RB : RBE) + d * 64;
        bf16_t* dst = (bf16_t*)(P.ws + (c < 128 ? WS_UB : WS_WB)) + ((size_t)((d * 4 + b) * 4 + h) * NCH + cn) * 64 * 128 + (c & 127);
        int sb_ = d ? 63 * KP : 0, ss_ = d ? -KP : KP; asm volatile("" : "+v"(sb_), "+v"(ss_));
        gdn_solve(src, scl, AD + d * 4096, dst, sb_, ss_);
    }
    __syncthreads();
}

__device__ __forceinline__ int chunk_of(int d, int s) { return d ? (s < 4 ? 3 - s : 67 - (s - 4)) : s; }
constexpr int TP = 272, AP = 144;
__device__ __forceinline__ bf16x8 ldfrag(const unsigned char* base, int row, int pitch, int kbyte) { return *(const bf16x8*)(base + row * pitch + kbyte); }
__device__ __forceinline__ void gdn_scan_item(const Ptrs& P, unsigned char* lds, int item, int tid, int lane, int wave) {
    const int chain = item & 31, slice = item >> 5, d = chain >> 4, b = (chain >> 2) & 3, h = chain & 3, e0 = slice * 32;
    unsigned char* Wl = lds; unsigned char* Ql = lds + 17408; unsigned char* Kl = lds + 34816; unsigned char* ATl = lds + 52224;
    unsigned char* St = lds + 61440; unsigned char* Vt = lds + 70144; unsigned char* Vdt = lds + 74752; float* gcs = (float*)(lds + 79360);
    const bf16_t* WBp = (const bf16_t*)(P.ws + WS_WB) + (size_t)((d * 4 + b) * 4 + h) * NCH * 8192;
    const bf16_t* UBp = (const bf16_t*)(P.ws + WS_UB) + (size_t)((d * 4 + b) * 4 + h) * NCH * 8192;
    const bf16_t* ATp = (const bf16_t*)(P.ws + WS_ATT) + (size_t)((d * 4 + b) * 4 + h) * NCH * 4096;
    const float* GCp = (const float*)(P.ws + WS_GC) + (size_t)((d * 4 + b) * 4 + h) * NCH * 64;
    const bf16_t* QGp = (const bf16_t*)(P.ws + WS_QG) + (size_t)(b * 4 + h) * NCH * 8192;
    const bf16_t* KGp = (const bf16_t*)(P.ws + WS_KG) + (size_t)(b * 4 + h) * NCH * 8192;
    bf16_t* Op = (bf16_t*)(P.ws + (d ? WS_OB : WS_OF));
    const int fr = lane & 15, fq = lane >> 4, mt = wave & 3, nt = wave >> 2;
    for (int i = tid; i < 8704 / 4; i += 512) ((unsigned*)St)[i] = 0u;
    f32x4 Sacc[2] = {(f32x4){0.f, 0.f, 0.f, 0.f}, (f32x4){0.f, 0.f, 0.f, 0.f}};
    u32x4 rw[2], rq[2], rk[2], ra; float rg = 0.f;
#define SCAN_PREFETCH(s_) do { const int cn_ = chunk_of(d, s_); \
        const u32x4* w4 = (const u32x4*)(WBp + (size_t)cn_ * 8192); const u32x4* q4 = (const u32x4*)(QGp + (size_t)cn_ * 8192); const u32x4* k4 = (const u32x4*)(KGp + (size_t)cn_ * 8192); \
        rw[0] = w4[tid]; rw[1] = w4[tid + 512]; rq[0] = q4[tid]; rq[1] = q4[tid + 512]; rk[0] = k4[tid]; rk[1] = k4[tid + 512]; \
        ra = ((const u32x4*)(ATp + (size_t)cn_ * 4096))[tid]; if (tid < 64) rg = GCp[cn_ * 64 + tid]; } while (0)
    SCAN_PREFETCH(0);
    for (int s = 0; s < NCH; ++s) {
        const int cn = chunk_of(d, s); const bool lat = cn >= 4;
#pragma unroll
        for (int i = 0; i < 2; ++i) { const int idx = tid + 512 * i, row = idx >> 4, cc = idx & 15;
            *(u32x4*)(Wl + row * TP + cc * 16) = rw[i]; *(u32x4*)(Ql + row * TP + cc * 16) = rq[i]; *(u32x4*)(Kl + row * TP + cc * 16) = rk[i]; }
        *(u32x4*)(ATl + (tid >> 3) * AP + (tid & 7) * 16) = ra;
        if (tid < 64) gcs[tid] = rg;
        __syncthreads();
        if (s + 1 < NCH) SCAN_PREFETCH(s + 1);
        float uv[4];
        { const bf16_t* up = UBp + (size_t)cn * 8192 + (mt * 16 + fq * 4) * 128 + e0 + nt * 16 + fr;
#pragma unroll
          for (int jj = 0; jj < 4; ++jj) uv[jj] = bf2f(up[jj * 128]); }
        const float glast = gcs[63];
        f32x4 acc_a = (f32x4){0.f, 0.f, 0.f, 0.f}, acc_b = (f32x4){0.f, 0.f, 0.f, 0.f};
        { const int qrow = d ? 63 - (mt * 16 + fr) : (mt * 16 + fr);
#pragma unroll
          for (int ks = 0; ks < 4; ++ks) { const bf16x8 bs = ldfrag(St, nt * 16 + fr, TP, ks * 64 + fq * 16);
              const bf16x8 aw = ldfrag(Wl, mt * 16 + fr, TP, ks * 64 + fq * 16);
              acc_a = __builtin_amdgcn_mfma_f32_16x16x32_bf16(aw, bs, acc_a, 0, 0, 0);
              if (lat) { const bf16x8 aq = ldfrag(Ql, qrow, TP, ks * 64 + fq * 16); acc_b = __builtin_amdgcn_mfma_f32_16x16x32_bf16(aq, bs, acc_b, 0, 0, 0); } } }
        { float vn[4], vd[4];
#pragma unroll
          for (int jj = 0; jj < 4; ++jj) { const float gi = gcs[mt * 16 + fq * 4 + jj]; vn[jj] = uv[jj] - acc_a[jj]; vd[jj] = vn[jj] * __expf(glast - gi); acc_b[jj] *= __expf(gi); }
          u32x2 w; w.x = pk2(vn[0], vn[1]); w.y = pk2(vn[2], vn[3]); *(u32x2*)(Vt + (nt * 16 + fr) * AP + (mt * 16 + fq * 4) * 2) = w;
          w.x = pk2(vd[0], vd[1]); w.y = pk2(vd[2], vd[3]); *(u32x2*)(Vdt + (nt * 16 + fr) * AP + (mt * 16 + fq * 4) * 2) = w; }
        __syncthreads();
        if (lat) {
#pragma unroll
            for (int ks = 0; ks < 2; ++ks) { const bf16x8 aa = ldfrag(ATl, mt * 16 + fr, AP, ks * 64 + fq * 16); const bf16x8 bv = ldfrag(Vt, nt * 16 + fr, AP, ks * 64 + fq * 16);
                acc_b = __builtin_amdgcn_mfma_f32_16x16x32_bf16(aa, bv, acc_b, 0, 0, 0); }
            bf16_t* op = Op + (size_t)(b * SEQ + (cn - 4) * 64) * 512 + h * 128 + e0 + nt * 16 + fr;
#pragma unroll
            for (int jj = 0; jj < 4; ++jj) { const int i = mt * 16 + fq * 4 + jj, tok = d ? 63 - i : i; op[(size_t)tok * 512] = (bf16_t)f2bf(acc_b[jj]); }
        }
        { const float eg = __expf(glast);
          bf16x8 ak[2];
#pragma unroll
          for (int ks = 0; ks < 2; ++ks)
#pragma unroll
              for (int jj = 0; jj < 8; ++jj) { const int i = ks * 32 + fq * 8 + jj, row = d ? 63 - i : i; ak[ks][jj] = (short)*(const bf16_t*)(Kl + row * TP + (16 * wave + fr) * 2); }
#pragma unroll
          for (int n2 = 0; n2 < 2; ++n2) { f32x4 a = Sacc[n2] * eg;
#pragma unroll
              for (int ks = 0; ks < 2; ++ks) { const bf16x8 bv = ldfrag(Vdt, n2 * 16 + fr, AP, ks * 64 + fq * 16); a = __builtin_amdgcn_mfma_f32_16x16x32_bf16(ak[ks], bv, a, 0, 0, 0); }
              Sacc[n2] = a;
              u32x2 w; w.x = pk2(a[0], a[1]); w.y = pk2(a[2], a[3]); *(u32x2*)(St + (n2 * 16 + fr) * TP + (16 * wave + fq * 4) * 2) = w; } }
        __syncthreads();
    }
#undef SCAN_PREFETCH
}

template <int MODE>
__device__ __forceinline__ void lru_item(const Ptrs& P, unsigned char* lds, int b, int cn, int nb, int tid, int lane, int wave) {
    const bool isctx = cn < 4; const int cl = isctx ? cn : cn - 4, L = isctx ? CTXL : SEQ, s0 = cl * 64;
    const bf16_t* PB = (const bf16_t*)(P.ws + WS_PB);
    float* xin = (float*)lds;
    float* xT = (float*)(lds + 17408);
    float* wg = (float*)(lds + 34816);
    f32x2* seg = (f32x2*)(lds + 100352);
#define rowof(s_) (isctx ? (size_t)(M_LAT + b * CTXL + (s_)) : (size_t)(b * SEQ + ((s_) & 63) * 64 + ((s_) >> 6)))
    for (int idx = tid; idx < 67 * 64; idx += 512) { const int si = idx >> 6, c = idx & 63, s = s0 - 2 + si;
        xin[idx] = (s >= 0 && s < L) ? bf2f(PB[rowof(s) * 1536 + 512 + nb * 64 + c]) : 0.f; }
    for (int idx = tid; idx < 4 * 4096; idx += 512) { const int dg = idx >> 12; wg[idx] = P.lwg[((size_t)dg * 8 + nb) * 4096 + (idx & 4095)]; }
    __syncthreads();
    { const int c = tid & 63, ig = tid >> 6, ch = nb * 64 + c;
      const float w0 = P.lconv[ch], w1 = P.lconv[512 + ch], w2 = P.lconv[1024 + ch], w3 = P.lconv[1536 + ch], bias = P.lconvb[ch];
#pragma unroll
      for (int ii = 0; ii < 8; ++ii) { const int i = ig * 8 + ii; xT[c * 68 + i] = bias + w0 * xin[i * 64 + c] + w1 * xin[(i + 1) * 64 + c] + w2 * xin[(i + 2) * 64 + c] + w3 * xin[(i + 3) * 64 + c]; } }
    __syncthreads();
    const int co = tid & 63, ig = tid >> 6, ch = nb * 64 + co;
    float acc[4][8];
#pragma unroll
    for (int q = 0; q < 4; ++q)
#pragma unroll
        for (int ii = 0; ii < 8; ++ii) acc[q][ii] = 0.f;
#pragma unroll 4
    for (int ci = 0; ci < 64; ++ci) { const f32x4 xa = *(const f32x4*)(xT + ci * 68 + ig * 8), xb = *(const f32x4*)(xT + ci * 68 + ig * 8 + 4);
        float wv[4];
#pragma unroll
        for (int q = 0; q < 4; ++q) wv[q] = wg[q * 4096 + ci * 64 + co];
#pragma unroll
        for (int q = 0; q < 4; ++q) {
#pragma unroll
            for (int ii = 0; ii < 4; ++ii) { acc[q][ii] += wv[q] * xa[ii]; acc[q][ii + 4] += wv[q] * xb[ii]; } } }
    float av[2][8], bv[2][8];
#pragma unroll
    for (int d = 0; d < 2; ++d) { const float bgr = P.lbg[(d * 2 + 0) * 512 + ch], bgi = P.lbg[(d * 2 + 1) * 512 + ch], sp = softplusf_(-P.llam[d * 512 + ch]);
#pragma unroll
        for (int ii = 0; ii < 8; ++ii) { const int i = ig * 8 + ii; const float xv = xT[co * 68 + i];
            const float r = sigmoidf_(acc[d * 2][ii] + bgr), ing = sigmoidf_(acc[d * 2 + 1][ii] + bgi), la = -8.f * sp * r;
            float mult = sqrtf(-expm1f(2.f * la));
            if (isctx && ((d == 0 && cn == 0 && i == 0) || (d == 1 && cn == 3 && i == 63))) mult = 1.f;
            av[d][ii] = __expf(la); bv[d][ii] = mult * ing * xv; } }
    { float A0 = 1.f, B0 = 0.f, A1 = 1.f, B1 = 0.f;
#pragma unroll
      for (int ii = 0; ii < 8; ++ii) { B0 = av[0][ii] * B0 + bv[0][ii]; A0 *= av[0][ii]; B1 = av[1][7 - ii] * B1 + bv[1][7 - ii]; A1 *= av[1][7 - ii]; }
      seg[(ig * 2 + 0) * 64 + co] = (f32x2){A0, B0}; seg[(ig * 2 + 1) * 64 + co] = (f32x2){A1, B1}; }
    __syncthreads();
    if constexpr (MODE == 0) {
        if (tid < 128) { const int d = tid >> 6; float At = 1.f, Bt = 0.f;
#pragma unroll
            for (int k = 0; k < 8; ++k) { const int sg = d ? 7 - k : k; const f32x2 v = seg[(sg * 2 + d) * 64 + co]; Bt = v[0] * Bt + v[1]; At *= v[0]; }
            ((f32x2*)(P.ws + WS_LSUM))[((size_t)(b * 2 + d) * NCH + cn) * 512 + ch] = (f32x2){At, Bt}; }
    } else {
        const float* CAR = (const float*)(P.ws + WS_LCAR);
        float hf = CAR[((size_t)(b * 2 + 0) * NCH + cn) * 512 + ch], hb = CAR[((size_t)(b * 2 + 1) * NCH + cn) * 512 + ch];
        for (int k = 0; k < ig; ++k) { const f32x2 v = seg[(k * 2 + 0) * 64 + co]; hf = v[0] * hf + v[1]; }
        for (int k = 7; k > ig; --k) { const f32x2 v = seg[(k * 2 + 1) * 64 + co]; hb = v[0] * hb + v[1]; }
        float o[8];
#pragma unroll
        for (int ii = 0; ii < 8; ++ii) { hf = av[0][ii] * hf + bv[0][ii]; o[ii] = hf; }
#pragma unroll
        for (int ii = 7; ii >= 0; --ii) { hb = av[1][ii] * hb + bv[1][ii]; o[ii] += hb; }
        bf16_t* MIX = (bf16_t*)(P.ws + WS_MIX);
#pragma unroll
        for (int ii = 0; ii < 8; ++ii) { const size_t row = rowof(s0 + ig * 8 + ii); const float gt = bf2f(PB[row * 1536 + 1024 + ch]);
            MIX[row * D + 512 + ch] = (bf16_t)f2bf(o[ii] * geluf_(gt)); }
    }
    __syncthreads();
#undef rowof
}
__device__ __forceinline__ void lru_carry(const Ptrs& P, int gt) {
    const int b = gt >> 10, d = (gt >> 9) & 1, ch = gt & 511;
    const f32x2* SUM = (const f32x2*)(P.ws + WS_LSUM) + (size_t)(b * 2 + d) * NCH * 512 + ch; float* CAR = (float*)(P.ws + WS_LCAR) + (size_t)(b * 2 + d) * NCH * 512 + ch;
    float carry = 0.f;
    for (int s0 = 0; s0 < NCH; s0 += 17) {
        f32x2 v[17];
#pragma unroll
        for (int k = 0; k < 17; ++k) v[k] = SUM[(size_t)chunk_of(d, s0 + k) * 512];
#pragma unroll
        for (int k = 0; k < 17; ++k) { CAR[(size_t)chunk_of(d, s0 + k) * 512] = carry; carry = v[k][0] * carry + v[k][1]; }
    }
}

__device__ __forceinline__ void gdn_combine(const Ptrs& P, int gw, int NGW, int lane) {
    const bf16_t* OF = (const bf16_t*)(P.ws + WS_OF); const bf16_t* OB = (const bf16_t*)(P.ws + WS_OB); const bf16_t* PB = (const bf16_t*)(P.ws + WS_PB); bf16_t* MIX = (bf16_t*)(P.ws + WS_MIX);
    float nw[8];
#pragma unroll
    for (int j = 0; j < 8; ++j) nw[j] = P.gnormw[(lane * 8 + j) & 127];
    for (int m = gw; m < M_LAT; m += NGW) {
        const u32x4 a = *(const u32x4*)(OF + (size_t)m * 512 + lane * 8), c = *(const u32x4*)(OB + (size_t)m * 512 + lane * 8), z = *(const u32x4*)(PB + (size_t)m * 1536 + lane * 8);
        float o[8], zz[8]; float ss = 0.f;
#pragma unroll
        for (int j = 0; j < 4; ++j) { o[2 * j] = bf2f(a[j] & 0xffffu) + bf2f(c[j] & 0xffffu); o[2 * j + 1] = bf2f(a[j] >> 16) + bf2f(c[j] >> 16); zz[2 * j] = bf2f(z[j] & 0xffffu); zz[2 * j + 1] = bf2f(z[j] >> 16); }
#pragma unroll
        for (int j = 0; j < 8; ++j) ss += o[j] * o[j];
        ss += __shfl_xor(ss, 1); ss += __shfl_xor(ss, 2); ss += __shfl_xor(ss, 4); ss += __shfl_xor(ss, 8);
        const float rs = rsqrtf(ss * (1.f / 128.f) + EPS);
        u32x4 w;
        w.x = pk2(o[0] * rs * nw[0] * siluf_(zz[0]), o[1] * rs * nw[1] * siluf_(zz[1])); w.y = pk2(o[2] * rs * nw[2] * siluf_(zz[2]), o[3] * rs * nw[3] * siluf_(zz[3]));
        w.z = pk2(o[4] * rs * nw[4] * siluf_(zz[4]), o[5] * rs * nw[5] * siluf_(zz[5])); w.w = pk2(o[6] * rs * nw[6] * siluf_(zz[6]), o[7] * rs * nw[7] * siluf_(zz[7]));
        *(u32x4*)(MIX + (size_t)m * D + lane * 8) = w;
    }
}

struct Args { const float* in[22]; float* out; unsigned char* ws; int ph_lo, ph_hi; };
constexpr int N_PHASES = 14;

__global__ void __launch_bounds__(512, 2) fwd_kernel(Args args) {
    extern __shared__ __attribute__((aligned(16))) unsigned char lds[];
    const int tid = threadIdx.x, lane = tid & 63, wave = __builtin_amdgcn_readfirstlane(tid >> 6);
    const int G = gridDim.x, bid = blockIdx.x, gw = bid * 8 + wave, NGW = G * 8;
    Ptrs P;
    P.x = args.in[0]; P.c = args.in[1]; P.ctx = args.in[2]; P.cctx = args.in[3]; P.w_ada = args.in[4]; P.b_ada = args.in[5]; P.norm_g = args.in[6];
    P.w1 = args.in[7]; P.w3 = args.in[8]; P.w2 = args.in[9]; P.w_in = args.in[10]; P.w_out = args.in[11]; P.gconv = args.in[12]; P.galog = args.in[13]; P.gdtb = args.in[14];
    P.gnormw = args.in[15]; P.lconv = args.in[16]; P.lconvb = args.in[17]; P.lwg = args.in[18]; P.lbg = args.in[19]; P.llam = args.in[20]; P.fng = args.in[21];
    P.out = args.out; P.ws = args.ws;
    unsigned char* ws = args.ws;
    const float* mods = (const float*)(ws + WS_MODS);
    bf16_t* U = (bf16_t*)(ws + WS_U); bf16_t* HID = (bf16_t*)(ws + WS_HID); float* H1CTX = (float*)(ws + WS_H1CTX);
    LAS unsigned char* ldsl = (LAS unsigned char*)lds;
    const int lo = args.ph_lo, hi = args.ph_hi;
#ifndef SKIP_MASK
#define SKIP_MASK 0
#endif
#define IN(k) (!((SKIP_MASK >> (k)) & 1) && lo <= (k) && (k) < hi)
#define SEAM(k) do { if (IN(k) && IN((k) + 1)) { cg::this_grid().sync(); } } while (0)

    if (IN(0)) { phase_prologue(P, lds, tid, lane, wave, bid, G); } SEAM(0);
    if (IN(1)) { phase_norm_mod(P.x, P.ctx, M_TOT, P.norm_g, mods, 0, 1, U, gw, NGW, lane); } SEAM(1);
    if (IN(2)) { pg8::Gemm g{U, (const bf16_t*)(ws + WS_W1A), M_TOT, 2 * FF, D}; pg8::StaticOrder S; S.init(M_TOT, 2 * FF, G, bid); pg8::EpiSwiglu E{HID};
        pg8::gemm_phase<pg8::EpiSwiglu, true>(ldsl, g, S, E); } SEAM(2);
    if (IN(3)) { pg8::Gemm g{HID, (const bf16_t*)(ws + WS_W2A), M_TOT, D, FF}; pg8::StaticOrder S; S.init(M_TOT, D, G, bid);
        pg8::EpiRes E{P.x, P.ctx, P.out, H1CTX, mods + 2 * D, 0.5f}; pg8::gemm_phase<pg8::EpiRes, true>(ldsl, g, S, E); } SEAM(3);
    if (IN(4)) { phase_norm_mod(P.out, H1CTX, M_TOT, P.norm_g + D, mods, 3, 4, U, gw, NGW, lane); } SEAM(4);
    if (IN(5)) { pg8::Gemm g{U, (const bf16_t*)(ws + WS_WIN), M_TOT, NIN, D}; pg8::StaticOrder S; S.init(M_TOT, NIN, G, bid);
        pg8::EpiIn E{(bf16_t*)(ws + WS_PA), (bf16_t*)(ws + WS_PB), (float*)(ws + WS_BA)}; pg8::gemm_phase<pg8::EpiIn, true>(ldsl, g, S, E); } SEAM(5);
    if (IN(6)) {
        for (int it = bid; it < NB * 4 * NCH; it += G) gdn_prep_item(P, lds, it, tid, lane, wave);
        for (int it = bid; it < NB * NCH * 8; it += G) { const int b = it / (NCH * 8), cn = (it / 8) % NCH, nb = it & 7; lru_item<0>(P, lds, b, cn, nb, tid, lane, wave); }
    } SEAM(6);
    if (IN(7)) {
        for (int j = 0; j < 8; ++j) if ((G - 1 - j) % G == bid) lru_carry(P, j * 512 + tid);
        for (int it = bid; it < 128; it += G) { gdn_scan_item(P, lds, it, tid, lane, wave); __syncthreads(); }
    } SEAM(7);
    if (IN(8)) {
        gdn_combine(P, gw, NGW, lane);
        for (int it = bid; it < NB * 64 * 8; it += G) { const int b = it / 512, cn = 4 + ((it >> 3) & 63), nb = it & 7; lru_item<1>(P, lds, b, cn, nb, tid, lane, wave); }
    } SEAM(8);
    if (IN(9)) { pg8::Gemm g{(const bf16_t*)(ws + WS_MIX), (const bf16_t*)(ws + WS_WOUT), M_LAT, D, D}; pg8::StaticOrder S; S.init(M_LAT, D, G, bid);
        pg8::EpiRes E{P.out, P.out, P.out, P.out, mods + 5 * D, 1.0f}; pg8::gemm_phase<pg8::EpiRes, true>(ldsl, g, S, E); } SEAM(9);
    if (IN(10)) { phase_norm_mod(P.out, P.out, M_LAT, P.norm_g + 2 * D, mods, 6, 7, U, gw, NGW, lane); } SEAM(10);
    if (IN(11)) { pg8::Gemm g{U, (const bf16_t*)(ws + WS_W1B), M_LAT, 2 * FF, D}; pg8::StaticOrder S; S.init(M_LAT, 2 * FF, G, bid); pg8::EpiSwiglu E{HID};
        pg8::gemm_phase<pg8::EpiSwiglu, true>(ldsl, g, S, E); } SEAM(11);
    if (IN(12)) { pg8::Gemm g{HID, (const bf16_t*)(ws + WS_W2B), M_LAT, D, FF}; pg8::StaticOrder S; S.init(M_LAT, D, G, bid);
        pg8::EpiRes E{P.out, P.out, P.out, P.out, mods + 8 * D, 0.5f}; pg8::gemm_phase<pg8::EpiRes, true>(ldsl, g, S, E); } SEAM(12);
    if (IN(13)) {
        for (int m = gw; m < M_LAT; m += NGW) { float* row = P.out + (size_t)m * D; f32x4 v[4]; float ss = 0.f;
#pragma unroll
            for (int j = 0; j < 4; ++j) { v[j] = *(const f32x4*)(row + 4 * lane + 256 * j); ss += (v[j][0] * v[j][0] + v[j][1] * v[j][1]) + (v[j][2] * v[j][2] + v[j][3] * v[j][3]); }
            const float rstd = rsqrtf(wave_sum(ss) * (1.f / D) + EPS);
#pragma unroll
            for (int j = 0; j < 4; ++j) { const f32x4 gv = *(const f32x4*)(P.fng + 4 * lane + 256 * j); *(f32x4*)(row + 4 * lane + 256 * j) = v[j] * rstd * gv; } }
    }
#undef IN
#undef SEAM
}

extern "C" void kernel_launch(void* const* d_in, const int* in_sizes, int n_in, void* d_out, int out_size, void* d_ws, size_t ws_size, hipStream_t stream) {
    static int grid = 0;
    if (grid == 0) {
        if (n_in != 22 || out_size != M_LAT * D || ws_size < WS_END) { fprintf(stderr, "kernel_launch: unexpected shapes (n_in %d, out %d, ws %zu)\n", n_in, out_size, ws_size); grid = -1; return; }
        int dev = 0, cus = 0, per_cu = 0;
        hipGetDevice(&dev); hipDeviceGetAttribute(&cus, hipDeviceAttributeMultiprocessorCount, dev);
        if (hipFuncSetAttribute((const void*)fwd_kernel, hipFuncAttributeMaxDynamicSharedMemorySize, LDS_BYTES) != hipSuccess) { fprintf(stderr, "kernel_launch: hipFuncSetAttribute failed\n"); grid = -1; return; }
        if (hipOccupancyMaxActiveBlocksPerMultiprocessor(&per_cu, (const void*)fwd_kernel, 512, LDS_BYTES) != hipSuccess || per_cu < 1) { fprintf(stderr, "kernel_launch: occupancy query gives %d\n", per_cu); per_cu = 1; }
        (void)hipGetLastError();
        grid = cus;
        fprintf(stderr, "kernel_launch: grid %d (cus %d, per_cu %d)\n", grid, cus, per_cu);
    }
    if (grid < 0) return;
    Args a{};
    for (int i = 0; i < 22; ++i) a.in[i] = (const float*)d_in[i];
    a.out = (float*)d_out; a.ws = (unsigned char*)d_ws;
#if ONE_LAUNCH
    a.ph_lo = 0; a.ph_hi = N_PHASES;
    void* kargs[] = {&a};
    hipError_t e = hipLaunchCooperativeKernel((const void*)fwd_kernel, dim3(grid), dim3(512), kargs, LDS_BYTES, stream);
    if (e != hipSuccess) fprintf(stderr, "kernel_launch: cooperative launch failed: %s\n", hipGetErrorString(e));
#else
    for (int p = 0; p < N_PHASES; ++p) { a.ph_lo = p; a.ph_hi = p + 1; hipLaunchKernelGGL(fwd_kernel, dim3(grid), dim3(512), LDS_BYTES, stream, a); }
#endif
}
```

```cpp
#include <hip/hip_runtime.h>
#include <hip/hip_cooperative_groups.h>
#include <cstdio>
#include <cstdint>
namespace cg = cooperative_groups;

#ifndef ONE_LAUNCH
#define ONE_LAUNCH 1
#endif

#define LAS __attribute__((address_space(3)))
typedef unsigned short bf16_t;
typedef short bf16x8 __attribute__((ext_vector_type(8)));
typedef float f32x4 __attribute__((ext_vector_type(4)));
typedef float f32x2 __attribute__((ext_vector_type(2)));
typedef unsigned u32x4 __attribute__((ext_vector_type(4)));
typedef unsigned u32x2 __attribute__((ext_vector_type(2)));

constexpr int D = 1024, NB = 4, SEQ = 4096, CTXL = 256, FF = 2816;
constexpr int M_LAT = NB * SEQ, M_CTX = NB * CTXL, M_TOT = M_LAT + M_CTX;
constexpr int NMOD = 9 * D;
constexpr int IN_COLS = 3088, NIN = 3328;
constexpr int NCH = 68;
constexpr float EPS = 1e-6f;

constexpr size_t MiB = 1u << 20;
constexpr size_t WS_MODS = 1 * MiB, WS_BA = 2 * MiB, WS_GC = 4 * MiB, WS_LSUM = 5 * MiB, WS_LCAR = 7 * MiB + MiB / 2;
constexpr size_t WS_WOUT = 10 * MiB, WS_W1B = 12 * MiB, WS_W2B = 23 * MiB;
constexpr size_t WS_PA = 29 * MiB, WS_PB = 80 * MiB, WS_HID = 29 * MiB, WS_OF = 29 * MiB, WS_OB = 45 * MiB;
constexpr size_t WS_U = 131 * MiB, WS_W1A = 165 * MiB, WS_W2A = 176 * MiB, WS_WIN = 182 * MiB, WS_H1CTX = 189 * MiB;
constexpr size_t WS_QG = 131 * MiB, WS_KG = 148 * MiB, WS_WB = 165 * MiB, WS_UB = 199 * MiB, WS_ATT = 233 * MiB, WS_MIX = 131 * MiB;
constexpr size_t WS_END = 256 * MiB;
constexpr int LDS_BYTES = 147456;

__device__ __forceinline__ unsigned f2bf(float f) { unsigned u = __builtin_bit_cast(unsigned, f); return (u + 0x7fffu + ((u >> 16) & 1u)) >> 16; }
__device__ __forceinline__ unsigned pk2(float lo, float hi) { return f2bf(lo) | (f2bf(hi) << 16); }
__device__ __forceinline__ float bf2f(unsigned h) { return __builtin_bit_cast(float, h << 16); }
__device__ __forceinline__ float wave_sum(float v) {
#pragma unroll
    for (int o = 1; o < 64; o <<= 1) v += __shfl_xor(v, o);
    return v;
}
__device__ __forceinline__ float sigmoidf_(float x) { return 1.f / (1.f + __expf(-x)); }
__device__ __forceinline__ float siluf_(float x) { return x / (1.f + __expf(-x)); }
__device__ __forceinline__ float softplusf_(float x) { return x > 20.f ? x : log1pf(__expf(x)); }
__device__ __forceinline__ float geluf_(float x) { const float t = 0.7978845608f * (x + 0.044715f * x * x * x); return 0.5f * x * (1.f + tanhf(t)); }
#define LDS_WAIT() asm volatile("s_waitcnt lgkmcnt(0)" ::: "memory")

namespace pg8 {
constexpr int BM = 256, BK = 64, HALF = 128, HTB = HALF * BK * 2, NXCD = 8, WGM = 8;
__host__ __device__ __forceinline__ int lds_byte(int r, int c) { const int st = (r >> 4) * 2 + (c >> 5), rr = r & 15, cc = c & 31, ob = rr * 64 + cc * 2; return st * 1024 + (ob ^ (((ob >> 9) & 1) << 5)); }
__host__ __device__ __forceinline__ void stage_rc(int b, int& R, int& C) { const int st = b / 1024, sb = b % 1024, swz = sb ^ (((sb >> 9) & 1) << 5); R = (st >> 1) * 16 + swz / 64; C = (st & 1) * 32 + (swz % 64) / 2; }
struct Unit { int pm, pn; };
struct Gemm { const bf16_t* A; const bf16_t* Bt; int M, N, K; };
struct StaticOrder {
    int nM, nN, nwg, G, c;
    __device__ void init(int M, int N, int G_, int c_) { nM = M / BM; nN = N / BM; nwg = nM * nN; G = G_; c = c_; }
    __device__ bool next(int i, Unit& u) const {
        const long L = (long)i * G + c; if (L >= nwg) return false;
        int wgid = (int)L; { const int q = nwg / NXCD, r = nwg % NXCD, xcd = wgid % NXCD, off = wgid / NXCD; wgid = (xcd < r ? xcd * (q + 1) : r * (q + 1) + (xcd - r) * q) + off; }
        const int nig = WGM * nN, gid = wgid / nig, fm = gid * WGM, gsz = (nM - fm) < WGM ? (nM - fm) : WGM;
        u.pm = fm + ((wgid % nig) % gsz); u.pn = (wgid % nig) / gsz; return true;
    }
};
template <class Epi, bool ALIGN_EPI>
__device__ __forceinline__ void gemm_phase(LAS unsigned char* lds, const Gemm g, const StaticOrder& S, const Epi& E) {
    const int tid = threadIdx.x, wid = __builtin_amdgcn_readfirstlane(tid >> 6), lane = tid & 63, wr = wid >> 2, wc = wid & 3, fr = lane & 15, fq = lane >> 4;
    const int K = g.K, nt = K / BK;
    unsigned voffA[2];
#pragma unroll
    for (int i = 0; i < 2; ++i) { int R, C; stage_rc(tid * 16 + i * 8192, R, C); voffA[i] = (unsigned)(R * K + C) * 2u; }
    const size_t kstep = (size_t)(BK * 2);
    const size_t hstep = (size_t)HALF * K * 2;
    const size_t tstep = 2 * hstep;
    const unsigned ldsw = (unsigned)wid * 1024u;
    const int aoff = lds_byte(wr * 64 + fr, fq * 8), boff = lds_byte(wc * 32 + fr, fq * 8);
#define PG8_SA(b, h) (((b) * 2 + (h)) * HTB)
#define PG8_SB(b, h) ((4 + (b) * 2 + (h)) * HTB)
#define PG8_STAGE(bufoff, gbase, voff) do { _Pragma("unroll") for (int _i = 0; _i < 2; ++_i) \
        __builtin_amdgcn_global_load_lds((const unsigned*)((const char*)(gbase) + (voff)[_i]), (LAS unsigned*)(lds + (bufoff) + ldsw + _i * 8192), 16, 0, 0); } while (0)
#define PG8_LDA(dst, b, h) do { _Pragma("unroll") for (int m = 0; m < 4; ++m) _Pragma("unroll") for (int k = 0; k < 2; ++k) dst[m][k] = *(const LAS bf16x8*)(lds + PG8_SA(b, h) + aoff + m * 2048 + k * 1024); } while (0)
#define PG8_LDB(dst, b, h) do { _Pragma("unroll") for (int n = 0; n < 2; ++n) _Pragma("unroll") for (int k = 0; k < 2; ++k) dst[n][k] = *(const LAS bf16x8*)(lds + PG8_SB(b, h) + boff + n * 2048 + k * 1024); } while (0)
#define PG8_MMA(ai, bj, At, Bt) do { __builtin_amdgcn_s_setprio(1); _Pragma("unroll") for (int m = 0; m < 4; ++m) _Pragma("unroll") for (int n = 0; n < 2; ++n) _Pragma("unroll") for (int k = 0; k < 2; ++k) \
        acc[ai][bj][m][n] = __builtin_amdgcn_mfma_f32_16x16x32_bf16(Bt[n][k], At[m][k], acc[ai][bj][m][n], 0, 0, 0); __builtin_amdgcn_s_setprio(0); } while (0)
#define PG8_WAIT_V(n) asm volatile("s_waitcnt vmcnt(" #n ")" ::: "memory")
#define PG8_WAIT_L(n) asm volatile("s_waitcnt lgkmcnt(" #n ")" ::: "memory")
#define PG8_BAR __builtin_amdgcn_s_barrier()
#define PG8_SCHED __builtin_amdgcn_sched_barrier(0)
    Unit cur, nxt; int ui = 0;
    if (!S.next(0, cur)) return;
    f32x4 acc[2][2][4][2];
#pragma unroll
    for (int a = 0; a < 2; ++a)
#pragma unroll
        for (int b = 0; b < 2; ++b)
#pragma unroll
            for (int m = 0; m < 4; ++m)
#pragma unroll
                for (int n = 0; n < 2; ++n) acc[a][b][m][n] = (f32x4){0.f, 0.f, 0.f, 0.f};
    bf16x8 At[4][2], B0[2][2], B1[2][2];
    const char* cA = (const char*)g.A + (size_t)cur.pm * tstep; const char* cB = (const char*)g.Bt + (size_t)cur.pn * tstep;
    PG8_STAGE(PG8_SB(0, 0), cB, voffA); PG8_STAGE(PG8_SB(0, 1), cB + hstep, voffA); PG8_STAGE(PG8_SA(0, 0), cA, voffA); PG8_STAGE(PG8_SA(0, 1), cA + hstep, voffA);
    if (wr == 1) PG8_BAR;
    PG8_WAIT_V(2); PG8_BAR;
    PG8_STAGE(PG8_SB(1, 0), cB + kstep, voffA); PG8_STAGE(PG8_SA(1, 0), cA + kstep, voffA); PG8_STAGE(PG8_SB(1, 1), cB + hstep + kstep, voffA);
    PG8_WAIT_V(6); PG8_BAR;
    for (;;) {
        const bool has_next = S.next(ui + 1, nxt);
        const char* nA = has_next ? (const char*)g.A + (size_t)nxt.pm * tstep : cA; const char* nB = has_next ? (const char*)g.Bt + (size_t)nxt.pn * tstep : cB;
        for (int t = 0; t < nt; t += 2) {
            const bool last = (t == nt - 2);
            const char* a1 = cA + (size_t)(t + 1) * kstep;
            const char* a2 = last ? nA : cA + (size_t)(t + 2) * kstep; const char* b2 = last ? nB : cB + (size_t)(t + 2) * kstep;
            const char* a3 = a2 + kstep; const char* b3 = b2 + kstep;
            PG8_LDB(B0, 0, 0); PG8_LDB(B1, 0, 1); PG8_SCHED; PG8_LDA(At, 0, 0); PG8_STAGE(PG8_SA(1, 1), a1 + hstep, voffA);
            PG8_WAIT_V(8); PG8_WAIT_L(0); PG8_BAR; PG8_MMA(0, 0, At, B0); PG8_MMA(0, 1, At, B1); PG8_BAR; PG8_SCHED;
            PG8_LDA(At, 0, 1); PG8_STAGE(PG8_SB(0, 0), b2, voffA); PG8_STAGE(PG8_SB(0, 1), b2 + hstep, voffA); PG8_STAGE(PG8_SA(0, 0), a2, voffA);
            PG8_WAIT_V(8); PG8_WAIT_L(0); PG8_BAR; PG8_MMA(1, 0, At, B0); PG8_MMA(1, 1, At, B1); PG8_BAR; PG8_SCHED;
            PG8_LDB(B0, 1, 0); PG8_LDB(B1, 1, 1); PG8_SCHED; PG8_LDA(At, 1, 0); PG8_STAGE(PG8_SA(0, 1), a2 + hstep, voffA);
            PG8_WAIT_V(8); PG8_WAIT_L(0); PG8_BAR; PG8_MMA(0, 0, At, B0); PG8_MMA(0, 1, At, B1); PG8_BAR; PG8_SCHED;
            PG8_LDA(At, 1, 1); PG8_STAGE(PG8_SB(1, 0), b3, voffA); PG8_STAGE(PG8_SB(1, 1), b3 + hstep, voffA); PG8_STAGE(PG8_SA(1, 0), a3, voffA);
            PG8_WAIT_V(8); PG8_WAIT_L(0); PG8_BAR; PG8_MMA(1, 0, At, B0); PG8_MMA(1, 1, At, B1); PG8_BAR; PG8_SCHED;
        }
        if constexpr (ALIGN_EPI) { if (wr == 0) PG8_BAR; }
        E(acc, cur, wr, wc, fr, fq);
        if (!has_next) break;
#pragma unroll
        for (int a = 0; a < 2; ++a)
#pragma unroll
            for (int b = 0; b < 2; ++b)
#pragma unroll
                for (int m = 0; m < 4; ++m)
#pragma unroll
                    for (int n = 0; n < 2; ++n) acc[a][b][m][n] = (f32x4){0.f, 0.f, 0.f, 0.f};
        cur = nxt; cA = nA; cB = nB; ++ui;
        if constexpr (ALIGN_EPI) { if (wr == 1) PG8_BAR; }
    }
    PG8_WAIT_V(0);
    if constexpr (!ALIGN_EPI) { if (wr == 0) PG8_BAR; }
    PG8_BAR;
#undef PG8_SA
#undef PG8_SB
#undef PG8_STAGE
#undef PG8_LDA
#undef PG8_LDB
#undef PG8_MMA
#undef PG8_WAIT_V
#undef PG8_WAIT_L
#undef PG8_BAR
#undef PG8_SCHED
}

struct EpiSwiglu {
    bf16_t* H;
    __device__ __forceinline__ void operator()(const f32x4 (&acc)[2][2][4][2], const Unit& u, int wr, int wc, int fr, int fq) const {
        const int row0 = u.pm * BM + wr * 64 + fr, col0 = u.pn * 128 + wc * 32 + 4 * fq;
#pragma unroll
        for (int ai = 0; ai < 2; ++ai)
#pragma unroll
            for (int m = 0; m < 4; ++m) { bf16_t* rowp = H + (size_t)(row0 + ai * HALF + m * 16) * FF + col0;
#pragma unroll
                for (int n = 0; n < 2; ++n) { const f32x4 gt = acc[ai][0][m][n], up = acc[ai][1][m][n];
                    u32x2 w; w.x = pk2(siluf_(gt[0]) * up[0], siluf_(gt[1]) * up[1]); w.y = pk2(siluf_(gt[2]) * up[2], siluf_(gt[3]) * up[3]);
                    *(u32x2*)(rowp + n * 16) = w; } }
    }
};
struct EpiRes {
    const float* res_lat; const float* res_ctx; float* out_lat; float* out_ctx; const float* gate; float coef;
    __device__ __forceinline__ void operator()(const f32x4 (&acc)[2][2][4][2], const Unit& u, int wr, int wc, int fr, int fq) const {
        const bool isctx = u.pm >= 64; const int mr = isctx ? 4 : (u.pm >> 4);
        const int lrow0 = (isctx ? (u.pm - 64) : u.pm) * BM + wr * 64 + fr, col0 = u.pn * BM + wc * 32 + 4 * fq;
        const float* res = isctx ? res_ctx : res_lat; float* out = isctx ? out_ctx : out_lat;
        const float* gp = gate + (size_t)mr * NMOD + col0;
        f32x4 gv[2][2];
#pragma unroll
        for (int bj = 0; bj < 2; ++bj)
#pragma unroll
            for (int n = 0; n < 2; ++n) gv[bj][n] = *(const f32x4*)(gp + bj * HALF + n * 16) * coef;
#pragma unroll
        for (int ai = 0; ai < 2; ++ai)
#pragma unroll
            for (int m = 0; m < 4; ++m) { const size_t ro = (size_t)(lrow0 + ai * HALF + m * 16) * D + col0;
#pragma unroll
                for (int bj = 0; bj < 2; ++bj)
#pragma unroll
                    for (int n = 0; n < 2; ++n) { const f32x4 r = *(const f32x4*)(res + ro + bj * HALF + n * 16);
                        *(f32x4*)(out + ro + bj * HALF + n * 16) = r + gv[bj][n] * acc[ai][bj][m][n]; } }
    }
};
struct EpiIn {
    bf16_t* PA; bf16_t* PB; float* BA;
    __device__ __forceinline__ void operator()(const f32x4 (&acc)[2][2][4][2], const Unit& u, int wr, int wc, int fr, int fq) const {
        const int row0 = u.pm * BM + wr * 64 + fr;
        if (u.pn == 12) {
            if (wc == 0) {
#pragma unroll
                for (int ai = 0; ai < 2; ++ai)
#pragma unroll
                    for (int m = 0; m < 4; ++m) *(f32x4*)(BA + (size_t)(row0 + ai * HALF + m * 16) * 16 + 4 * fq) = acc[ai][0][m][0];
            }
            return;
        }
        bf16_t* base = (u.pn < 6) ? PA : PB; const int col0 = (u.pn % 6) * BM + wc * 32 + 4 * fq;
#pragma unroll
        for (int ai = 0; ai < 2; ++ai)
#pragma unroll
            for (int m = 0; m < 4; ++m) { bf16_t* rowp = base + (size_t)(row0 + ai * HALF + m * 16) * 1536 + col0;
#pragma unroll
                for (int bj = 0; bj < 2; ++bj)
#pragma unroll
                    for (int n = 0; n < 2; ++n) { const f32x4 v = acc[ai][bj][m][n]; u32x2 w; w.x = pk2(v[0], v[1]); w.y = pk2(v[2], v[3]); *(u32x2*)(rowp + bj * HALF + n * 16) = w; } }
    }
};
}

__device__ __forceinline__ void transpose_item(const float* W, int N, int k0, int src_col0, int nvalid, bf16_t* WT, int Kp, int dst_row0, float* scr, int lane) {
#pragma unroll 8
    for (int i = 0; i < 32; ++i) { const int kk = 2 * i + (lane >> 5), n = lane & 31; scr[kk * 33 + n] = (n < nvalid) ? W[(size_t)(k0 + kk) * N + src_col0 + n] : 0.f; }
    LDS_WAIT();
    const int c = lane & 7;
#pragma unroll
    for (int j = 0; j < 4; ++j) { const int n = (lane >> 3) + 8 * j; const float* s = scr + (8 * c) * 33 + n;
        u32x4 o; o.x = pk2(s[0 * 33], s[1 * 33]); o.y = pk2(s[2 * 33], s[3 * 33]); o.z = pk2(s[4 * 33], s[5 * 33]); o.w = pk2(s[6 * 33], s[7 * 33]);
        *(u32x4*)(WT + (size_t)(dst_row0 + n) * Kp + k0 + 8 * c) = o; }
    LDS_WAIT();
}

struct Ptrs {
    const float *x, *c, *ctx, *cctx, *w_ada, *b_ada, *norm_g, *w1, *w3, *w2, *w_in, *w_out, *gconv, *galog, *gdtb, *gnormw, *lconv, *lconvb, *lwg, *lbg, *llam, *fng;
    float* out; unsigned char* ws;
};

__device__ __forceinline__ void phase_prologue(const Ptrs& P, unsigned char* lds, int tid, int lane, int wave, int bid, int G) {
    float* mods = (float*)(P.ws + WS_MODS);
    {
        float* sc = (float*)lds;
        for (int i = tid; i < 5 * D; i += 512) { const int r = i >> 10, k = i & 1023; const float v = (r < 4) ? P.c[r * D + k] : P.cctx[k]; sc[i] = siluf_(v); }
        __syncthreads();
        float* red = (float*)(lds + 20480);
        for (int it = bid; it < NMOD / 64; it += G) {
            const int n0 = it * 64, cq = tid & 15, kl = tid >> 4;
            float acc[5][4];
#pragma unroll
            for (int r = 0; r < 5; ++r)
#pragma unroll
                for (int j = 0; j < 4; ++j) acc[r][j] = 0.f;
#pragma unroll 4
            for (int i = 0; i < 32; ++i) { const int k = kl + 32 * i; const f32x4 w = *(const f32x4*)(P.w_ada + (size_t)k * NMOD + n0 + 4 * cq);
#pragma unroll
                for (int r = 0; r < 5; ++r) { const float s = sc[r * D + k];
#pragma unroll
                    for (int j = 0; j < 4; ++j) acc[r][j] += s * w[j]; } }
#pragma unroll
            for (int r = 0; r < 5; ++r)
#pragma unroll
                for (int j = 0; j < 4; ++j) red[(kl * 16 + cq) * 20 + r * 4 + j] = acc[r][j];
            __syncthreads();
            if (tid < 320) { const int cq2 = tid / 20, rj = tid % 20; float s = 0.f;
                for (int k2 = 0; k2 < 32; ++k2) s += red[(k2 * 16 + cq2) * 20 + rj];
                const int r = rj >> 2, n = n0 + 4 * cq2 + (rj & 3); mods[r * NMOD + n] = s + P.b_ada[n]; }
            __syncthreads();
        }
        __syncthreads();
    }
    {
        float* scr = (float*)(lds + wave * 16384);
        const int gw = bid * 8 + wave, NGW = G * 8;
        bf16_t* W1A = (bf16_t*)(P.ws + WS_W1A); bf16_t* W2A = (bf16_t*)(P.ws + WS_W2A); bf16_t* W1B = (bf16_t*)(P.ws + WS_W1B); bf16_t* W2B = (bf16_t*)(P.ws + WS_W2B);
        bf16_t* WIN = (bf16_t*)(P.ws + WS_WIN); bf16_t* WOUT = (bf16_t*)(P.ws + WS_WOUT);
        constexpr int I_UP = 16 * 88, I_DN = 44 * 32, I_IN = 16 * 97, I_OUT = 16 * 32;
        constexpr int NITEMS = 6 * I_UP + I_IN + I_OUT;
        static_assert(I_UP == I_DN, "item counts");
        for (int it = gw; it < NITEMS; it += NGW) {
            int r = it;
            if (r < 6 * I_UP) {
                const int seg = r / I_UP; r -= seg * I_UP; const int layer = seg / 3, kind = seg % 3;
                if (kind < 2) { const int kb = r / 88, nbk = r % 88, sc0 = 32 * nbk; const float* W = (kind == 0 ? P.w1 : P.w3) + (size_t)layer * D * FF;
                    transpose_item(W, FF, 64 * kb, sc0, 32, layer ? W1B : W1A, D, 256 * (sc0 / 128) + (sc0 % 128) + (kind ? 128 : 0), scr, lane); }
                else { const int kb = r / 32, nbk = r % 32; transpose_item(P.w2 + (size_t)layer * FF * D, D, 64 * kb, 32 * nbk, 32, layer ? W2B : W2A, FF, 32 * nbk, scr, lane); }
                continue;
            }
            r -= 6 * I_UP;
            if (r < I_IN) { const int kb = r / 97, g = r % 97;
                if (g < 64) transpose_item(P.w_in, IN_COLS, 64 * kb, 32 * g, 32, WIN, D, 32 * g, scr, lane);
                else if (g < 96) transpose_item(P.w_in, IN_COLS, 64 * kb, 2064 + 32 * (g - 64), 32, WIN, D, 2048 + 32 * (g - 64), scr, lane);
                else transpose_item(P.w_in, IN_COLS, 64 * kb, 2048, 16, WIN, D, 3072, scr, lane);
                continue; }
            r -= I_IN;
            { const int kb = r / 32, nbk = r % 32; transpose_item(P.w_out, D, 64 * kb, 32 * nbk, 32, WOUT, D, 32 * nbk, scr, lane); }
        }
        u32x4* z = (u32x4*)(WIN + (size_t)3104 * D);
        for (int i = bid * 512 + tid; i < 224 * D * 2 / 16; i += G * 512) z[i] = (u32x4){0u, 0u, 0u, 0u};
    }
}

__device__ __forceinline__ void phase_norm_mod(const float* src_lat, const float* src_ctx, int nrows, const float* g, const float* mods, int shift_idx, int scale_idx, bf16_t* U, int gw, int NGW, int lane) {
    for (int m = gw; m < nrows; m += NGW) {
        const float* xrow = (m < M_LAT) ? src_lat + (size_t)m * D : src_ctx + (size_t)(m - M_LAT) * D;
        const int mr = (m < M_LAT) ? (m >> 12) : 4;
        const float* sh = mods + (size_t)mr * NMOD + shift_idx * D; const float* sc = mods + (size_t)mr * NMOD + scale_idx * D;
        f32x4 v[4]; float ss = 0.f;
#pragma unroll
        for (int j = 0; j < 4; ++j) { v[j] = *(const f32x4*)(xrow + 4 * lane + 256 * j); ss += (v[j][0] * v[j][0] + v[j][1] * v[j][1]) + (v[j][2] * v[j][2] + v[j][3] * v[j][3]); }
        const float rstd = rsqrtf(wave_sum(ss) * (1.f / D) + EPS);
#pragma unroll
        for (int j = 0; j < 4; ++j) { const int col = 4 * lane + 256 * j;
            const f32x4 gv = *(const f32x4*)(g + col), sv = *(const f32x4*)(sc + col), hv = *(const f32x4*)(sh + col);
            const f32x4 y = v[j] * rstd * gv * (sv + 1.f) + hv;
            u32x2 w; w.x = pk2(y[0], y[1]); w.y = pk2(y[2], y[3]); *(u32x2*)(U + (size_t)m * D + col) = w; }
    }
}

constexpr int KP = 132;
__device__ __forceinline__ void gdn_solve(const float* src, const float* scl, const float* A, bf16_t* dst, int base, int stride) {
    float x[64];
#pragma unroll
    for (int i = 0; i < 64; ++i) x[i] = 0.f;
#pragma unroll
    for (int i = 0; i < 64; ++i) {
        float s0 = src[base + i * stride] * scl[i], s1 = 0.f, s2 = 0.f, s3 = 0.f;
#pragma unroll
        for (int j4 = 0; j4 < (i + 3) / 4; ++j4) { const f32x4 av = *(const f32x4*)(A + i * 64 + 4 * j4);
            s0 -= av[0] * x[4 * j4]; s1 -= av[1] * x[4 * j4 + 1]; s2 -= av[2] * x[4 * j4 + 2]; s3 -= av[3] * x[4 * j4 + 3]; }
        x[i] = (s0 + s1) + (s2 + s3);
        dst[i * 128] = (bf16_t)f2bf(x[i]);
    }
}
__device__ __forceinline__ void gdn_prep_item(const Ptrs& P, unsigned char* lds, int item, int tid, int lane, int wave) {
    const int b = item / (4 * NCH), h = (item / NCH) & 3, cn = item % NCH;
    const bool isctx = cn < 4; const int cl = isctx ? cn : cn - 4, L = isctx ? CTXL : SEQ;
    const int rowbase = isctx ? M_LAT + b * CTXL : b * SEQ;
    const bf16_t* PA = (const bf16_t*)(P.ws + WS_PA); const float* BA = (const float*)(P.ws + WS_BA);
    int lo_ = 0; asm volatile("" : "+v"(lo_));
    float* KF = (float*)(lds + lo_); float* QF = (float*)(lds + lo_ + 33792); float* VF = (float*)(lds + lo_ + 67584);
    float* KKN = (float*)(lds + lo_ + 101376); float* QKN = (float*)(lds + lo_ + 118016);
    float* GS = (float*)(lds + lo_ + 134656);
    float* RB = GS + 128;
    float* RBE = GS + 256;
    float* AD = QF;
    {
        const int c = tid & 127, tg = tid >> 7;
#pragma unroll
        for (int mat = 0; mat < 3; ++mat) {
            const int ch = mat * 512 + h * 128 + c;
            const float w0 = P.gconv[ch], w1 = P.gconv[1536 + ch], w2 = P.gconv[2 * 1536 + ch], w3 = P.gconv[3 * 1536 + ch];
            const int t0 = cl * 64 + tg * 16;
            const bf16_t* src = PA + (size_t)rowbase * 1536 + ch;
            float xm2 = (t0 - 2 >= 0) ? bf2f(src[(size_t)(t0 - 2) * 1536]) : 0.f;
            float xm1 = (t0 - 1 >= 0) ? bf2f(src[(size_t)(t0 - 1) * 1536]) : 0.f;
            float x0 = bf2f(src[(size_t)t0 * 1536]);
            float* dst = (mat == 0 ? QF : (mat == 1 ? KF : VF)) + (tg * 16) * KP + c;
#pragma unroll 4
            for (int i = 0; i < 16; ++i) { const int t = t0 + i; const float xp1 = (t + 1 < L) ? bf2f(src[(size_t)(t + 1) * 1536]) : 0.f;
                const float y = w0 * xm2 + w1 * xm1 + w2 * x0 + w3 * xp1; dst[i * KP] = siluf_(y); xm2 = xm1; xm1 = x0; x0 = xp1; }
        }
    }
    if (tid < 128) {
        const int d = tid >> 6, i = lane, r = d ? 63 - i : i;
        const float* ba = BA + (size_t)(rowbase + cl * 64 + r) * 16;
        const float beta = sigmoidf_(ba[d * 4 + h]);
        float gg = -__expf(P.galog[d * 4 + h]) * softplusf_(ba[(2 + d) * 4 + h] + P.gdtb[d * 4 + h]);
#pragma unroll
        for (int o = 1; o < 64; o <<= 1) { const float t = __shfl_up(gg, o); if (lane >= o) gg += t; }
        GS[d * 64 + i] = gg; RB[d * 64 + i] = beta; RBE[d * 64 + i] = beta * __expf(gg);
        ((float*)(P.ws + WS_GC))[((size_t)((d * 4 + b) * 4 + h) * NCH + cn) * 64 + i] = gg;
    }
    __syncthreads();
    {
        bf16_t* QG = (bf16_t*)(P.ws + WS_QG) + ((size_t)((b * 4 + h) * NCH + cn) * 64) * 128;
        bf16_t* KG = (bf16_t*)(P.ws + WS_KG) + ((size_t)((b * 4 + h) * NCH + cn) * 64) * 128;
#pragma unroll
        for (int tt = 0; tt < 8; ++tt) { const int tok = wave * 8 + tt;
            f32x2 q = *(f32x2*)(QF + tok * KP + 2 * lane), k = *(f32x2*)(KF + tok * KP + 2 * lane);
            const float sq = wave_sum(q[0] * q[0] + q[1] * q[1]), sk = wave_sum(k[0] * k[0] + k[1] * k[1]);
            q = q * (rsqrtf(sq + EPS) * 0.08838834764831845f); k = k * rsqrtf(sk + EPS);
            *(f32x2*)(QF + tok * KP + 2 * lane) = q; *(f32x2*)(KF + tok * KP + 2 * lane) = k;
            *(unsigned*)(QG + tok * 128 + 2 * lane) = pk2(q[0], q[1]); *(unsigned*)(KG + tok * 128 + 2 * lane) = pk2(k[0], k[1]); }
    }
    __syncthreads();
    {
        const int tp = tid & 255, ti = tp >> 4, tj = tp & 15; const float* X = (tid < 256) ? KF : QF; float* OUT = (tid < 256) ? KKN : QKN;
        float acc[4][4];
#pragma unroll
        for (int a = 0; a < 4; ++a)
#pragma unroll
            for (int c = 0; c < 4; ++c) acc[a][c] = 0.f;
#pragma unroll 2
        for (int kq = 0; kq < 32; ++kq) {
            f32x4 av[4], bv[4];
#pragma unroll
            for (int a = 0; a < 4; ++a) { av[a] = *(const f32x4*)(X + (ti + 16 * a) * KP + 4 * kq); bv[a] = *(const f32x4*)(KF + (tj + 16 * a) * KP + 4 * kq); }
#pragma unroll
            for (int a = 0; a < 4; ++a)
#pragma unroll
                for (int c = 0; c < 4; ++c) acc[a][c] += (av[a][0] * bv[c][0] + av[a][1] * bv[c][1]) + (av[a][2] * bv[c][2] + av[a][3] * bv[c][3]);
        }
#pragma unroll
        for (int a = 0; a < 4; ++a)
#pragma unroll
            for (int c = 0; c < 4; ++c) OUT[(ti + 16 * a) * 65 + tj + 16 * c] = acc[a][c];
    }
    __syncthreads();
    {
        const int d = tid >> 8, tp = tid & 255;
        bf16_t* ATT = (bf16_t*)(P.ws + WS_ATT) + ((size_t)((d * 4 + b) * 4 + h) * NCH + cn) * 4096;
#pragma unroll 4
        for (int e = 0; e < 16; ++e) { const int idx = tp + 256 * e, i = idx >> 6, j = idx & 63, ri = d ? 63 - i : i, rj = d ? 63 - j : j;
            const float dec = (i >= j) ? __expf(GS[d * 64 + i] - GS[d * 64 + j]) : 0.f;
            AD[d * 4096 + idx] = (i > j) ? RB[d * 64 + i] * KKN[ri * 65 + rj] * dec : 0.f;
            ATT[idx] = (bf16_t)f2bf(QKN[ri * 65 + rj] * dec); }
    }
    __syncthreads();
    {
        const int d = tid >> 8, c = tid & 255;
        const float* src = (c < 128) ? VF + c : KF + (c - 128); const float* scl = ((c < 128) ? RB : RBE) + d * 64;
        bf16_t* dst = (bf16_t*)(P.ws + (c < 128 ? WS_UB : WS_WB)) + ((size_t)((d * 4 + b) * 4 + h) * NCH + cn) * 64 * 128 + (c & 127);
        int sb_ = d ? 63 * KP : 0, ss_ = d ? -KP : KP; asm volatile("" : "+v"(sb_), "+v"(ss_));
        gdn_solve(src, scl, AD + d * 4096, dst, sb_, ss_);
    }
    __syncthreads();
}

__device__ __forceinline__ int chunk_of(int d, int s) { return d ? (s < 4 ? 3 - s : 67 - (s - 4)) : s; }
constexpr int TP = 272, AP = 144;
__device__ __forceinline__ bf16x8 ldfrag(const unsigned char* base, int row, int pitch, int kbyte) { return *(const bf16x8*)(base + row * pitch + kbyte); }
__device__ __forceinline__ void gdn_scan_item(const Ptrs& P, unsigned char* lds, int item, int tid, int lane, int wave) {
    const int chain = item & 31, slice = item >> 5, d = chain >> 4, b = (chain >> 2) & 3, h = chain & 3, e0 = slice * 32;
    unsigned char* Wl = lds; unsigned char* Ql = lds + 17408; unsigned char* Kl = lds + 34816; unsigned char* ATl = lds + 52224;
    unsigned char* St = lds + 61440; unsigned char* Vt = lds + 70144; unsigned char* Vdt = lds + 74752; float* gcs = (float*)(lds + 79360);
    const bf16_t* WBp = (const bf16_t*)(P.ws + WS_WB) + (size_t)((d * 4 + b) * 4 + h) * NCH * 8192;
    const bf16_t* UBp = (const bf16_t*)(P.ws + WS_UB) + (size_t)((d * 4 + b) * 4 + h) * NCH * 8192;
    const bf16_t* ATp = (const bf16_t*)(P.ws + WS_ATT) + (size_t)((d * 4 + b) * 4 + h) * NCH * 4096;
    const float* GCp = (const float*)(P.ws + WS_GC) + (size_t)((d * 4 + b) * 4 + h) * NCH * 64;
    const bf16_t* QGp = (const bf16_t*)(P.ws + WS_QG) + (size_t)(b * 4 + h) * NCH * 8192;
    const bf16_t* KGp = (const bf16_t*)(P.ws + WS_KG) + (size_t)(b * 4 + h) * NCH * 8192;
    bf16_t* Op = (bf16_t*)(P.ws + (d ? WS_OB : WS_OF));
    const int fr = lane & 15, fq = lane >> 4, mt = wave & 3, nt = wave >> 2;
    for (int i = tid; i < 8704 / 4; i += 512) ((unsigned*)St)[i] = 0u;
    f32x4 Sacc[2] = {(f32x4){0.f, 0.f, 0.f, 0.f}, (f32x4){0.f, 0.f, 0.f, 0.f}};
    u32x4 rw[2], rq[2], rk[2], ra; float rg = 0.f;
#define SCAN_PREFETCH(s_) do { const int cn_ = chunk_of(d, s_); \
        const u32x4* w4 = (const u32x4*)(WBp + (size_t)cn_ * 8192); const u32x4* q4 = (const u32x4*)(QGp + (size_t)cn_ * 8192); const u32x4* k4 = (const u32x4*)(KGp + (size_t)cn_ * 8192); \
        rw[0] = w4[tid]; rw[1] = w4[tid + 512]; rq[0] = q4[tid]; rq[1] = q4[tid + 512]; rk[0] = k4[tid]; rk[1] = k4[tid + 512]; \
        ra = ((const u32x4*)(ATp + (size_t)cn_ * 4096))[tid]; if (tid < 64) rg = GCp[cn_ * 64 + tid]; } while (0)
    SCAN_PREFETCH(0);
    for (int s = 0; s < NCH; ++s) {
        const int cn = chunk_of(d, s); const bool lat = cn >= 4;
#pragma unroll
        for (int i = 0; i < 2; ++i) { const int idx = tid + 512 * i, row = idx >> 4, cc = idx & 15;
            *(u32x4*)(Wl + row * TP + cc * 16) = rw[i]; *(u32x4*)(Ql + row * TP + cc * 16) = rq[i]; *(u32x4*)(Kl + row * TP + cc * 16) = rk[i]; }
        *(u32x4*)(ATl + (tid >> 3) * AP + (tid & 7) * 16) = ra;
        if (tid < 64) gcs[tid] = rg;
        __syncthreads();
        if (s + 1 < NCH) SCAN_PREFETCH(s + 1);
        float uv[4];
        { const bf16_t* up = UBp + (size_t)cn * 8192 + (mt * 16 + fq * 4) * 128 + e0 + nt * 16 + fr;
#pragma unroll
          for (int jj = 0; jj < 4; ++jj) uv[jj] = bf2f(up[jj * 128]); }
        const float glast = gcs[63];
        f32x4 acc_a = (f32x4){0.f, 0.f, 0.f, 0.f}, acc_b = (f32x4){0.f, 0.f, 0.f, 0.f};
        { const int qrow = d ? 63 - (mt * 16 + fr) : (mt * 16 + fr);
#pragma unroll
          for (int ks = 0; ks < 4; ++ks) { const bf16x8 bs = ldfrag(St, nt * 16 + fr, TP, ks * 64 + fq * 16);
              const bf16x8 aw = ldfrag(Wl, mt * 16 + fr, TP, ks * 64 + fq * 16);
              acc_a = __builtin_amdgcn_mfma_f32_16x16x32_bf16(aw, bs, acc_a, 0, 0, 0);
              if (lat) { const bf16x8 aq = ldfrag(Ql, qrow, TP, ks * 64 + fq * 16); acc_b = __builtin_amdgcn_mfma_f32_16x16x32_bf16(aq, bs, acc_b, 0, 0, 0); } } }
        { float vn[4], vd[4];
#pragma unroll
          for (int jj = 0; jj < 4; ++jj) { const float gi = gcs[mt * 16 + fq * 4 + jj]; vn[jj] = uv[jj] - acc_a[jj]; vd[jj] = vn[jj] * __expf(glast - gi); acc_b[jj] *= __expf(gi); }
          u32x2 w; w.x = pk2(vn[0], vn[1]); w.y = pk2(vn[2], vn[3]); *(u32x2*)(Vt + (nt * 16 + fr) * AP + (mt * 16 + fq * 4) * 2) = w;
          w.x = pk2(vd[0], vd[1]); w.y = pk2(vd[2], vd[3]); *(u32x2*)(Vdt + (nt * 16 + fr) * AP + (mt * 16 + fq * 4) * 2) = w; }
        __syncthreads();
        if (lat) {
#pragma unroll
            for (int ks = 0; ks < 2; ++ks) { const bf16x8 aa = ldfrag(ATl, mt * 16 + fr, AP, ks * 64 + fq * 16); const bf16x8 bv = ldfrag(Vt, nt * 16 + fr, AP, ks * 64 + fq * 16);
                acc_b = __builtin_amdgcn_mfma_f32_16x16x32_bf16(aa, bv, acc_b, 0, 0, 0); }
            bf16_t* op = Op + (size_t)(b * SEQ + (cn - 4) * 64) * 512 + h * 128 + e0 + nt * 16 + fr;
#pragma unroll
            for (int jj = 0; jj < 4; ++jj) { const int i = mt * 16 + fq * 4 + jj, tok = d ? 63 - i : i; op[(size_t)tok * 512] = (bf16_t)f2bf(acc_b[jj]); }
        }
        { const float eg = __expf(glast);
          bf16x8 ak[2];
#pragma unroll
          for (int ks = 0; ks < 2; ++ks)
#pragma unroll
              for (int jj = 0; jj < 8; ++jj) { const int i = ks * 32 + fq * 8 + jj, row = d ? 63 - i : i; ak[ks][jj] = (short)*(const bf16_t*)(Kl + row * TP + (16 * wave + fr) * 2); }
#pragma unroll
          for (int n2 = 0; n2 < 2; ++n2) { f32x4 a = Sacc[n2] * eg;
#pragma unroll
              for (int ks = 0; ks < 2; ++ks) { const bf16x8 bv = ldfrag(Vdt, n2 * 16 + fr, AP, ks * 64 + fq * 16); a = __builtin_amdgcn_mfma_f32_16x16x32_bf16(ak[ks], bv, a, 0, 0, 0); }
              Sacc[n2] = a;
              u32x2 w; w.x = pk2(a[0], a[1]); w.y = pk2(a[2], a[3]); *(u32x2*)(St + (n2 * 16 + fr) * TP + (16 * wave + fq * 4) * 2) = w; } }
        __syncthreads();
    }
#undef SCAN_PREFETCH
}

template <int MODE>
__device__ __forceinline__ void lru_item(const Ptrs& P, unsigned char* lds, int b, int cn, int nb, int tid, int lane, int wave) {
    const bool isctx = cn < 4; const int cl = isctx ? cn : cn - 4, L = isctx ? CTXL : SEQ, s0 = cl * 64;
    const bf16_t* PB = (const bf16_t*)(P.ws + WS_PB);
    float* xin = (float*)lds;
    float* xT = (float*)(lds + 17408);
    float* wg = (float*)(lds + 34816);
    f32x2* seg = (f32x2*)(lds + 100352);
#define rowof(s_) (isctx ? (size_t)(M_LAT + b * CTXL + (s_)) : (size_t)(b * SEQ + ((s_) & 63) * 64 + ((s_) >> 6)))
    for (int idx = tid; idx < 67 * 64; idx += 512) { const int si = idx >> 6, c = idx & 63, s = s0 - 2 + si;
        xin[idx] = (s >= 0 && s < L) ? bf2f(PB[rowof(s) * 1536 + 512 + nb * 64 + c]) : 0.f; }
    for (int idx = tid; idx < 4 * 4096; idx += 512) { const int dg = idx >> 12; wg[idx] = P.lwg[((size_t)dg * 8 + nb) * 4096 + (idx & 4095)]; }
    __syncthreads();
    { const int c = tid & 63, ig = tid >> 6, ch = nb * 64 + c;
      const float w0 = P.lconv[ch], w1 = P.lconv[512 + ch], w2 = P.lconv[1024 + ch], w3 = P.lconv[1536 + ch], bias = P.lconvb[ch];
#pragma unroll
      for (int ii = 0; ii < 8; ++ii) { const int i = ig * 8 + ii; xT[c * 68 + i] = bias + w0 * xin[i * 64 + c] + w1 * xin[(i + 1) * 64 + c] + w2 * xin[(i + 2) * 64 + c] + w3 * xin[(i + 3) * 64 + c]; } }
    __syncthreads();
    const int co = tid & 63, ig = tid >> 6, ch = nb * 64 + co;
    float acc[4][8];
#pragma unroll
    for (int q = 0; q < 4; ++q)
#pragma unroll
        for (int ii = 0; ii < 8; ++ii) acc[q][ii] = 0.f;
#pragma unroll 4
    for (int ci = 0; ci < 64; ++ci) { const f32x4 xa = *(const f32x4*)(xT + ci * 68 + ig * 8), xb = *(const f32x4*)(xT + ci * 68 + ig * 8 + 4);
        float wv[4];
#pragma unroll
        for (int q = 0; q < 4; ++q) wv[q] = wg[q * 4096 + ci * 64 + co];
#pragma unroll
        for (int q = 0; q < 4; ++q) {
#pragma unroll
            for (int ii = 0; ii < 4; ++ii) { acc[q][ii] += wv[q] * xa[ii]; acc[q][ii + 4] += wv[q] * xb[ii]; } } }
    float av[2][8], bv[2][8];
#pragma unroll
    for (int d = 0; d < 2; ++d) { const float bgr = P.lbg[(d * 2 + 0) * 512 + ch], bgi = P.lbg[(d * 2 + 1) * 512 + ch], sp = softplusf_(-P.llam[d * 512 + ch]);
#pragma unroll
        for (int ii = 0; ii < 8; ++ii) { const int i = ig * 8 + ii; const float xv = xT[co * 68 + i];
            const float r = sigmoidf_(acc[d * 2][ii] + bgr), ing = sigmoidf_(acc[d * 2 + 1][ii] + bgi), la = -8.f * sp * r;
            float mult = sqrtf(-expm1f(2.f * la));
            if (isctx && ((d == 0 && cn == 0 && i == 0) || (d == 1 && cn == 3 && i == 63))) mult = 1.f;
            av[d][ii] = __expf(la); bv[d][ii] = mult * ing * xv; } }
    { float A0 = 1.f, B0 = 0.f, A1 = 1.f, B1 = 0.f;
#pragma unroll
      for (int ii = 0; ii < 8; ++ii) { B0 = av[0][ii] * B0 + bv[0][ii]; A0 *= av[0][ii]; B1 = av[1][7 - ii] * B1 + bv[1][7 - ii]; A1 *= av[1][7 - ii]; }
      seg[(ig * 2 + 0) * 64 + co] = (f32x2){A0, B0}; seg[(ig * 2 + 1) * 64 + co] = (f32x2){A1, B1}; }
    __syncthreads();
    if constexpr (MODE == 0) {
        if (tid < 128) { const int d = tid >> 6; float At = 1.f, Bt = 0.f;
#pragma unroll
            for (int k = 0; k < 8; ++k) { const int sg = d ? 7 - k : k; const f32x2 v = seg[(sg * 2 + d) * 64 + co]; Bt = v[0] * Bt + v[1]; At *= v[0]; }
            ((f32x2*)(P.ws + WS_LSUM))[((size_t)(b * 2 + d) * NCH + cn) * 512 + ch] = (f32x2){At, Bt}; }
    } else {
        const float* CAR = (const float*)(P.ws + WS_LCAR);
        float hf = CAR[((size_t)(b * 2 + 0) * NCH + cn) * 512 + ch], hb = CAR[((size_t)(b * 2 + 1) * NCH + cn) * 512 + ch];
        for (int k = 0; k < ig; ++k) { const f32x2 v = seg[(k * 2 + 0) * 64 + co]; hf = v[0] * hf + v[1]; }
        for (int k = 7; k > ig; --k) { const f32x2 v = seg[(k * 2 + 1) * 64 + co]; hb = v[0] * hb + v[1]; }
        float o[8];
#pragma unroll
        for (int ii = 0; ii < 8; ++ii) { hf = av[0][ii] * hf + bv[0][ii]; o[ii] = hf; }
#pragma unroll
        for (int ii = 7; ii >= 0; --ii) { hb = av[1][ii] * hb + bv[1][ii]; o[ii] += hb; }
        bf16_t* MIX = (bf16_t*)(P.ws + WS_MIX);
#pragma unroll
        for (int ii = 0; ii < 8; ++ii) { const size_t row = rowof(s0 + ig * 8 + ii); const float gt = bf2f(PB[row * 1536 + 1024 + ch]);
            MIX[row * D + 512 + ch] = (bf16_t)f2bf(o[ii] * geluf_(gt)); }
    }
    __syncthreads();
#undef rowof
}
__device__ __forceinline__ void lru_carry(const Ptrs& P, int gt) {
    const int b = gt >> 10, d = (gt >> 9) & 1, ch = gt & 511;
    const f32x2* SUM = (const f32x2*)(P.ws + WS_LSUM) + (size_t)(b * 2 + d) * NCH * 512 + ch; float* CAR = (float*)(P.ws + WS_LCAR) + (size_t)(b * 2 + d) * NCH * 512 + ch;
    float carry = 0.f;
    for (int s0 = 0; s0 < NCH; s0 += 17) {
        f32x2 v[17];
#pragma unroll
        for (int k = 0; k < 17; ++k) v[k] = SUM[(size_t)chunk_of(d, s0 + k) * 512];
#pragma unroll
        for (int k = 0; k < 17; ++k) { CAR[(size_t)chunk_of(d, s0 + k) * 512] = carry; carry = v[k][0] * carry + v[k][1]; }
    }
}

__device__ __forceinline__ void gdn_combine(const Ptrs& P, int gw, int NGW, int lane) {
    const bf16_t* OF = (const bf16_t*)(P.ws + WS_OF); const bf16_t* OB = (const bf16_t*)(P.ws + WS_OB); const bf16_t* PB = (const bf16_t*)(P.ws + WS_PB); bf16_t* MIX = (bf16_t*)(P.ws + WS_MIX);
    float nw[8];
#pragma unroll
    for (int j = 0; j < 8; ++j) nw[j] = P.gnormw[(lane * 8 + j) & 127];
    for (int m = gw; m < M_LAT; m += NGW) {
        const u32x4 a = *(const u32x4*)(OF + (size_t)m * 512 + lane * 8), c = *(const u32x4*)(OB + (size_t)m * 512 + lane * 8), z = *(const u32x4*)(PB + (size_t)m * 1536 + lane * 8);
        float o[8], zz[8]; float ss = 0.f;
#pragma unroll
        for (int j = 0; j < 4; ++j) { o[2 * j] = bf2f(a[j] & 0xffffu) + bf2f(c[j] & 0xffffu); o[2 * j + 1] = bf2f(a[j] >> 16) + bf2f(c[j] >> 16); zz[2 * j] = bf2f(z[j] & 0xffffu); zz[2 * j + 1] = bf2f(z[j] >> 16); }
#pragma unroll
        for (int j = 0; j < 8; ++j) ss += o[j] * o[j];
        ss += __shfl_xor(ss, 1); ss += __shfl_xor(ss, 2); ss += __shfl_xor(ss, 4); ss += __shfl_xor(ss, 8);
        const float rs = rsqrtf(ss * (1.f / 128.f) + EPS);
        u32x4 w;
        w.x = pk2(o[0] * rs * nw[0] * siluf_(zz[0]), o[1] * rs * nw[1] * siluf_(zz[1])); w.y = pk2(o[2] * rs * nw[2] * siluf_(zz[2]), o[3] * rs * nw[3] * siluf_(zz[3]));
        w.z = pk2(o[4] * rs * nw[4] * siluf_(zz[4]), o[5] * rs * nw[5] * siluf_(zz[5])); w.w = pk2(o[6] * rs * nw[6] * siluf_(zz[6]), o[7] * rs * nw[7] * siluf_(zz[7]));
        *(u32x4*)(MIX + (size_t)m * D + lane * 8) = w;
    }
}

#define RLX_AGENT __ATOMIC_RELAXED, __HIP_MEMORY_SCOPE_AGENT
#define XB_TMO      128
#define XB_XCNT(j)  (256  + 64 * (j))
#define XB_XSUB(j)  (1280 + 64 * (j))
#define XB_XGEN(j)  (2304 + 64 * (j))
#define XB_TOP      3328
#define XB_TOPGEN   3392
#define XCD_BAR_WORDS 3456
#define XB_SPIN_CAP (1u << 18)

__device__ __forceinline__ unsigned xb_ld(unsigned* p)              { return __hip_atomic_load(p, __ATOMIC_RELAXED, __HIP_MEMORY_SCOPE_AGENT); }
__device__ __forceinline__ unsigned xb_add(unsigned* p, unsigned v) { return __hip_atomic_fetch_add(p, v, __ATOMIC_RELAXED, __HIP_MEMORY_SCOPE_AGENT); }
__device__ __forceinline__ unsigned xb_xcc_id() { return (unsigned)__builtin_amdgcn_s_getreg((3 << 11) | 20) & 0xFu; }
#define XB_SPIN(cond, bar) do { unsigned _sp = 0; while (cond) { __builtin_amdgcn_s_sleep(1); \
    if ((++_sp & 255u) == 0u) { if (xb_ld(&(bar)[XB_TMO])) break; if (_sp > XB_SPIN_CAP) { atomicAdd(&(bar)[XB_TMO], 1u); break; } } } } while (0)

struct XcdBarrier {
    unsigned* bar; unsigned x;
    volatile LAS unsigned* st;
};

__device__ __forceinline__ XcdBarrier xcd_barrier_post(unsigned* bar, volatile LAS unsigned* st) {
    XcdBarrier b; b.bar = bar; b.x = xb_xcc_id(); b.st = st;
    if (threadIdx.x == 0) (void)xb_add(&bar[XB_XCNT(b.x)], 1u);
    return b;
}
__device__ __forceinline__ void xcd_barrier_complete(unsigned* bar, unsigned x, unsigned& nloc, unsigned& nx) {
    const unsigned G = gridDim.x * gridDim.y * gridDim.z;
    unsigned sum, cnt, mine, sp = 0u;
    for (;;) {
        sum = 0u; cnt = 0u; mine = 0u;
#pragma unroll
        for (unsigned j = 0; j < 16; ++j) { const unsigned c = xb_ld(&bar[XB_XCNT(j)]); sum += c; cnt += (c > 0u) ? 1u : 0u; mine = (j == x) ? c : mine; }
        if (sum == G) break;
        __builtin_amdgcn_s_sleep(1);
        if ((++sp & 255u) == 0u) { if (xb_ld(&bar[XB_TMO])) break; if (sp > XB_SPIN_CAP) { atomicAdd(&bar[XB_TMO], 1u); break; } }
    }
    nloc = mine > 0u ? mine : 1u; nx = cnt > 0u ? cnt : 1u;
}

__device__ __forceinline__ void xcd_barrier(const XcdBarrier& b) {
    asm volatile("s_waitcnt vmcnt(0)" ::: "memory");
    __syncthreads();
    if (threadIdx.x == 0) {
        unsigned* bar = b.bar;
        __builtin_amdgcn_s_waitcnt(0);
        unsigned nloc = b.st[0], nx = b.st[1];
        if (nloc == 0u) { xcd_barrier_complete(bar, b.x, nloc, nx); b.st[0] = nloc; b.st[1] = nx; }
        const unsigned old = xb_add(&bar[XB_XSUB(b.x)], 1u);
        const unsigned gen = old / nloc;
        if (old + 1u == (gen + 1u) * nloc) {
            __builtin_amdgcn_fence(__ATOMIC_RELEASE, "agent");
            asm volatile("s_waitcnt vmcnt(0)" ::: "memory");
            const unsigned og = xb_add(&bar[XB_TOP], 1u);
            const unsigned tg = og / nx;
            if (og + 1u == (tg + 1u) * nx) xb_add(&bar[XB_TOPGEN], 1u);
            else XB_SPIN(xb_ld(&bar[XB_TOPGEN]) == tg, bar);
            __builtin_amdgcn_fence(__ATOMIC_ACQUIRE, "agent");
            xb_add(&bar[XB_XGEN(b.x)], 1u);
            asm volatile("s_waitcnt vmcnt(0)" ::: "memory");
        } else {
            XB_SPIN(xb_ld(&bar[XB_XGEN(b.x)]) == gen, bar);
            __builtin_amdgcn_fence(__ATOMIC_ACQUIRE, "agent");
            asm volatile("s_waitcnt vmcnt(0)" ::: "memory");
        }
    }
    __syncthreads();
}


struct Args { const float* in[22]; float* out; unsigned char* ws; int ph_lo, ph_hi; };
constexpr int N_PHASES = 14;

__global__ void __launch_bounds__(512, 2) fwd_kernel(Args args) {
    extern __shared__ __attribute__((aligned(16))) unsigned char lds[];
    const int tid = threadIdx.x, lane = tid & 63, wave = __builtin_amdgcn_readfirstlane(tid >> 6);
    const int G = gridDim.x, bid = blockIdx.x, gw = bid * 8 + wave, NGW = G * 8;
    Ptrs P;
    P.x = args.in[0]; P.c = args.in[1]; P.ctx = args.in[2]; P.cctx = args.in[3]; P.w_ada = args.in[4]; P.b_ada = args.in[5]; P.norm_g = args.in[6];
    P.w1 = args.in[7]; P.w3 = args.in[8]; P.w2 = args.in[9]; P.w_in = args.in[10]; P.w_out = args.in[11]; P.gconv = args.in[12]; P.galog = args.in[13]; P.gdtb = args.in[14];
    P.gnormw = args.in[15]; P.lconv = args.in[16]; P.lconvb = args.in[17]; P.lwg = args.in[18]; P.lbg = args.in[19]; P.llam = args.in[20]; P.fng = args.in[21];
    P.out = args.out; P.ws = args.ws;
    unsigned char* ws = args.ws;
    const float* mods = (const float*)(ws + WS_MODS);
    bf16_t* U = (bf16_t*)(ws + WS_U); bf16_t* HID = (bf16_t*)(ws + WS_HID); float* H1CTX = (float*)(ws + WS_H1CTX);
    LAS unsigned char* ldsl = (LAS unsigned char*)lds;
    const int lo = args.ph_lo, hi = args.ph_hi;
#ifndef REP_MASK
#define REP_MASK 0
#endif
#ifndef SKIP_MASK
#define SKIP_MASK 0
#endif
#define IN(k) (!((SKIP_MASK >> (k)) & 1) && lo <= (k) && (k) < hi)
#define SEAM(k) do { if (IN(k) && IN((k) + 1)) { if ((k) == 0) cg::this_grid().sync(); else xcd_barrier(bar); } } while (0)
    volatile LAS unsigned* MISC = (volatile LAS unsigned*)(ldsl + LDS_BYTES - 64);
    if (tid == 0) { MISC[0] = 0u; MISC[1] = 0u; }
    __syncthreads();
    XcdBarrier bar = xcd_barrier_post((unsigned*)ws + 4096, MISC);

    if (IN(0)) for (int rep_ = 0; rep_ < 1 + ((REP_MASK >> 0) & 1); ++rep_) { if (rep_) __syncthreads(); phase_prologue(P, lds, tid, lane, wave, bid, G); } SEAM(0);
    if (IN(1)) for (int rep_ = 0; rep_ < 1 + ((REP_MASK >> 1) & 1); ++rep_) { if (rep_) __syncthreads(); phase_norm_mod(P.x, P.ctx, M_TOT, P.norm_g, mods, 0, 1, U, gw, NGW, lane); } SEAM(1);
    if (IN(2)) for (int rep_ = 0; rep_ < 1 + ((REP_MASK >> 2) & 1); ++rep_) { if (rep_) __syncthreads(); pg8::Gemm g{U, (const bf16_t*)(ws + WS_W1A), M_TOT, 2 * FF, D}; pg8::StaticOrder S; S.init(M_TOT, 2 * FF, G, bid); pg8::EpiSwiglu E{HID};
        pg8::gemm_phase<pg8::EpiSwiglu, true>(ldsl, g, S, E); } SEAM(2);
    if (IN(3)) for (int rep_ = 0; rep_ < 1 + ((REP_MASK >> 3) & 1); ++rep_) { if (rep_) __syncthreads(); pg8::Gemm g{HID, (const bf16_t*)(ws + WS_W2A), M_TOT, D, FF}; pg8::StaticOrder S; S.init(M_TOT, D, G, bid);
        pg8::EpiRes E{P.x, P.ctx, P.out, H1CTX, mods + 2 * D, 0.5f}; pg8::gemm_phase<pg8::EpiRes, true>(ldsl, g, S, E); } SEAM(3);
    if (IN(4)) for (int rep_ = 0; rep_ < 1 + ((REP_MASK >> 4) & 1); ++rep_) { if (rep_) __syncthreads(); phase_norm_mod(P.out, H1CTX, M_TOT, P.norm_g + D, mods, 3, 4, U, gw, NGW, lane); } SEAM(4);
    if (IN(5)) for (int rep_ = 0; rep_ < 1 + ((REP_MASK >> 5) & 1); ++rep_) { if (rep_) __syncthreads(); pg8::Gemm g{U, (const bf16_t*)(ws + WS_WIN), M_TOT, NIN, D}; pg8::StaticOrder S; S.init(M_TOT, NIN, G, bid);
        pg8::EpiIn E{(bf16_t*)(ws + WS_PA), (bf16_t*)(ws + WS_PB), (float*)(ws + WS_BA)}; pg8::gemm_phase<pg8::EpiIn, true>(ldsl, g, S, E); } SEAM(5);
    if (IN(6)) for (int rep_ = 0; rep_ < 1 + ((REP_MASK >> 6) & 1); ++rep_) { if (rep_) __syncthreads();
        for (int it = bid; it < NB * 4 * NCH; it += G) gdn_prep_item(P, lds, it, tid, lane, wave);
        for (int it = bid; it < NB * NCH * 8; it += G) { const int b = it / (NCH * 8), cn = (it / 8) % NCH, nb = it & 7; lru_item<0>(P, lds, b, cn, nb, tid, lane, wave); }
    } SEAM(6);
    if (IN(7)) for (int rep_ = 0; rep_ < 1 + ((REP_MASK >> 7) & 1); ++rep_) { if (rep_) __syncthreads();
        for (int j = 0; j < 8; ++j) if ((G - 1 - j) % G == bid) lru_carry(P, j * 512 + tid);
        for (int it = bid; it < 128; it += G) { gdn_scan_item(P, lds, it, tid, lane, wave); __syncthreads(); }
    } SEAM(7);
    if (IN(8)) for (int rep_ = 0; rep_ < 1 + ((REP_MASK >> 8) & 1); ++rep_) { if (rep_) __syncthreads();
        gdn_combine(P, gw, NGW, lane);
        for (int it = bid; it < NB * 64 * 8; it += G) { const int b = it / 512, cn = 4 + ((it >> 3) & 63), nb = it & 7; lru_item<1>(P, lds, b, cn, nb, tid, lane, wave); }
    } SEAM(8);
    if (IN(9)) for (int rep_ = 0; rep_ < 1 + ((REP_MASK >> 9) & 1); ++rep_) { if (rep_) __syncthreads(); pg8::Gemm g{(const bf16_t*)(ws + WS_MIX), (const bf16_t*)(ws + WS_WOUT), M_LAT, D, D}; pg8::StaticOrder S; S.init(M_LAT, D, G, bid);
        pg8::EpiRes E{P.out, P.out, P.out, P.out, mods + 5 * D, 1.0f}; pg8::gemm_phase<pg8::EpiRes, true>(ldsl, g, S, E); } SEAM(9);
    if (IN(10)) for (int rep_ = 0; rep_ < 1 + ((REP_MASK >> 10) & 1); ++rep_) { if (rep_) __syncthreads(); phase_norm_mod(P.out, P.out, M_LAT, P.norm_g + 2 * D, mods, 6, 7, U, gw, NGW, lane); } SEAM(10);
    if (IN(11)) for (int rep_ = 0; rep_ < 1 + ((REP_MASK >> 11) & 1); ++rep_) { if (rep_) __syncthreads(); pg8::Gemm g{U, (const bf16_t*)(ws + WS_W1B), M_LAT, 2 * FF, D}; pg8::StaticOrder S; S.init(M_LAT, 2 * FF, G, bid); pg8::EpiSwiglu E{HID};
        pg8::gemm_phase<pg8::EpiSwiglu, true>(ldsl, g, S, E); } SEAM(11);
    if (IN(12)) for (int rep_ = 0; rep_ < 1 + ((REP_MASK >> 12) & 1); ++rep_) { if (rep_) __syncthreads(); pg8::Gemm g{HID, (const bf16_t*)(ws + WS_W2B), M_LAT, D, FF}; pg8::StaticOrder S; S.init(M_LAT, D, G, bid);
        pg8::EpiRes E{P.out, P.out, P.out, P.out, mods + 8 * D, 0.5f}; pg8::gemm_phase<pg8::EpiRes, true>(ldsl, g, S, E); } SEAM(12);
    if (IN(13)) for (int rep_ = 0; rep_ < 1 + ((REP_MASK >> 13) & 1); ++rep_) { if (rep_) __syncthreads();
        for (int m = gw; m < M_LAT; m += NGW) { float* row = P.out + (size_t)m * D; f32x4 v[4]; float ss = 0.f;
#pragma unroll
            for (int j = 0; j < 4; ++j) { v[j] = *(const f32x4*)(row + 4 * lane + 256 * j); ss += (v[j][0] * v[j][0] + v[j][1] * v[j][1]) + (v[j][2] * v[j][2] + v[j][3] * v[j][3]); }
            const float rstd = rsqrtf(wave_sum(ss) * (1.f / D) + EPS);
#pragma unroll
            for (int j = 0; j < 4; ++j) { const f32x4 gv = *(const f32x4*)(P.fng + 4 * lane + 256 * j); *(f32x4*)(row + 4 * lane + 256 * j) = v[j] * rstd * gv; } }
    }
#undef IN
#undef SEAM
}

extern "C" void kernel_launch(void* const* d_in, const int* in_sizes, int n_in, void* d_out, int out_size, void* d_ws, size_t ws_size, hipStream_t stream) {
    static int grid = 0;
    if (grid == 0) {
        if (n_in != 22 || out_size != M_LAT * D || ws_size < WS_END) { fprintf(stderr, "kernel_launch: unexpected shapes (n_in %d, out %d, ws %zu)\n", n_in, out_size, ws_size); grid = -1; return; }
        int dev = 0, cus = 0, per_cu = 0;
        hipGetDevice(&dev); hipDeviceGetAttribute(&cus, hipDeviceAttributeMultiprocessorCount, dev);
        if (hipFuncSetAttribute((const void*)fwd_kernel, hipFuncAttributeMaxDynamicSharedMemorySize, LDS_BYTES) != hipSuccess) { fprintf(stderr, "kernel_launch: hipFuncSetAttribute failed\n"); grid = -1; return; }
        if (hipOccupancyMaxActiveBlocksPerMultiprocessor(&per_cu, (const void*)fwd_kernel, 512, LDS_BYTES) != hipSuccess || per_cu < 1) { fprintf(stderr, "kernel_launch: occupancy query gives %d\n", per_cu); per_cu = 1; }
        (void)hipGetLastError();
        grid = cus;
        fprintf(stderr, "kernel_launch: grid %d (cus %d, per_cu %d)\n", grid, cus, per_cu);
    }
    if (grid < 0) return;
    Args a{};
    for (int i = 0; i < 22; ++i) a.in[i] = (const float*)d_in[i];
    a.out = (float*)d_out; a.ws = (unsigned char*)d_ws;
    if (hipMemsetAsync(d_ws, 0, 65536, stream) != hipSuccess) { fprintf(stderr, "kernel_launch: memset failed\n"); return; }
#if ONE_LAUNCH
    a.ph_lo = 0; a.ph_hi = N_PHASES;
    void* kargs[] = {&a};
    hipError_t e = hipLaunchCooperativeKernel((const void*)fwd_kernel, dim3(grid), dim3(512), kargs, LDS_BYTES, stream);
    if (e != hipSuccess) fprintf(stderr, "kernel_launch: cooperative launch failed: %s\n", hipGetErrorString(e));
#else
    for (int p = 0; p < N_PHASES; ++p) { a.ph_lo = p; a.ph_hi = p + 1; hipLaunchKernelGGL(fwd_kernel, dim3(grid), dim3(512), LDS_BYTES, stream, a); }
#endif
}
```

```cpp
#include <hip/hip_runtime.h>
#include <hip/hip_cooperative_groups.h>
#include <cstdio>
#include <cstdint>
namespace cg = cooperative_groups;

#ifndef ONE_LAUNCH
#define ONE_LAUNCH 1
#endif

#define LAS __attribute__((address_space(3)))
typedef unsigned short bf16_t;
typedef short bf16x8 __attribute__((ext_vector_type(8)));
typedef float f32x4 __attribute__((ext_vector_type(4)));
typedef float f32x2 __attribute__((ext_vector_type(2)));
typedef unsigned u32x4 __attribute__((ext_vector_type(4)));
typedef unsigned u32x2 __attribute__((ext_vector_type(2)));

constexpr int D = 1024, NB = 4, SEQ = 4096, CTXL = 256, FF = 2816;
constexpr int M_LAT = NB * SEQ, M_CTX = NB * CTXL, M_TOT = M_LAT + M_CTX;
constexpr int NMOD = 9 * D;
constexpr int IN_COLS = 3088, NIN = 3328;
constexpr int NCH = 68;
constexpr float EPS = 1e-6f;

constexpr size_t MiB = 1u << 20;
constexpr size_t WS_MODS = 1 * MiB, WS_BA = 2 * MiB, WS_GC = 4 * MiB, WS_LSUM = 5 * MiB, WS_LCAR = 7 * MiB + MiB / 2;
constexpr size_t WS_WOUT = 10 * MiB, WS_W1B = 12 * MiB, WS_W2B = 23 * MiB;
constexpr size_t WS_PA = 29 * MiB, WS_PB = 80 * MiB, WS_HID = 29 * MiB, WS_OF = 29 * MiB, WS_OB = 45 * MiB;
constexpr size_t WS_U = 131 * MiB, WS_W1A = 165 * MiB, WS_W2A = 176 * MiB, WS_WIN = 182 * MiB, WS_H1CTX = 189 * MiB;
constexpr size_t WS_QG = 131 * MiB, WS_KG = 148 * MiB, WS_WB = 165 * MiB, WS_UB = 199 * MiB, WS_ATT = 233 * MiB, WS_MIX = 131 * MiB;
constexpr size_t WS_END = 256 * MiB;
constexpr int LDS_BYTES = 147456;

__device__ __forceinline__ unsigned f2bf(float f) { unsigned u = __builtin_bit_cast(unsigned, f); return (u + 0x7fffu + ((u >> 16) & 1u)) >> 16; }
__device__ __forceinline__ unsigned pk2(float lo, float hi) { return f2bf(lo) | (f2bf(hi) << 16); }
__device__ __forceinline__ float bf2f(unsigned h) { return __builtin_bit_cast(float, h << 16); }
__device__ __forceinline__ float wave_sum(float v) {
#pragma unroll
    for (int o = 1; o < 64; o <<= 1) v += __shfl_xor(v, o);
    return v;
}
__device__ __forceinline__ float sigmoidf_(float x) { return 1.f / (1.f + __expf(-x)); }
__device__ __forceinline__ float siluf_(float x) { return x / (1.f + __expf(-x)); }
__device__ __forceinline__ float softplusf_(float x) { return x > 20.f ? x : log1pf(__expf(x)); }
__device__ __forceinline__ float geluf_(float x) { const float t = 0.7978845608f * (x + 0.044715f * x * x * x); return 0.5f * x * (1.f + tanhf(t)); }
#define LDS_WAIT() asm volatile("s_waitcnt lgkmcnt(0)" ::: "memory")

namespace pg8 {
constexpr int BM = 256, BK = 64, HALF = 128, HTB = HALF * BK * 2, NXCD = 8, WGM = 8;
__host__ __device__ __forceinline__ int lds_byte(int r, int c) { const int st = (r >> 4) * 2 + (c >> 5), rr = r & 15, cc = c & 31, ob = rr * 64 + cc * 2; return st * 1024 + (ob ^ (((ob >> 9) & 1) << 5)); }
__host__ __device__ __forceinline__ void stage_rc(int b, int& R, int& C) { const int st = b / 1024, sb = b % 1024, swz = sb ^ (((sb >> 9) & 1) << 5); R = (st >> 1) * 16 + swz / 64; C = (st & 1) * 32 + (swz % 64) / 2; }
struct Unit { int pm, pn; };
struct Gemm { const bf16_t* A; const bf16_t* Bt; int M, N, K; };
struct StaticOrder {
    int nM, nN, nwg, G, c;
    __device__ void init(int M, int N, int G_, int c_) { nM = M / BM; nN = N / BM; nwg = nM * nN; G = G_; c = c_; }
    __device__ bool next(int i, Unit& u) const {
        const long L = (long)i * G + c; if (L >= nwg) return false;
        int wgid = (int)L; { const int q = nwg / NXCD, r = nwg % NXCD, xcd = wgid % NXCD, off = wgid / NXCD; wgid = (xcd < r ? xcd * (q + 1) : r * (q + 1) + (xcd - r) * q) + off; }
        const int nig = WGM * nN, gid = wgid / nig, fm = gid * WGM, gsz = (nM - fm) < WGM ? (nM - fm) : WGM;
        u.pm = fm + ((wgid % nig) % gsz); u.pn = (wgid % nig) / gsz; return true;
    }
};
template <class Epi, bool ALIGN_EPI>
__device__ __forceinline__ void gemm_phase(LAS unsigned char* lds, const Gemm g, const StaticOrder& S, const Epi& E) {
    const int tid = threadIdx.x, wid = __builtin_amdgcn_readfirstlane(tid >> 6), lane = tid & 63, wr = wid >> 2, wc = wid & 3, fr = lane & 15, fq = lane >> 4;
    const int K = g.K, nt = K / BK;
    unsigned voffA[2];
#pragma unroll
    for (int i = 0; i < 2; ++i) { int R, C; stage_rc(tid * 16 + i * 8192, R, C); voffA[i] = (unsigned)(R * K + C) * 2u; }
    const size_t kstep = (size_t)(BK * 2);
    const size_t hstep = (size_t)HALF * K * 2;
    const size_t tstep = 2 * hstep;
    const unsigned ldsw = (unsigned)wid * 1024u;
    const int aoff = lds_byte(wr * 64 + fr, fq * 8), boff = lds_byte(wc * 32 + fr, fq * 8);
#define PG8_SA(b, h) (((b) * 2 + (h)) * HTB)
#define PG8_SB(b, h) ((4 + (b) * 2 + (h)) * HTB)
#define PG8_STAGE(bufoff, gbase, voff) do { _Pragma("unroll") for (int _i = 0; _i < 2; ++_i) \
        __builtin_amdgcn_global_load_lds((const unsigned*)((const char*)(gbase) + (voff)[_i]), (LAS unsigned*)(lds + (bufoff) + ldsw + _i * 8192), 16, 0, 0); } while (0)
#define PG8_LDA(dst, b, h) do { _Pragma("unroll") for (int m = 0; m < 4; ++m) _Pragma("unroll") for (int k = 0; k < 2; ++k) dst[m][k] = *(const LAS bf16x8*)(lds + PG8_SA(b, h) + aoff + m * 2048 + k * 1024); } while (0)
#define PG8_LDB(dst, b, h) do { _Pragma("unroll") for (int n = 0; n < 2; ++n) _Pragma("unroll") for (int k = 0; k < 2; ++k) dst[n][k] = *(const LAS bf16x8*)(lds + PG8_SB(b, h) + boff + n * 2048 + k * 1024); } while (0)
#define PG8_MMA(ai, bj, At, Bt) do { __builtin_amdgcn_s_setprio(1); _Pragma("unroll") for (int m = 0; m < 4; ++m) _Pragma("unroll") for (int n = 0; n < 2; ++n) _Pragma("unroll") for (int k = 0; k < 2; ++k) \
        acc[ai][bj][m][n] = __builtin_amdgcn_mfma_f32_16x16x32_bf16(Bt[n][k], At[m][k], acc[ai][bj][m][n], 0, 0, 0); __builtin_amdgcn_s_setprio(0); } while (0)
#define PG8_WAIT_V(n) asm volatile("s_waitcnt vmcnt(" #n ")" ::: "memory")
#define PG8_WAIT_L(n) asm volatile("s_waitcnt lgkmcnt(" #n ")" ::: "memory")
#define PG8_BAR __builtin_amdgcn_s_barrier()
#define PG8_SCHED __builtin_amdgcn_sched_barrier(0)
    Unit cur, nxt; int ui = 0;
    if (!S.next(0, cur)) return;
    f32x4 acc[2][2][4][2];
#pragma unroll
    for (int a = 0; a < 2; ++a)
#pragma unroll
        for (int b = 0; b < 2; ++b)
#pragma unroll
            for (int m = 0; m < 4; ++m)
#pragma unroll
                for (int n = 0; n < 2; ++n) acc[a][b][m][n] = (f32x4){0.f, 0.f, 0.f, 0.f};
    bf16x8 At[4][2], B0[2][2], B1[2][2];
    const char* cA = (const char*)g.A + (size_t)cur.pm * tstep; const char* cB = (const char*)g.Bt + (size_t)cur.pn * tstep;
    PG8_STAGE(PG8_SB(0, 0), cB, voffA); PG8_STAGE(PG8_SB(0, 1), cB + hstep, voffA); PG8_STAGE(PG8_SA(0, 0), cA, voffA); PG8_STAGE(PG8_SA(0, 1), cA + hstep, voffA);
    if (wr == 1) PG8_BAR;
    PG8_WAIT_V(2); PG8_BAR;
    PG8_STAGE(PG8_SB(1, 0), cB + kstep, voffA); PG8_STAGE(PG8_SA(1, 0), cA + kstep, voffA); PG8_STAGE(PG8_SB(1, 1), cB + hstep + kstep, voffA);
    PG8_WAIT_V(6); PG8_BAR;
    for (;;) {
        const bool has_next = S.next(ui + 1, nxt);
        const char* nA = has_next ? (const char*)g.A + (size_t)nxt.pm * tstep : cA; const char* nB = has_next ? (const char*)g.Bt + (size_t)nxt.pn * tstep : cB;
        for (int t = 0; t < nt; t += 2) {
            const bool last = (t == nt - 2);
            const char* a1 = cA + (size_t)(t + 1) * kstep;
            const char* a2 = last ? nA : cA + (size_t)(t + 2) * kstep; const char* b2 = last ? nB : cB + (size_t)(t + 2) * kstep;
            const char* a3 = a2 + kstep; const char* b3 = b2 + kstep;
            PG8_LDB(B0, 0, 0); PG8_LDB(B1, 0, 1); PG8_SCHED; PG8_LDA(At, 0, 0); PG8_STAGE(PG8_SA(1, 1), a1 + hstep, voffA);
            PG8_WAIT_V(8); PG8_WAIT_L(0); PG8_BAR; PG8_MMA(0, 0, At, B0); PG8_MMA(0, 1, At, B1); PG8_BAR; PG8_SCHED;
            PG8_LDA(At, 0, 1); PG8_STAGE(PG8_SB(0, 0), b2, voffA); PG8_STAGE(PG8_SB(0, 1), b2 + hstep, voffA); PG8_STAGE(PG8_SA(0, 0), a2, voffA);
            PG8_WAIT_V(8); PG8_WAIT_L(0); PG8_BAR; PG8_MMA(1, 0, At, B0); PG8_MMA(1, 1, At, B1); PG8_BAR; PG8_SCHED;
            PG8_LDB(B0, 1, 0); PG8_LDB(B1, 1, 1); PG8_SCHED; PG8_LDA(At, 1, 0); PG8_STAGE(PG8_SA(0, 1), a2 + hstep, voffA);
            PG8_WAIT_V(8); PG8_WAIT_L(0); PG8_BAR; PG8_MMA(0, 0, At, B0); PG8_MMA(0, 1, At, B1); PG8_BAR; PG8_SCHED;
            PG8_LDA(At, 1, 1); PG8_STAGE(PG8_SB(1, 0), b3, voffA); PG8_STAGE(PG8_SB(1, 1), b3 + hstep, voffA); PG8_STAGE(PG8_SA(1, 0), a3, voffA);
            PG8_WAIT_V(8); PG8_WAIT_L(0); PG8_BAR; PG8_MMA(1, 0, At, B0); PG8_MMA(1, 1, At, B1); PG8_BAR; PG8_SCHED;
        }
        if constexpr (ALIGN_EPI) { if (wr == 0) PG8_BAR; }
        E(acc, cur, wr, wc, fr, fq);
        if (!has_next) break;
#pragma unroll
        for (int a = 0; a < 2; ++a)
#pragma unroll
            for (int b = 0; b < 2; ++b)
#pragma unroll
                for (int m = 0; m < 4; ++m)
#pragma unroll
                    for (int n = 0; n < 2; ++n) acc[a][b][m][n] = (f32x4){0.f, 0.f, 0.f, 0.f};
        cur = nxt; cA = nA; cB = nB; ++ui;
        if constexpr (ALIGN_EPI) { if (wr == 1) PG8_BAR; }
    }
    PG8_WAIT_V(0);
    if constexpr (!ALIGN_EPI) { if (wr == 0) PG8_BAR; }
    PG8_BAR;
#undef PG8_SA
#undef PG8_SB
#undef PG8_STAGE
#undef PG8_LDA
#undef PG8_LDB
#undef PG8_MMA
#undef PG8_WAIT_V
#undef PG8_WAIT_L
#undef PG8_BAR
#undef PG8_SCHED
}

struct EpiSwiglu {
    bf16_t* H;
    __device__ __forceinline__ void operator()(const f32x4 (&acc)[2][2][4][2], const Unit& u, int wr, int wc, int fr, int fq) const {
        const int row0 = u.pm * BM + wr * 64 + fr, col0 = u.pn * 128 + wc * 32 + 4 * fq;
#pragma unroll
        for (int ai = 0; ai < 2; ++ai)
#pragma unroll
            for (int m = 0; m < 4; ++m) { bf16_t* rowp = H + (size_t)(row0 + ai * HALF + m * 16) * FF + col0;
#pragma unroll
                for (int n = 0; n < 2; ++n) { const f32x4 gt = acc[ai][0][m][n], up = acc[ai][1][m][n];
                    u32x2 w; w.x = pk2(siluf_(gt[0]) * up[0], siluf_(gt[1]) * up[1]); w.y = pk2(siluf_(gt[2]) * up[2], siluf_(gt[3]) * up[3]);
                    *(u32x2*)(rowp + n * 16) = w; } }
    }
};
struct EpiRes {
    const float* res_lat; const float* res_ctx; float* out_lat; float* out_ctx; const float* gate; float coef;
    __device__ __forceinline__ void operator()(const f32x4 (&acc)[2][2][4][2], const Unit& u, int wr, int wc, int fr, int fq) const {
        const bool isctx = u.pm >= 64; const int mr = isctx ? 4 : (u.pm >> 4);
        const int lrow0 = (isctx ? (u.pm - 64) : u.pm) * BM + wr * 64 + fr, col0 = u.pn * BM + wc * 32 + 4 * fq;
        const float* res = isctx ? res_ctx : res_lat; float* out = isctx ? out_ctx : out_lat;
        const float* gp = gate + (size_t)mr * NMOD + col0;
        f32x4 gv[2][2];
#pragma unroll
        for (int bj = 0; bj < 2; ++bj)
#pragma unroll
            for (int n = 0; n < 2; ++n) gv[bj][n] = *(const f32x4*)(gp + bj * HALF + n * 16) * coef;
#pragma unroll
        for (int ai = 0; ai < 2; ++ai)
#pragma unroll
            for (int m = 0; m < 4; ++m) { const size_t ro = (size_t)(lrow0 + ai * HALF + m * 16) * D + col0;
#pragma unroll
                for (int bj = 0; bj < 2; ++bj)
#pragma unroll
                    for (int n = 0; n < 2; ++n) { const f32x4 r = *(const f32x4*)(res + ro + bj * HALF + n * 16);
                        *(f32x4*)(out + ro + bj * HALF + n * 16) = r + gv[bj][n] * acc[ai][bj][m][n]; } }
    }
};
struct EpiIn {
    bf16_t* PA; bf16_t* PB; float* BA;
    __device__ __forceinline__ void operator()(const f32x4 (&acc)[2][2][4][2], const Unit& u, int wr, int wc, int fr, int fq) const {
        const int row0 = u.pm * BM + wr * 64 + fr;
        if (u.pn == 12) {
            if (wc == 0) {
#pragma unroll
                for (int ai = 0; ai < 2; ++ai)
#pragma unroll
                    for (int m = 0; m < 4; ++m) *(f32x4*)(BA + (size_t)(row0 + ai * HALF + m * 16) * 16 + 4 * fq) = acc[ai][0][m][0];
            }
            return;
        }
        bf16_t* base = (u.pn < 6) ? PA : PB; const int col0 = (u.pn % 6) * BM + wc * 32 + 4 * fq;
#pragma unroll
        for (int ai = 0; ai < 2; ++ai)
#pragma unroll
            for (int m = 0; m < 4; ++m) { bf16_t* rowp = base + (size_t)(row0 + ai * HALF + m * 16) * 1536 + col0;
#pragma unroll
                for (int bj = 0; bj < 2; ++bj)
#pragma unroll
                    for (int n = 0; n < 2; ++n) { const f32x4 v = acc[ai][bj][m][n]; u32x2 w; w.x = pk2(v[0], v[1]); w.y = pk2(v[2], v[3]); *(u32x2*)(rowp + bj * HALF + n * 16) = w; } }
    }
};
}

__device__ __forceinline__ void transpose_item(const float* W, int N, int k0, int src_col0, int nvalid, bf16_t* WT, int Kp, int dst_row0, float* scr, int lane) {
#pragma unroll 8
    for (int i = 0; i < 32; ++i) { const int kk = 2 * i + (lane >> 5), n = lane & 31; scr[kk * 33 + n] = (n < nvalid) ? W[(size_t)(k0 + kk) * N + src_col0 + n] : 0.f; }
    LDS_WAIT();
    const int c = lane & 7;
#pragma unroll
    for (int j = 0; j < 4; ++j) { const int n = (lane >> 3) + 8 * j; const float* s = scr + (8 * c) * 33 + n;
        u32x4 o; o.x = pk2(s[0 * 33], s[1 * 33]); o.y = pk2(s[2 * 33], s[3 * 33]); o.z = pk2(s[4 * 33], s[5 * 33]); o.w = pk2(s[6 * 33], s[7 * 33]);
        *(u32x4*)(WT + (size_t)(dst_row0 + n) * Kp + k0 + 8 * c) = o; }
    LDS_WAIT();
}

struct Ptrs {
    const float *x, *c, *ctx, *cctx, *w_ada, *b_ada, *norm_g, *w1, *w3, *w2, *w_in, *w_out, *gconv, *galog, *gdtb, *gnormw, *lconv, *lconvb, *lwg, *lbg, *llam, *fng;
    float* out; unsigned char* ws;
};

__device__ __forceinline__ void phase_prologue(const Ptrs& P, unsigned char* lds, int tid, int lane, int wave, int bid, int G) {
    float* mods = (float*)(P.ws + WS_MODS);
    {
        float* sc = (float*)lds;
        for (int i = tid; i < 5 * D; i += 512) { const int r = i >> 10, k = i & 1023; const float v = (r < 4) ? P.c[r * D + k] : P.cctx[k]; sc[i] = siluf_(v); }
        __syncthreads();
        float* red = (float*)(lds + 20480);
        for (int it = bid; it < NMOD / 64; it += G) {
            const int n0 = it * 64, cq = tid & 15, kl = tid >> 4;
            float acc[5][4];
#pragma unroll
            for (int r = 0; r < 5; ++r)
#pragma unroll
                for (int j = 0; j < 4; ++j) acc[r][j] = 0.f;
#pragma unroll 4
            for (int i = 0; i < 32; ++i) { const int k = kl + 32 * i; const f32x4 w = *(const f32x4*)(P.w_ada + (size_t)k * NMOD + n0 + 4 * cq);
#pragma unroll
                for (int r = 0; r < 5; ++r) { const float s = sc[r * D + k];
#pragma unroll
                    for (int j = 0; j < 4; ++j) acc[r][j] += s * w[j]; } }
#pragma unroll
            for (int r = 0; r < 5; ++r)
#pragma unroll
                for (int j = 0; j < 4; ++j) red[(kl * 16 + cq) * 20 + r * 4 + j] = acc[r][j];
            __syncthreads();
            if (tid < 320) { const int cq2 = tid / 20, rj = tid % 20; float s = 0.f;
                for (int k2 = 0; k2 < 32; ++k2) s += red[(k2 * 16 + cq2) * 20 + rj];
                const int r = rj >> 2, n = n0 + 4 * cq2 + (rj & 3); mods[r * NMOD + n] = s + P.b_ada[n]; }
            __syncthreads();
        }
        __syncthreads();
    }
    {
        float* scr = (float*)(lds + wave * 16384);
        const int gw = bid * 8 + wave, NGW = G * 8;
        bf16_t* W1A = (bf16_t*)(P.ws + WS_W1A); bf16_t* W2A = (bf16_t*)(P.ws + WS_W2A); bf16_t* W1B = (bf16_t*)(P.ws + WS_W1B); bf16_t* W2B = (bf16_t*)(P.ws + WS_W2B);
        bf16_t* WIN = (bf16_t*)(P.ws + WS_WIN); bf16_t* WOUT = (bf16_t*)(P.ws + WS_WOUT);
        constexpr int I_UP = 16 * 88, I_DN = 44 * 32, I_IN = 16 * 97, I_OUT = 16 * 32;
        constexpr int NITEMS = 6 * I_UP + I_IN + I_OUT;
        static_assert(I_UP == I_DN, "item counts");
        for (int it = gw; it < NITEMS; it += NGW) {
            int r = it;
            if (r < 6 * I_UP) {
                const int seg = r / I_UP; r -= seg * I_UP; const int layer = seg / 3, kind = seg % 3;
                if (kind < 2) { const int kb = r / 88, nbk = r % 88, sc0 = 32 * nbk; const float* W = (kind == 0 ? P.w1 : P.w3) + (size_t)layer * D * FF;
                    transpose_item(W, FF, 64 * kb, sc0, 32, layer ? W1B : W1A, D, 256 * (sc0 / 128) + (sc0 % 128) + (kind ? 128 : 0), scr, lane); }
                else { const int kb = r / 32, nbk = r % 32; transpose_item(P.w2 + (size_t)layer * FF * D, D, 64 * kb, 32 * nbk, 32, layer ? W2B : W2A, FF, 32 * nbk, scr, lane); }
                continue;
            }
            r -= 6 * I_UP;
            if (r < I_IN) { const int kb = r / 97, g = r % 97;
                if (g < 64) transpose_item(P.w_in, IN_COLS, 64 * kb, 32 * g, 32, WIN, D, 32 * g, scr, lane);
                else if (g < 96) transpose_item(P.w_in, IN_COLS, 64 * kb, 2064 + 32 * (g - 64), 32, WIN, D, 2048 + 32 * (g - 64), scr, lane);
                else transpose_item(P.w_in, IN_COLS, 64 * kb, 2048, 16, WIN, D, 3072, scr, lane);
                continue; }
            r -= I_IN;
            { const int kb = r / 32, nbk = r % 32; transpose_item(P.w_out, D, 64 * kb, 32 * nbk, 32, WOUT, D, 32 * nbk, scr, lane); }
        }
        u32x4* z = (u32x4*)(WIN + (size_t)3104 * D);
        for (int i = bid * 512 + tid; i < 224 * D * 2 / 16; i += G * 512) z[i] = (u32x4){0u, 0u, 0u, 0u};
    }
}

__device__ __forceinline__ void phase_norm_mod(const float* src_lat, const float* src_ctx, int nrows, const float* g, const float* mods, int shift_idx, int scale_idx, bf16_t* U, int gw, int NGW, int lane) {
    for (int m = gw; m < nrows; m += NGW) {
        const float* xrow = (m < M_LAT) ? src_lat + (size_t)m * D : src_ctx + (size_t)(m - M_LAT) * D;
        const int mr = (m < M_LAT) ? (m >> 12) : 4;
        const float* sh = mods + (size_t)mr * NMOD + shift_idx * D; const float* sc = mods + (size_t)mr * NMOD + scale_idx * D;
        f32x4 v[4]; float ss = 0.f;
#pragma unroll
        for (int j = 0; j < 4; ++j) { v[j] = *(const f32x4*)(xrow + 4 * lane + 256 * j); ss += (v[j][0] * v[j][0] + v[j][1] * v[j][1]) + (v[j][2] * v[j][2] + v[j][3] * v[j][3]); }
        const float rstd = rsqrtf(wave_sum(ss) * (1.f / D) + EPS);
#pragma unroll
        for (int j = 0; j < 4; ++j) { const int col = 4 * lane + 256 * j;
            const f32x4 gv = *(const f32x4*)(g + col), sv = *(const f32x4*)(sc + col), hv = *(const f32x4*)(sh + col);
            const f32x4 y = v[j] * rstd * gv * (sv + 1.f) + hv;
            u32x2 w; w.x = pk2(y[0], y[1]); w.y = pk2(y[2], y[3]); *(u32x2*)(U + (size_t)m * D + col) = w; }
    }
}

constexpr int KP = 132;
__device__ __forceinline__ void gdn_solve(const float* src, const float* scl, const float* A, bf16_t* dst, int base, int stride) {
    float x[64];
#pragma unroll
    for (int i = 0; i < 64; ++i) x[i] = 0.f;
#pragma unroll
    for (int i = 0; i < 64; ++i) {
        float s0 = src[base + i * stride] * scl[i], s1 = 0.f, s2 = 0.f, s3 = 0.f;
#pragma unroll
        for (int j4 = 0; j4 < (i + 3) / 4; ++j4) { const f32x4 av = *(const f32x4*)(A + i * 64 + 4 * j4);
            s0 -= av[0] * x[4 * j4]; s1 -= av[1] * x[4 * j4 + 1]; s2 -= av[2] * x[4 * j4 + 2]; s3 -= av[3] * x[4 * j4 + 3]; }
        x[i] = (s0 + s1) + (s2 + s3);
        dst[i * 128] = (bf16_t)f2bf(x[i]);
    }
}
__device__ __forceinline__ void gdn_prep_item(const Ptrs& P, unsigned char* lds, int item, int tid, int lane, int wave) {
    const int b = item / (4 * NCH), h = (item / NCH) & 3, cn = item % NCH;
    const bool isctx = cn < 4; const int cl = isctx ? cn : cn - 4, L = isctx ? CTXL : SEQ;
    const int rowbase = isctx ? M_LAT + b * CTXL : b * SEQ;
    const bf16_t* PA = (const bf16_t*)(P.ws + WS_PA); const float* BA = (const float*)(P.ws + WS_BA);
    int lo_ = 0; asm volatile("" : "+v"(lo_));
    float* KF = (float*)(lds + lo_); float* QF = (float*)(lds + lo_ + 33792); float* VF = (float*)(lds + lo_ + 67584);
    float* KKN = (float*)(lds + lo_ + 101376); float* QKN = (float*)(lds + lo_ + 118016);
    float* GS = (float*)(lds + lo_ + 134656);
    float* RB = GS + 128;
    float* RBE = GS + 256;
    float* AD = QF;
    {
        const int c = tid & 127, tg = tid >> 7;
#pragma unroll
        for (int mat = 0; mat < 3; ++mat) {
            const int ch = mat * 512 + h * 128 + c;
            const float w0 = P.gconv[ch], w1 = P.gconv[1536 + ch], w2 = P.gconv[2 * 1536 + ch], w3 = P.gconv[3 * 1536 + ch];
            const int t0 = cl * 64 + tg * 16;
            const bf16_t* src = PA + (size_t)rowbase * 1536 + ch;
            float xm2 = (t0 - 2 >= 0) ? bf2f(src[(size_t)(t0 - 2) * 1536]) : 0.f;
            float xm1 = (t0 - 1 >= 0) ? bf2f(src[(size_t)(t0 - 1) * 1536]) : 0.f;
            float x0 = bf2f(src[(size_t)t0 * 1536]);
            float* dst = (mat == 0 ? QF : (mat == 1 ? KF : VF)) + (tg * 16) * KP + c;
#pragma unroll 4
            for (int i = 0; i < 16; ++i) { const int t = t0 + i; const float xp1 = (t + 1 < L) ? bf2f(src[(size_t)(t + 1) * 1536]) : 0.f;
                const float y = w0 * xm2 + w1 * xm1 + w2 * x0 + w3 * xp1; dst[i * KP] = siluf_(y); xm2 = xm1; xm1 = x0; x0 = xp1; }
        }
    }
    if (tid < 128) {
        const int d = tid >> 6, i = lane, r = d ? 63 - i : i;
        const float* ba = BA + (size_t)(rowbase + cl * 64 + r) * 16;
        const float beta = sigmoidf_(ba[d * 4 + h]);
        float gg = -__expf(P.galog[d * 4 + h]) * softplusf_(ba[(2 + d) * 4 + h] + P.gdtb[d * 4 + h]);
#pragma unroll
        for (int o = 1; o < 64; o <<= 1) { const float t = __shfl_up(gg, o); if (lane >= o) gg += t; }
        GS[d * 64 + i] = gg; RB[d * 64 + i] = beta; RBE[d * 64 + i] = beta * __expf(gg);
        ((float*)(P.ws + WS_GC))[((size_t)((d * 4 + b) * 4 + h) * NCH + cn) * 64 + i] = gg;
    }
    __syncthreads();
    {
        bf16_t* QG = (bf16_t*)(P.ws + WS_QG) + ((size_t)((b * 4 + h) * NCH + cn) * 64) * 128;
        bf16_t* KG = (bf16_t*)(P.ws + WS_KG) + ((size_t)((b * 4 + h) * NCH + cn) * 64) * 128;
#pragma unroll
        for (int tt = 0; tt < 8; ++tt) { const int tok = wave * 8 + tt;
            f32x2 q = *(f32x2*)(QF + tok * KP + 2 * lane), k = *(f32x2*)(KF + tok * KP + 2 * lane);
            const float sq = wave_sum(q[0] * q[0] + q[1] * q[1]), sk = wave_sum(k[0] * k[0] + k[1] * k[1]);
            q = q * (rsqrtf(sq + EPS) * 0.08838834764831845f); k = k * rsqrtf(sk + EPS);
            *(f32x2*)(QF + tok * KP + 2 * lane) = q; *(f32x2*)(KF + tok * KP + 2 * lane) = k;
            *(unsigned*)(QG + tok * 128 + 2 * lane) = pk2(q[0], q[1]); *(unsigned*)(KG + tok * 128 + 2 * lane) = pk2(k[0], k[1]); }
    }
    __syncthreads();
    {
        const int tp = tid & 255, ti = tp >> 4, tj = tp & 15; const float* X = (tid < 256) ? KF : QF; float* OUT = (tid < 256) ? KKN : QKN;
        float acc[4][4];
#pragma unroll
        for (int a = 0; a < 4; ++a)
#pragma unroll
            for (int c = 0; c < 4; ++c) acc[a][c] = 0.f;
#pragma unroll 2
        for (int kq = 0; kq < 32; ++kq) {
            f32x4 av[4], bv[4];
#pragma unroll
            for (int a = 0; a < 4; ++a) { av[a] = *(const f32x4*)(X + (ti + 16 * a) * KP + 4 * kq); bv[a] = *(const f32x4*)(KF + (tj + 16 * a) * KP + 4 * kq); }
#pragma unroll
            for (int a = 0; a < 4; ++a)
#pragma unroll
                for (int c = 0; c < 4; ++c) acc[a][c] += (av[a][0] * bv[c][0] + av[a][1] * bv[c][1]) + (av[a][2] * bv[c][2] + av[a][3] * bv[c][3]);
        }
#pragma unroll
        for (int a = 0; a < 4; ++a)
#pragma unroll
            for (int c = 0; c < 4; ++c) OUT[(ti + 16 * a) * 65 + tj + 16 * c] = acc[a][c];
    }
    __syncthreads();
    {
        const int d = tid >> 8, tp = tid & 255;
        bf16_t* ATT = (bf16_t*)(P.ws + WS_ATT) + ((size_t)((d * 4 + b) * 4 + h) * NCH + cn) * 4096;
#pragma unroll 4
        for (int e = 0; e < 16; ++e) { const int idx = tp + 256 * e, i = idx >> 6, j = idx & 63, ri = d ? 63 - i : i, rj = d ? 63 - j : j;
            const float dec = (i >= j) ? __expf(GS[d * 64 + i] - GS[d * 64 + j]) : 0.f;
            AD[d * 4096 + idx] = (i > j) ? RB[d * 64 + i] * KKN[ri * 65 + rj] * dec : 0.f;
            ATT[idx] = (bf16_t)f2bf(QKN[ri * 65 + rj] * dec); }
    }
    __syncthreads();
    {
        const int d = tid >> 8, c = tid & 255;
        const float* src = (c < 128) ? VF + c : KF + (c - 128); const float* scl = ((c < 128) ? RB : RBE) + d * 64;
        bf16_t* dst = (bf16_t*)(P.ws + (c < 128 ? WS_UB : WS_WB)) + ((size_t)((d * 4 + b) * 4 + h) * NCH + cn) * 64 * 128 + (c & 127);
        int sb_ = d ? 63 * KP : 0, ss_ = d ? -KP : KP; asm volatile("" : "+v"(sb_), "+v"(ss_));
        gdn_solve(src, scl, AD + d * 4096, dst, sb_, ss_);
    }
    __syncthreads();
}

__device__ __forceinline__ int chunk_of(int d, int s) { return d ? (s < 4 ? 3 - s : 67 - (s - 4)) : s; }
constexpr int TP = 272, AP = 144;
__device__ __forceinline__ bf16x8 ldfrag(const unsigned char* base, int row, int pitch, int kbyte) { return *(const bf16x8*)(base + row * pitch + kbyte); }
__device__ __forceinline__ void gdn_scan_item(const Ptrs& P, unsigned char* lds, int item, int tid, int lane, int wave) {
    const int chain = item & 31, slice = item >> 5, d = chain >> 4, b = (chain >> 2) & 3, h = chain & 3, e0 = slice * 32;
    unsigned char* Wl = lds; unsigned char* Ql = lds + 17408; unsigned char* Kl = lds + 34816; unsigned char* ATl = lds + 52224;
    unsigned char* St = lds + 61440; unsigned char* Vt = lds + 70144; unsigned char* Vdt = lds + 74752; float* gcs = (float*)(lds + 79360);
    const bf16_t* WBp = (const bf16_t*)(P.ws + WS_WB) + (size_t)((d * 4 + b) * 4 + h) * NCH * 8192;
    const bf16_t* UBp = (const bf16_t*)(P.ws + WS_UB) + (size_t)((d * 4 + b) * 4 + h) * NCH * 8192;
    const bf16_t* ATp = (const bf16_t*)(P.ws + WS_ATT) + (size_t)((d * 4 + b) * 4 + h) * NCH * 4096;
    const float* GCp = (const float*)(P.ws + WS_GC) + (size_t)((d * 4 + b) * 4 + h) * NCH * 64;
    const bf16_t* QGp = (const bf16_t*)(P.ws + WS_QG) + (size_t)(b * 4 + h) * NCH * 8192;
    const bf16_t* KGp = (const bf16_t*)(P.ws + WS_KG) + (size_t)(b * 4 + h) * NCH * 8192;
    bf16_t* Op = (bf16_t*)(P.ws + (d ? WS_OB : WS_OF));
    const int fr = lane & 15, fq = lane >> 4, mt = wave & 3, nt = wave >> 2;
    for (int i = tid; i < 8704 / 4; i += 512) ((unsigned*)St)[i] = 0u;
    f32x4 Sacc[2] = {(f32x4){0.f, 0.f, 0.f, 0.f}, (f32x4){0.f, 0.f, 0.f, 0.f}};
    u32x4 rw[2], rq[2], rk[2], ra; float rg = 0.f; bf16_t ru[4];
#define SCAN_PREFETCH(s_) do { const int cn_ = chunk_of(d, s_); \
        const u32x4* w4 = (const u32x4*)(WBp + (size_t)cn_ * 8192); const u32x4* q4 = (const u32x4*)(QGp + (size_t)cn_ * 8192); const u32x4* k4 = (const u32x4*)(KGp + (size_t)cn_ * 8192); \
        rw[0] = w4[tid]; rw[1] = w4[tid + 512]; rq[0] = q4[tid]; rq[1] = q4[tid + 512]; rk[0] = k4[tid]; rk[1] = k4[tid + 512]; \
        ra = ((const u32x4*)(ATp + (size_t)cn_ * 4096))[tid]; if (tid < 64) rg = GCp[cn_ * 64 + tid]; \
        { const bf16_t* up_ = UBp + (size_t)cn_ * 8192 + (mt * 16 + fq * 4) * 128 + e0 + nt * 16 + fr; ru[0] = up_[0]; ru[1] = up_[128]; ru[2] = up_[256]; ru[3] = up_[384]; } } while (0)
    SCAN_PREFETCH(0);
    for (int s = 0; s < NCH; ++s) {
        const int cn = chunk_of(d, s); const bool lat = cn >= 4;
#pragma unroll
        for (int i = 0; i < 2; ++i) { const int idx = tid + 512 * i, row = idx >> 4, cc = idx & 15;
            *(u32x4*)(Wl + row * TP + cc * 16) = rw[i]; *(u32x4*)(Ql + row * TP + cc * 16) = rq[i]; *(u32x4*)(Kl + row * TP + cc * 16) = rk[i]; }
        *(u32x4*)(ATl + (tid >> 3) * AP + (tid & 7) * 16) = ra;
        if (tid < 64) gcs[tid] = rg;
        float uv[4];
#pragma unroll
        for (int jj = 0; jj < 4; ++jj) uv[jj] = bf2f(ru[jj]);
        __syncthreads();
        if (s + 1 < NCH) SCAN_PREFETCH(s + 1);
        const float glast = gcs[63];
        f32x4 acc_a = (f32x4){0.f, 0.f, 0.f, 0.f}, acc_b = (f32x4){0.f, 0.f, 0.f, 0.f};
        { const int qrow = d ? 63 - (mt * 16 + fr) : (mt * 16 + fr);
#pragma unroll
          for (int ks = 0; ks < 4; ++ks) { const bf16x8 bs = ldfrag(St, nt * 16 + fr, TP, ks * 64 + fq * 16);
              const bf16x8 aw = ldfrag(Wl, mt * 16 + fr, TP, ks * 64 + fq * 16);
              acc_a = __builtin_amdgcn_mfma_f32_16x16x32_bf16(aw, bs, acc_a, 0, 0, 0);
              if (lat) { const bf16x8 aq = ldfrag(Ql, qrow, TP, ks * 64 + fq * 16); acc_b = __builtin_amdgcn_mfma_f32_16x16x32_bf16(aq, bs, acc_b, 0, 0, 0); } } }
        { float vn[4], vd[4];
#pragma unroll
          for (int jj = 0; jj < 4; ++jj) { const float gi = gcs[mt * 16 + fq * 4 + jj]; vn[jj] = uv[jj] - acc_a[jj]; vd[jj] = vn[jj] * __expf(glast - gi); acc_b[jj] *= __expf(gi); }
          u32x2 w; w.x = pk2(vn[0], vn[1]); w.y = pk2(vn[2], vn[3]); *(u32x2*)(Vt + (nt * 16 + fr) * AP + (mt * 16 + fq * 4) * 2) = w;
          w.x = pk2(vd[0], vd[1]); w.y = pk2(vd[2], vd[3]); *(u32x2*)(Vdt + (nt * 16 + fr) * AP + (mt * 16 + fq * 4) * 2) = w; }
        __syncthreads();
        if (lat) {
#pragma unroll
            for (int ks = 0; ks < 2; ++ks) { const bf16x8 aa = ldfrag(ATl, mt * 16 + fr, AP, ks * 64 + fq * 16); const bf16x8 bv = ldfrag(Vt, nt * 16 + fr, AP, ks * 64 + fq * 16);
                acc_b = __builtin_amdgcn_mfma_f32_16x16x32_bf16(aa, bv, acc_b, 0, 0, 0); }
            bf16_t* op = Op + (size_t)(b * SEQ + (cn - 4) * 64) * 512 + h * 128 + e0 + nt * 16 + fr;
#pragma unroll
            for (int jj = 0; jj < 4; ++jj) { const int i = mt * 16 + fq * 4 + jj, tok = d ? 63 - i : i; op[(size_t)tok * 512] = (bf16_t)f2bf(acc_b[jj]); }
        }
        { const float eg = __expf(glast);
          bf16x8 ak[2];
#pragma unroll
          for (int ks = 0; ks < 2; ++ks)
#pragma unroll
              for (int jj = 0; jj < 8; ++jj) { const int i = ks * 32 + fq * 8 + jj, row = d ? 63 - i : i; ak[ks][jj] = (short)*(const bf16_t*)(Kl + row * TP + (16 * wave + fr) * 2); }
#pragma unroll
          for (int n2 = 0; n2 < 2; ++n2) { f32x4 a = Sacc[n2] * eg;
#pragma unroll
              for (int ks = 0; ks < 2; ++ks) { const bf16x8 bv = ldfrag(Vdt, n2 * 16 + fr, AP, ks * 64 + fq * 16); a = __builtin_amdgcn_mfma_f32_16x16x32_bf16(ak[ks], bv, a, 0, 0, 0); }
              Sacc[n2] = a;
              u32x2 w; w.x = pk2(a[0], a[1]); w.y = pk2(a[2], a[3]); *(u32x2*)(St + (n2 * 16 + fr) * TP + (16 * wave + fq * 4) * 2) = w; } }
        __syncthreads();
    }
#undef SCAN_PREFETCH
}

template <int MODE>
__device__ __forceinline__ void lru_item(const Ptrs& P, unsigned char* lds, int b, int cn, int nb, int tid, int lane, int wave) {
    const bool isctx = cn < 4; const int cl = isctx ? cn : cn - 4, L = isctx ? CTXL : SEQ, s0 = cl * 64;
    const bf16_t* PB = (const bf16_t*)(P.ws + WS_PB);
    float* xin = (float*)lds;
    float* xT = (float*)(lds + 17408);
    float* wg = (float*)(lds + 34816);
    f32x2* seg = (f32x2*)(lds + 100352);
#define rowof(s_) (isctx ? (size_t)(M_LAT + b * CTXL + (s_)) : (size_t)(b * SEQ + ((s_) & 63) * 64 + ((s_) >> 6)))
    for (int idx = tid; idx < 67 * 64; idx += 512) { const int si = idx >> 6, c = idx & 63, s = s0 - 2 + si;
        xin[idx] = (s >= 0 && s < L) ? bf2f(PB[rowof(s) * 1536 + 512 + nb * 64 + c]) : 0.f; }
    for (int idx = tid; idx < 4 * 4096; idx += 512) { const int dg = idx >> 12; wg[idx] = P.lwg[((size_t)dg * 8 + nb) * 4096 + (idx & 4095)]; }
    __syncthreads();
    { const int c = tid & 63, ig = tid >> 6, ch = nb * 64 + c;
      const float w0 = P.lconv[ch], w1 = P.lconv[512 + ch], w2 = P.lconv[1024 + ch], w3 = P.lconv[1536 + ch], bias = P.lconvb[ch];
#pragma unroll
      for (int ii = 0; ii < 8; ++ii) { const int i = ig * 8 + ii; xT[c * 68 + i] = bias + w0 * xin[i * 64 + c] + w1 * xin[(i + 1) * 64 + c] + w2 * xin[(i + 2) * 64 + c] + w3 * xin[(i + 3) * 64 + c]; } }
    __syncthreads();
    const int co = tid & 63, ig = tid >> 6, ch = nb * 64 + co;
    float acc[4][8];
#pragma unroll
    for (int q = 0; q < 4; ++q)
#pragma unroll
        for (int ii = 0; ii < 8; ++ii) acc[q][ii] = 0.f;
#pragma unroll 4
    for (int ci = 0; ci < 64; ++ci) { const f32x4 xa = *(const f32x4*)(xT + ci * 68 + ig * 8), xb = *(const f32x4*)(xT + ci * 68 + ig * 8 + 4);
        float wv[4];
#pragma unroll
        for (int q = 0; q < 4; ++q) wv[q] = wg[q * 4096 + ci * 64 + co];
#pragma unroll
        for (int q = 0; q < 4; ++q) {
#pragma unroll
            for (int ii = 0; ii < 4; ++ii) { acc[q][ii] += wv[q] * xa[ii]; acc[q][ii + 4] += wv[q] * xb[ii]; } } }
    float av[2][8], bv[2][8];
#pragma unroll
    for (int d = 0; d < 2; ++d) { const float bgr = P.lbg[(d * 2 + 0) * 512 + ch], bgi = P.lbg[(d * 2 + 1) * 512 + ch], sp = softplusf_(-P.llam[d * 512 + ch]);
#pragma unroll
        for (int ii = 0; ii < 8; ++ii) { const int i = ig * 8 + ii; const float xv = xT[co * 68 + i];
            const float r = sigmoidf_(acc[d * 2][ii] + bgr), ing = sigmoidf_(acc[d * 2 + 1][ii] + bgi), la = -8.f * sp * r;
            float mult = sqrtf(-expm1f(2.f * la));
            if (isctx && ((d == 0 && cn == 0 && i == 0) || (d == 1 && cn == 3 && i == 63))) mult = 1.f;
            av[d][ii] = __expf(la); bv[d][ii] = mult * ing * xv; } }
    { float A0 = 1.f, B0 = 0.f, A1 = 1.f, B1 = 0.f;
#pragma unroll
      for (int ii = 0; ii < 8; ++ii) { B0 = av[0][ii] * B0 + bv[0][ii]; A0 *= av[0][ii]; B1 = av[1][7 - ii] * B1 + bv[1][7 - ii]; A1 *= av[1][7 - ii]; }
      seg[(ig * 2 + 0) * 64 + co] = (f32x2){A0, B0}; seg[(ig * 2 + 1) * 64 + co] = (f32x2){A1, B1}; }
    __syncthreads();
    if constexpr (MODE == 0) {
        if (tid < 128) { const int d = tid >> 6; float At = 1.f, Bt = 0.f;
#pragma unroll
            for (int k = 0; k < 8; ++k) { const int sg = d ? 7 - k : k; const f32x2 v = seg[(sg * 2 + d) * 64 + co]; Bt = v[0] * Bt + v[1]; At *= v[0]; }
            ((f32x2*)(P.ws + WS_LSUM))[((size_t)(b * 2 + d) * NCH + cn) * 512 + ch] = (f32x2){At, Bt}; }
    } else {
        const float* CAR = (const float*)(P.ws + WS_LCAR);
        float hf = CAR[((size_t)(b * 2 + 0) * NCH + cn) * 512 + ch], hb = CAR[((size_t)(b * 2 + 1) * NCH + cn) * 512 + ch];
        for (int k = 0; k < ig; ++k) { const f32x2 v = seg[(k * 2 + 0) * 64 + co]; hf = v[0] * hf + v[1]; }
        for (int k = 7; k > ig; --k) { const f32x2 v = seg[(k * 2 + 1) * 64 + co]; hb = v[0] * hb + v[1]; }
        float o[8];
#pragma unroll
        for (int ii = 0; ii < 8; ++ii) { hf = av[0][ii] * hf + bv[0][ii]; o[ii] = hf; }
#pragma unroll
        for (int ii = 7; ii >= 0; --ii) { hb = av[1][ii] * hb + bv[1][ii]; o[ii] += hb; }
        bf16_t* MIX = (bf16_t*)(P.ws + WS_MIX);
#pragma unroll
        for (int ii = 0; ii < 8; ++ii) { const size_t row = rowof(s0 + ig * 8 + ii); const float gt = bf2f(PB[row * 1536 + 1024 + ch]);
            MIX[row * D + 512 + ch] = (bf16_t)f2bf(o[ii] * geluf_(gt)); }
    }
    __syncthreads();
#undef rowof
}
template <int MODE>
__device__ __forceinline__ void lru_phase(const Ptrs& P, unsigned char* lds, int tid, int lane, int wave, int bid, int G) {
    const int nb = bid & 7, slot = bid >> 3, nslots = G >> 3;
    const bf16_t* PB = (const bf16_t*)(P.ws + WS_PB);
    unsigned char* Wt = lds;
    float* xin = (float*)(lds + 36864);
    unsigned char* xb = lds + 54016;
    float* xc = (float*)(lds + 63232);
    f32x2* seg = (f32x2*)(lds + 80640);
    unsigned char* gtl = lds + 97024;
    unsigned char* otl = lds + 106240;
    for (int idx = tid; idx < 4 * 4096; idx += 512) { const int dg = idx >> 12, ci = (idx >> 6) & 63, co = idx & 63;
        *(bf16_t*)(Wt + dg * 9216 + co * 144 + ci * 2) = (bf16_t)f2bf(P.lwg[((size_t)dg * 8 + nb) * 4096 + (idx & 4095)]); }
    const int fr = lane & 15, fq = lane >> 4, nt = wave & 3, mh = wave >> 2;
    const int cch = nb * 64 + (tid & 63);
    const float cw0 = P.lconv[cch], cw1 = P.lconv[512 + cch], cw2 = P.lconv[1024 + cch], cw3 = P.lconv[1536 + cch], cbias = P.lconvb[cch];
    const int co = nt * 16 + fr, ch = nb * 64 + co;
    float bgr[2], bgi[2], sp[2];
#pragma unroll
    for (int d = 0; d < 2; ++d) { bgr[d] = P.lbg[(d * 2 + 0) * 512 + ch]; bgi[d] = P.lbg[(d * 2 + 1) * 512 + ch]; sp[d] = -8.f * softplusf_(-P.llam[d * 512 + ch]); }
    const int nitems = (MODE == 0) ? NB * NCH : NB * 64;
    u32x4 px[2], pg; px[0] = px[1] = pg = (u32x4){0u, 0u, 0u, 0u};
#define LRU_DECODE(j_, b_, cn_) const int b_ = (MODE == 0) ? (j_) / NCH : (j_) >> 6; const int cn_ = (MODE == 0) ? (j_) % NCH : 4 + ((j_) & 63);
#define LRU_ROW(b_, cn_, s_) ((cn_) < 4 ? (size_t)(M_LAT + (b_) * CTXL + (s_)) : (size_t)((b_) * SEQ + ((s_) & 63) * 64 + ((s_) >> 6)))
#define LRU_PREFETCH(j_) do { LRU_DECODE(j_, pb_, pcn_) const int pL_ = pcn_ < 4 ? CTXL : SEQ, ps0_ = (pcn_ < 4 ? pcn_ : pcn_ - 4) * 64; \
        _Pragma("unroll") for (int e_ = 0; e_ < 2; ++e_) { const int q_ = tid + 512 * e_, si_ = q_ >> 3, s_ = ps0_ - 2 + si_; \
            px[e_] = (q_ < 536 && s_ >= 0 && s_ < pL_) ? *(const u32x4*)(PB + LRU_ROW(pb_, pcn_, s_) * 1536 + 512 + nb * 64 + (q_ & 7) * 8) : (u32x4){0u, 0u, 0u, 0u}; } \
        if (MODE == 1) { const int i_ = tid >> 3; pg = *(const u32x4*)(PB + LRU_ROW(pb_, pcn_, ps0_ + i_) * 1536 + 1024 + nb * 64 + (tid & 7) * 8); } } while (0)
    if (slot < nitems) LRU_PREFETCH(slot);
    __syncthreads();
    for (int j = slot; j < nitems; j += nslots) {
        LRU_DECODE(j, b, cn)
        const bool isctx = cn < 4; const int s0 = (isctx ? cn : cn - 4) * 64;
#pragma unroll
        for (int e = 0; e < 2; ++e) { const int q = tid + 512 * e; if (q < 536) { float* dst = xin + (q >> 3) * 64 + (q & 7) * 8;
#pragma unroll
            for (int k = 0; k < 4; ++k) { dst[2 * k] = bf2f(px[e][k] & 0xffffu); dst[2 * k + 1] = bf2f(px[e][k] >> 16); } } }
        if (MODE == 1) *(u32x4*)(gtl + (tid >> 3) * 144 + (tid & 7) * 16) = pg;
        __syncthreads();
        if (j + nslots < nitems) LRU_PREFETCH(j + nslots);
        { const int c = tid & 63, ig = tid >> 6;
#pragma unroll
          for (int ii = 0; ii < 8; ++ii) { const int i = ig * 8 + ii; const float v = cbias + cw0 * xin[i * 64 + c] + cw1 * xin[(i + 1) * 64 + c] + cw2 * xin[(i + 2) * 64 + c] + cw3 * xin[(i + 3) * 64 + c];
              xc[i * 68 + c] = v; *(bf16_t*)(xb + i * 144 + c * 2) = (bf16_t)f2bf(v); } }
        __syncthreads();
        f32x4 acc[2][4];
#pragma unroll
        for (int m2 = 0; m2 < 2; ++m2)
#pragma unroll
            for (int dg = 0; dg < 4; ++dg) acc[m2][dg] = (f32x4){0.f, 0.f, 0.f, 0.f};
#pragma unroll
        for (int ks = 0; ks < 2; ++ks) { bf16x8 af[2];
#pragma unroll
            for (int m2 = 0; m2 < 2; ++m2) af[m2] = ldfrag(xb, (mh * 2 + m2) * 16 + fr, 144, ks * 64 + fq * 16);
#pragma unroll
            for (int dg = 0; dg < 4; ++dg) { const bf16x8 bfr = ldfrag(Wt + dg * 9216, nt * 16 + fr, 144, ks * 64 + fq * 16);
#pragma unroll
                for (int m2 = 0; m2 < 2; ++m2) acc[m2][dg] = __builtin_amdgcn_mfma_f32_16x16x32_bf16(af[m2], bfr, acc[m2][dg], 0, 0, 0); } }
        float av[2][2][4], bv[2][2][4];
#pragma unroll
        for (int m2 = 0; m2 < 2; ++m2)
#pragma unroll
            for (int jj = 0; jj < 4; ++jj) { const int i = (mh * 2 + m2) * 16 + fq * 4 + jj; const float xv = xc[i * 68 + co];
#pragma unroll
                for (int d = 0; d < 2; ++d) { const float r = sigmoidf_(acc[m2][d * 2][jj] + bgr[d]), ing = sigmoidf_(acc[m2][d * 2 + 1][jj] + bgi[d]), la = sp[d] * r;
                    float mult = sqrtf(-expm1f(2.f * la));
                    if (isctx && ((d == 0 && cn == 0 && i == 0) || (d == 1 && cn == 3 && i == 63))) mult = 1.f;
                    av[d][m2][jj] = __expf(la); bv[d][m2][jj] = mult * ing * xv; } }
#pragma unroll
        for (int m2 = 0; m2 < 2; ++m2) { const int sg = (mh * 2 + m2) * 4 + fq; float A0 = 1.f, B0 = 0.f, A1 = 1.f, B1 = 0.f;
#pragma unroll
            for (int jj = 0; jj < 4; ++jj) { B0 = av[0][m2][jj] * B0 + bv[0][m2][jj]; A0 *= av[0][m2][jj]; B1 = av[1][m2][3 - jj] * B1 + bv[1][m2][3 - jj]; A1 *= av[1][m2][3 - jj]; }
            seg[(sg * 2 + 0) * 64 + co] = (f32x2){A0, B0}; seg[(sg * 2 + 1) * 64 + co] = (f32x2){A1, B1}; }
        __syncthreads();
        if constexpr (MODE == 0) {
            if (tid < 128) { const int d = tid >> 6, c2 = tid & 63; float At = 1.f, Bt = 0.f;
#pragma unroll
                for (int k = 0; k < 16; ++k) { const int sg = d ? 15 - k : k; const f32x2 v = seg[(sg * 2 + d) * 64 + c2]; Bt = v[0] * Bt + v[1]; At *= v[0]; }
                ((f32x2*)(P.ws + WS_LSUM))[((size_t)(b * 2 + d) * NCH + cn) * 512 + nb * 64 + c2] = (f32x2){At, Bt}; }
        } else {
            const float* CAR = (const float*)(P.ws + WS_LCAR);
            float hf = CAR[((size_t)(b * 2 + 0) * NCH + cn) * 512 + ch], hb = CAR[((size_t)(b * 2 + 1) * NCH + cn) * 512 + ch];
            const int sg0 = (mh * 2) * 4 + fq;
            for (int k = 0; k < sg0; ++k) { const f32x2 v = seg[(k * 2 + 0) * 64 + co]; hf = v[0] * hf + v[1]; }
            for (int k = 15; k > sg0 + 4; --k) { const f32x2 v = seg[(k * 2 + 1) * 64 + co]; hb = v[0] * hb + v[1]; }
            float o[2][4];
#pragma unroll
            for (int jj = 0; jj < 4; ++jj) { hf = av[0][0][jj] * hf + bv[0][0][jj]; o[0][jj] = hf; }
#pragma unroll
            for (int k = 1; k < 4; ++k) { const f32x2 v = seg[((sg0 + k) * 2 + 0) * 64 + co]; hf = v[0] * hf + v[1]; }
#pragma unroll
            for (int jj = 0; jj < 4; ++jj) { hf = av[0][1][jj] * hf + bv[0][1][jj]; o[1][jj] = hf; }
#pragma unroll
            for (int jj = 3; jj >= 0; --jj) { hb = av[1][1][jj] * hb + bv[1][1][jj]; o[1][jj] += hb; }
#pragma unroll
            for (int k = 3; k >= 1; --k) { const f32x2 v = seg[((sg0 + k) * 2 + 1) * 64 + co]; hb = v[0] * hb + v[1]; }
#pragma unroll
            for (int jj = 3; jj >= 0; --jj) { hb = av[1][0][jj] * hb + bv[1][0][jj]; o[0][jj] += hb; }
#pragma unroll
            for (int m2 = 0; m2 < 2; ++m2)
#pragma unroll
                for (int jj = 0; jj < 4; ++jj) { const int i = (mh * 2 + m2) * 16 + fq * 4 + jj; const float gt = bf2f(*(const bf16_t*)(gtl + i * 144 + co * 2));
                    *(bf16_t*)(otl + i * 144 + co * 2) = (bf16_t)f2bf(o[m2][jj] * geluf_(gt)); }
            __syncthreads();
            { const int i = tid >> 3; bf16_t* MIX = (bf16_t*)(P.ws + WS_MIX);
              *(u32x4*)(MIX + LRU_ROW(b, cn, s0 + i) * D + 512 + nb * 64 + (tid & 7) * 8) = *(const u32x4*)(otl + i * 144 + (tid & 7) * 16); }
        }
        __syncthreads();
    }
#undef LRU_DECODE
#undef LRU_ROW
#undef LRU_PREFETCH
}
__device__ __forceinline__ void lru_carry(const Ptrs& P, int gt) {
    const int b = gt >> 10, d = (gt >> 9) & 1, ch = gt & 511;
    const f32x2* SUM = (const f32x2*)(P.ws + WS_LSUM) + (size_t)(b * 2 + d) * NCH * 512 + ch; float* CAR = (float*)(P.ws + WS_LCAR) + (size_t)(b * 2 + d) * NCH * 512 + ch;
    float carry = 0.f;
    for (int s0 = 0; s0 < NCH; s0 += 17) {
        f32x2 v[17];
#pragma unroll
        for (int k = 0; k < 17; ++k) v[k] = SUM[(size_t)chunk_of(d, s0 + k) * 512];
#pragma unroll
        for (int k = 0; k < 17; ++k) { CAR[(size_t)chunk_of(d, s0 + k) * 512] = carry; carry = v[k][0] * carry + v[k][1]; }
    }
}

__device__ __forceinline__ void gdn_combine(const Ptrs& P, int gw, int NGW, int lane) {
    const bf16_t* OF = (const bf16_t*)(P.ws + WS_OF); const bf16_t* OB = (const bf16_t*)(P.ws + WS_OB); const bf16_t* PB = (const bf16_t*)(P.ws + WS_PB); bf16_t* MIX = (bf16_t*)(P.ws + WS_MIX);
    float nw[8];
#pragma unroll
    for (int j = 0; j < 8; ++j) nw[j] = P.gnormw[(lane * 8 + j) & 127];
    for (int m = gw; m < M_LAT; m += NGW) {
        const u32x4 a = *(const u32x4*)(OF + (size_t)m * 512 + lane * 8), c = *(const u32x4*)(OB + (size_t)m * 512 + lane * 8), z = *(const u32x4*)(PB + (size_t)m * 1536 + lane * 8);
        float o[8], zz[8]; float ss = 0.f;
#pragma unroll
        for (int j = 0; j < 4; ++j) { o[2 * j] = bf2f(a[j] & 0xffffu) + bf2f(c[j] & 0xffffu); o[2 * j + 1] = bf2f(a[j] >> 16) + bf2f(c[j] >> 16); zz[2 * j] = bf2f(z[j] & 0xffffu); zz[2 * j + 1] = bf2f(z[j] >> 16); }
#pragma unroll
        for (int j = 0; j < 8; ++j) ss += o[j] * o[j];
        ss += __shfl_xor(ss, 1); ss += __shfl_xor(ss, 2); ss += __shfl_xor(ss, 4); ss += __shfl_xor(ss, 8);
        const float rs = rsqrtf(ss * (1.f / 128.f) + EPS);
        u32x4 w;
        w.x = pk2(o[0] * rs * nw[0] * siluf_(zz[0]), o[1] * rs * nw[1] * siluf_(zz[1])); w.y = pk2(o[2] * rs * nw[2] * siluf_(zz[2]), o[3] * rs * nw[3] * siluf_(zz[3]));
        w.z = pk2(o[4] * rs * nw[4] * siluf_(zz[4]), o[5] * rs * nw[5] * siluf_(zz[5])); w.w = pk2(o[6] * rs * nw[6] * siluf_(zz[6]), o[7] * rs * nw[7] * siluf_(zz[7]));
        *(u32x4*)(MIX + (size_t)m * D + lane * 8) = w;
    }
}

#define RLX_AGENT __ATOMIC_RELAXED, __HIP_MEMORY_SCOPE_AGENT
#define XB_TMO      128
#define XB_XCNT(j)  (256  + 64 * (j))
#define XB_XSUB(j)  (1280 + 64 * (j))
#define XB_XGEN(j)  (2304 + 64 * (j))
#define XB_TOP      3328
#define XB_TOPGEN   3392
#define XCD_BAR_WORDS 3456
#define XB_SPIN_CAP (1u << 18)

__device__ __forceinline__ unsigned xb_ld(unsigned* p)              { return __hip_atomic_load(p, __ATOMIC_RELAXED, __HIP_MEMORY_SCOPE_AGENT); }
__device__ __forceinline__ unsigned xb_add(unsigned* p, unsigned v) { return __hip_atomic_fetch_add(p, v, __ATOMIC_RELAXED, __HIP_MEMORY_SCOPE_AGENT); }
__device__ __forceinline__ unsigned xb_xcc_id() { return (unsigned)__builtin_amdgcn_s_getreg((3 << 11) | 20) & 0xFu; }
#define XB_SPIN(cond, bar) do { unsigned _sp = 0; while (cond) { __builtin_amdgcn_s_sleep(1); \
    if ((++_sp & 255u) == 0u) { if (xb_ld(&(bar)[XB_TMO])) break; if (_sp > XB_SPIN_CAP) { atomicAdd(&(bar)[XB_TMO], 1u); break; } } } } while (0)

struct XcdBarrier {
    unsigned* bar; unsigned x;
    volatile LAS unsigned* st;
};

__device__ __forceinline__ XcdBarrier xcd_barrier_post(unsigned* bar, volatile LAS unsigned* st) {
    XcdBarrier b; b.bar = bar; b.x = xb_xcc_id(); b.st = st;
    if (threadIdx.x == 0) (void)xb_add(&bar[XB_XCNT(b.x)], 1u);
    return b;
}
__device__ __forceinline__ void xcd_barrier_complete(unsigned* bar, unsigned x, unsigned& nloc, unsigned& nx) {
    const unsigned G = gridDim.x * gridDim.y * gridDim.z;
    unsigned sum, cnt, mine, sp = 0u;
    for (;;) {
        sum = 0u; cnt = 0u; mine = 0u;
#pragma unroll
        for (unsigned j = 0; j < 16; ++j) { const unsigned c = xb_ld(&bar[XB_XCNT(j)]); sum += c; cnt += (c > 0u) ? 1u : 0u; mine = (j == x) ? c : mine; }
        if (sum == G) break;
        __builtin_amdgcn_s_sleep(1);
        if ((++sp & 255u) == 0u) { if (xb_ld(&bar[XB_TMO])) break; if (sp > XB_SPIN_CAP) { atomicAdd(&bar[XB_TMO], 1u); break; } }
    }
    nloc = mine > 0u ? mine : 1u; nx = cnt > 0u ? cnt : 1u;
}

__device__ __forceinline__ void xcd_barrier(const XcdBarrier& b) {
    asm volatile("s_waitcnt vmcnt(0)" ::: "memory");
    __syncthreads();
    if (threadIdx.x == 0) {
        unsigned* bar = b.bar;
        __builtin_amdgcn_s_waitcnt(0);
        unsigned nloc = b.st[0], nx = b.st[1];
        if (nloc == 0u) { xcd_barrier_complete(bar, b.x, nloc, nx); b.st[0] = nloc; b.st[1] = nx; }
        const unsigned old = xb_add(&bar[XB_XSUB(b.x)], 1u);
        const unsigned gen = old / nloc;
        if (old + 1u == (gen + 1u) * nloc) {
            __builtin_amdgcn_fence(__ATOMIC_RELEASE, "agent");
            asm volatile("s_waitcnt vmcnt(0)" ::: "memory");
            const unsigned og = xb_add(&bar[XB_TOP], 1u);
            const unsigned tg = og / nx;
            if (og + 1u == (tg + 1u) * nx) xb_add(&bar[XB_TOPGEN], 1u);
            else XB_SPIN(xb_ld(&bar[XB_TOPGEN]) == tg, bar);
            __builtin_amdgcn_fence(__ATOMIC_ACQUIRE, "agent");
            xb_add(&bar[XB_XGEN(b.x)], 1u);
            asm volatile("s_waitcnt vmcnt(0)" ::: "memory");
        } else {
            XB_SPIN(xb_ld(&bar[XB_XGEN(b.x)]) == gen, bar);
            __builtin_amdgcn_fence(__ATOMIC_ACQUIRE, "agent");
            asm volatile("s_waitcnt vmcnt(0)" ::: "memory");
        }
    }
    __syncthreads();
}


struct Args { const float* in[22]; float* out; unsigned char* ws; int ph_lo, ph_hi; };
constexpr int N_PHASES = 14;

__global__ void __launch_bounds__(512, 2) fwd_kernel(Args args) {
    extern __shared__ __attribute__((aligned(16))) unsigned char lds[];
    const int tid = threadIdx.x, lane = tid & 63, wave = __builtin_amdgcn_readfirstlane(tid >> 6);
    const int G = gridDim.x, bid = blockIdx.x, gw = bid * 8 + wave, NGW = G * 8;
    Ptrs P;
    P.x = args.in[0]; P.c = args.in[1]; P.ctx = args.in[2]; P.cctx = args.in[3]; P.w_ada = args.in[4]; P.b_ada = args.in[5]; P.norm_g = args.in[6];
    P.w1 = args.in[7]; P.w3 = args.in[8]; P.w2 = args.in[9]; P.w_in = args.in[10]; P.w_out = args.in[11]; P.gconv = args.in[12]; P.galog = args.in[13]; P.gdtb = args.in[14];
    P.gnormw = args.in[15]; P.lconv = args.in[16]; P.lconvb = args.in[17]; P.lwg = args.in[18]; P.lbg = args.in[19]; P.llam = args.in[20]; P.fng = args.in[21];
    P.out = args.out; P.ws = args.ws;
    unsigned char* ws = args.ws;
    const float* mods = (const float*)(ws + WS_MODS);
    bf16_t* U = (bf16_t*)(ws + WS_U); bf16_t* HID = (bf16_t*)(ws + WS_HID); float* H1CTX = (float*)(ws + WS_H1CTX);
    LAS unsigned char* ldsl = (LAS unsigned char*)lds;
    const int lo = args.ph_lo, hi = args.ph_hi;
#ifndef REP_MASK
#define REP_MASK 0
#endif
#ifndef SKIP_MASK
#define SKIP_MASK 0
#endif
#define IN(k) (!((SKIP_MASK >> (k)) & 1) && lo <= (k) && (k) < hi)
#define SEAM(k) do { if (IN(k) && IN((k) + 1)) { if ((k) == 0) cg::this_grid().sync(); else xcd_barrier(bar); } } while (0)
    volatile LAS unsigned* MISC = (volatile LAS unsigned*)(ldsl + LDS_BYTES - 64);
    if (tid == 0) { MISC[0] = 0u; MISC[1] = 0u; }
    __syncthreads();
    XcdBarrier bar = xcd_barrier_post((unsigned*)ws + 4096, MISC);

    if (IN(0)) for (int rep_ = 0; rep_ < 1 + ((REP_MASK >> 0) & 1); ++rep_) { if (rep_) __syncthreads(); phase_prologue(P, lds, tid, lane, wave, bid, G); } SEAM(0);
    if (IN(1)) for (int rep_ = 0; rep_ < 1 + ((REP_MASK >> 1) & 1); ++rep_) { if (rep_) __syncthreads(); phase_norm_mod(P.x, P.ctx, M_TOT, P.norm_g, mods, 0, 1, U, gw, NGW, lane); } SEAM(1);
    if (IN(2)) for (int rep_ = 0; rep_ < 1 + ((REP_MASK >> 2) & 1); ++rep_) { if (rep_) __syncthreads(); pg8::Gemm g{U, (const bf16_t*)(ws + WS_W1A), M_TOT, 2 * FF, D}; pg8::StaticOrder S; S.init(M_TOT, 2 * FF, G, bid); pg8::EpiSwiglu E{HID};
        pg8::gemm_phase<pg8::EpiSwiglu, true>(ldsl, g, S, E); } SEAM(2);
    if (IN(3)) for (int rep_ = 0; rep_ < 1 + ((REP_MASK >> 3) & 1); ++rep_) { if (rep_) __syncthreads(); pg8::Gemm g{HID, (const bf16_t*)(ws + WS_W2A), M_TOT, D, FF}; pg8::StaticOrder S; S.init(M_TOT, D, G, bid);
        pg8::EpiRes E{P.x, P.ctx, P.out, H1CTX, mods + 2 * D, 0.5f}; pg8::gemm_phase<pg8::EpiRes, true>(ldsl, g, S, E); } SEAM(3);
    if (IN(4)) for (int rep_ = 0; rep_ < 1 + ((REP_MASK >> 4) & 1); ++rep_) { if (rep_) __syncthreads(); phase_norm_mod(P.out, H1CTX, M_TOT, P.norm_g + D, mods, 3, 4, U, gw, NGW, lane); } SEAM(4);
    if (IN(5)) for (int rep_ = 0; rep_ < 1 + ((REP_MASK >> 5) & 1); ++rep_) { if (rep_) __syncthreads(); pg8::Gemm g{U, (const bf16_t*)(ws + WS_WIN), M_TOT, NIN, D}; pg8::StaticOrder S; S.init(M_TOT, NIN, G, bid);
        pg8::EpiIn E{(bf16_t*)(ws + WS_PA), (bf16_t*)(ws + WS_PB), (float*)(ws + WS_BA)}; pg8::gemm_phase<pg8::EpiIn, true>(ldsl, g, S, E); } SEAM(5);
    if (IN(6)) for (int rep_ = 0; rep_ < 1 + ((REP_MASK >> 6) & 1); ++rep_) { if (rep_) __syncthreads();
        for (int it = bid; it < NB * 4 * NCH; it += G) gdn_prep_item(P, lds, it, tid, lane, wave);
        __syncthreads(); lru_phase<0>(P, lds, tid, lane, wave, bid, G);
    } SEAM(6);
    if (IN(7)) for (int rep_ = 0; rep_ < 1 + ((REP_MASK >> 7) & 1); ++rep_) { if (rep_) __syncthreads();
        for (int j = 0; j < 8; ++j) if ((G - 1 - j) % G == bid) lru_carry(P, j * 512 + tid);
        for (int it = bid; it < 128; it += G) { gdn_scan_item(P, lds, it, tid, lane, wave); __syncthreads(); }
    } SEAM(7);
    if (IN(8)) for (int rep_ = 0; rep_ < 1 + ((REP_MASK >> 8) & 1); ++rep_) { if (rep_) __syncthreads();
        gdn_combine(P, gw, NGW, lane);
        __syncthreads(); lru_phase<1>(P, lds, tid, lane, wave, bid, G);
    } SEAM(8);
    if (IN(9)) for (int rep_ = 0; rep_ < 1 + ((REP_MASK >> 9) & 1); ++rep_) { if (rep_) __syncthreads(); pg8::Gemm g{(const bf16_t*)(ws + WS_MIX), (const bf16_t*)(ws + WS_WOUT), M_LAT, D, D}; pg8::StaticOrder S; S.init(M_LAT, D, G, bid);
        pg8::EpiRes E{P.out, P.out, P.out, P.out, mods + 5 * D, 1.0f}; pg8::gemm_phase<pg8::EpiRes, true>(ldsl, g, S, E); } SEAM(9);
    if (IN(10)) for (int rep_ = 0; rep_ < 1 + ((REP_MASK >> 10) & 1); ++rep_) { if (rep_) __syncthreads(); phase_norm_mod(P.out, P.out, M_LAT, P.norm_g + 2 * D, mods, 6, 7, U, gw, NGW, lane); } SEAM(10);
    if (IN(11)) for (int rep_ = 0; rep_ < 1 + ((REP_MASK >> 11) & 1); ++rep_) { if (rep_) __syncthreads(); pg8::Gemm g{U, (const bf16_t*)(ws + WS_W1B), M_LAT, 2 * FF, D}; pg8::StaticOrder S; S.init(M_LAT, 2 * FF, G, bid); pg8::EpiSwiglu E{HID};
        pg8::gemm_phase<pg8::EpiSwiglu, true>(ldsl, g, S, E); } SEAM(11);
    if (IN(12)) for (int rep_ = 0; rep_ < 1 + ((REP_MASK >> 12) & 1); ++rep_) { if (rep_) __syncthreads(); pg8::Gemm g{HID, (const bf16_t*)(ws + WS_W2B), M_LAT, D, FF}; pg8::StaticOrder S; S.init(M_LAT, D, G, bid);
        pg8::EpiRes E{P.out, P.out, P.out, P.out, mods + 8 * D, 0.5f}; pg8::gemm_phase<pg8::EpiRes, true>(ldsl, g, S, E); } SEAM(12);
    if (IN(13)) for (int rep_ = 0; rep_ < 1 + ((REP_MASK >> 13) & 1); ++rep_) { if (rep_) __syncthreads();
        for (int m = gw; m < M_LAT; m += NGW) { float* row = P.out + (size_t)m * D; f32x4 v[4]; float ss = 0.f;
#pragma unroll
            for (int j = 0; j < 4; ++j) { v[j] = *(const f32x4*)(row + 4 * lane + 256 * j); ss += (v[j][0] * v[j][0] + v[j][1] * v[j][1]) + (v[j][2] * v[j][2] + v[j][3] * v[j][3]); }
            const float rstd = rsqrtf(wave_sum(ss) * (1.f / D) + EPS);
#pragma unroll
            for (int j = 0; j < 4; ++j) { const f32x4 gv = *(const f32x4*)(P.fng + 4 * lane + 256 * j); *(f32x4*)(row + 4 * lane + 256 * j) = v[j] * rstd * gv; } }
    }
#undef IN
#undef SEAM
}

extern "C" void kernel_launch(void* const* d_in, const int* in_sizes, int n_in, void* d_out, int out_size, void* d_ws, size_t ws_size, hipStream_t stream) {
    static int grid = 0;
    if (grid == 0) {
        if (n_in != 22 || out_size != M_LAT * D || ws_size < WS_END) { fprintf(stderr, "kernel_launch: unexpected shapes (n_in %d, out %d, ws %zu)\n", n_in, out_size, ws_size); grid = -1; return; }
        int dev = 0, cus = 0, per_cu = 0;
        hipGetDevice(&dev); hipDeviceGetAttribute(&cus, hipDeviceAttributeMultiprocessorCount, dev);
        if (hipFuncSetAttribute((const void*)fwd_kernel, hipFuncAttributeMaxDynamicSharedMemorySize, LDS_BYTES) != hipSuccess) { fprintf(stderr, "kernel_launch: hipFuncSetAttribute failed\n"); grid = -1; return; }
        if (hipOccupancyMaxActiveBlocksPerMultiprocessor(&per_cu, (const void*)fwd_kernel, 512, LDS_BYTES) != hipSuccess || per_cu < 1) { fprintf(stderr, "kernel_launch: occupancy query gives %d\n", per_cu); per_cu = 1; }
        (void)hipGetLastError();
        grid = cus;
        fprintf(stderr, "kernel_launch: grid %d (cus %d, per_cu %d)\n", grid, cus, per_cu);
    }
    if (grid < 0) return;
    Args a{};
    for (int i = 0; i < 22; ++i) a.in[i] = (const float*)d_in[i];
    a.out = (float*)d_out; a.ws = (unsigned char*)d_ws;
    if (hipMemsetAsync(d_ws, 0, 65536, stream) != hipSuccess) { fprintf(stderr, "kernel_launch: memset failed\n"); return; }
#if ONE_LAUNCH
    a.ph_lo = 0; a.ph_hi = N_PHASES;
    void* kargs[] = {&a};
    hipError_t e = hipLaunchCooperativeKernel((const void*)fwd_kernel, dim3(grid), dim3(512), kargs, LDS_BYTES, stream);
    if (e != hipSuccess) fprintf(stderr, "kernel_launch: cooperative launch failed: %s\n", hipGetErrorString(e));
#else
    for (int p = 0; p < N_PHASES; ++p) { a.ph_lo = p; a.ph_hi = p + 1; hipLaunchKernelGGL(fwd_kernel, dim3(grid), dim3(512), LDS_BYTES, stream, a); }
#endif
}
```

```cpp
#include <hip/hip_runtime.h>
#include <hip/hip_cooperative_groups.h>
#include <cstdio>
#include <cstdint>
namespace cg = cooperative_groups;

#ifndef ONE_LAUNCH
#define ONE_LAUNCH 1
#endif

#define LAS __attribute__((address_space(3)))
typedef unsigned short bf16_t;
typedef short bf16x8 __attribute__((ext_vector_type(8)));
typedef float f32x4 __attribute__((ext_vector_type(4)));
typedef float f32x2 __attribute__((ext_vector_type(2)));
typedef unsigned u32x4 __attribute__((ext_vector_type(4)));
typedef unsigned u32x2 __attribute__((ext_vector_type(2)));

constexpr int D = 1024, NB = 4, SEQ = 4096, CTXL = 256, FF = 2816;
constexpr int M_LAT = NB * SEQ, M_CTX = NB * CTXL, M_TOT = M_LAT + M_CTX;
constexpr int NMOD = 9 * D;
constexpr int IN_COLS = 3088, NIN = 3328;
constexpr int NCH = 68;
constexpr float EPS = 1e-6f;

constexpr size_t MiB = 1u << 20;
constexpr size_t WS_MODS = 1 * MiB, WS_BA = 2 * MiB, WS_GC = 4 * MiB, WS_LSUM = 5 * MiB, WS_LCAR = 7 * MiB + MiB / 2;
constexpr size_t WS_WOUT = 10 * MiB, WS_W1B = 12 * MiB, WS_W2B = 23 * MiB;
constexpr size_t WS_PA = 29 * MiB, WS_PB = 80 * MiB, WS_HID = 29 * MiB, WS_OF = 29 * MiB, WS_OB = 45 * MiB;
constexpr size_t WS_U = 131 * MiB, WS_W1A = 165 * MiB, WS_W2A = 176 * MiB, WS_WIN = 182 * MiB, WS_H1CTX = 189 * MiB;
constexpr size_t WS_QG = 131 * MiB, WS_KG = 148 * MiB, WS_WB = 165 * MiB, WS_UB = 199 * MiB, WS_ATT = 233 * MiB, WS_MIX = 131 * MiB;
constexpr size_t WS_END = 256 * MiB;
constexpr int LDS_BYTES = 147456;

__device__ __forceinline__ unsigned f2bf(float f) { unsigned u = __builtin_bit_cast(unsigned, f); return (u + 0x7fffu + ((u >> 16) & 1u)) >> 16; }
__device__ __forceinline__ unsigned pk2(float lo, float hi) { return f2bf(lo) | (f2bf(hi) << 16); }
__device__ __forceinline__ float bf2f(unsigned h) { return __builtin_bit_cast(float, h << 16); }
__device__ __forceinline__ float wave_sum(float v) {
#pragma unroll
    for (int o = 1; o < 64; o <<= 1) v += __shfl_xor(v, o);
    return v;
}
__device__ __forceinline__ float sigmoidf_(float x) { return 1.f / (1.f + __expf(-x)); }
__device__ __forceinline__ float siluf_(float x) { return x / (1.f + __expf(-x)); }
__device__ __forceinline__ float softplusf_(float x) { return x > 20.f ? x : log1pf(__expf(x)); }
__device__ __forceinline__ float geluf_(float x) { const float t = 0.7978845608f * (x + 0.044715f * x * x * x); return 0.5f * x * (1.f + tanhf(t)); }
#define LDS_WAIT() asm volatile("s_waitcnt lgkmcnt(0)" ::: "memory")

namespace pg8 {
constexpr int BM = 256, BK = 64, HALF = 128, HTB = HALF * BK * 2, NXCD = 8, WGM = 8;
__host__ __device__ __forceinline__ int lds_byte(int r, int c) { const int st = (r >> 4) * 2 + (c >> 5), rr = r & 15, cc = c & 31, ob = rr * 64 + cc * 2; return st * 1024 + (ob ^ (((ob >> 9) & 1) << 5)); }
__host__ __device__ __forceinline__ void stage_rc(int b, int& R, int& C) { const int st = b / 1024, sb = b % 1024, swz = sb ^ (((sb >> 9) & 1) << 5); R = (st >> 1) * 16 + swz / 64; C = (st & 1) * 32 + (swz % 64) / 2; }
struct Unit { int pm, pn; };
struct Gemm { const bf16_t* A; const bf16_t* Bt; int M, N, K; };
struct StaticOrder {
    int nM, nN, nwg, G, c;
    __device__ void init(int M, int N, int G_, int c_) { nM = M / BM; nN = N / BM; nwg = nM * nN; G = G_; c = c_; }
    __device__ bool next(int i, Unit& u) const {
        const long L = (long)i * G + c; if (L >= nwg) return false;
        int wgid = (int)L; { const int q = nwg / NXCD, r = nwg % NXCD, xcd = wgid % NXCD, off = wgid / NXCD; wgid = (xcd < r ? xcd * (q + 1) : r * (q + 1) + (xcd - r) * q) + off; }
        const int nig = WGM * nN, gid = wgid / nig, fm = gid * WGM, gsz = (nM - fm) < WGM ? (nM - fm) : WGM;
        u.pm = fm + ((wgid % nig) % gsz); u.pn = (wgid % nig) / gsz; return true;
    }
};
template <class Epi, bool ALIGN_EPI>
__device__ __forceinline__ void gemm_phase(LAS unsigned char* lds, const Gemm g, const StaticOrder& S, const Epi& E) {
    const int tid = threadIdx.x, wid = __builtin_amdgcn_readfirstlane(tid >> 6), lane = tid & 63, wr = wid >> 2, wc = wid & 3, fr = lane & 15, fq = lane >> 4;
    const int K = g.K, nt = K / BK;
    unsigned voffA[2];
#pragma unroll
    for (int i = 0; i < 2; ++i) { int R, C; stage_rc(tid * 16 + i * 8192, R, C); voffA[i] = (unsigned)(R * K + C) * 2u; }
    const size_t kstep = (size_t)(BK * 2);
    const size_t hstep = (size_t)HALF * K * 2;
    const size_t tstep = 2 * hstep;
    const unsigned ldsw = (unsigned)wid * 1024u;
    const int aoff = lds_byte(wr * 64 + fr, fq * 8), boff = lds_byte(wc * 32 + fr, fq * 8);
#define PG8_SA(b, h) (((b) * 2 + (h)) * HTB)
#define PG8_SB(b, h) ((4 + (b) * 2 + (h)) * HTB)
#define PG8_STAGE(bufoff, gbase, voff) do { _Pragma("unroll") for (int _i = 0; _i < 2; ++_i) \
        __builtin_amdgcn_global_load_lds((const unsigned*)((const char*)(gbase) + (voff)[_i]), (LAS unsigned*)(lds + (bufoff) + ldsw + _i * 8192), 16, 0, 0); } while (0)
#define PG8_LDA(dst, b, h) do { _Pragma("unroll") for (int m = 0; m < 4; ++m) _Pragma("unroll") for (int k = 0; k < 2; ++k) dst[m][k] = *(const LAS bf16x8*)(lds + PG8_SA(b, h) + aoff + m * 2048 + k * 1024); } while (0)
#define PG8_LDB(dst, b, h) do { _Pragma("unroll") for (int n = 0; n < 2; ++n) _Pragma("unroll") for (int k = 0; k < 2; ++k) dst[n][k] = *(const LAS bf16x8*)(lds + PG8_SB(b, h) + boff + n * 2048 + k * 1024); } while (0)
#define PG8_MMA(ai, bj, At, Bt) do { __builtin_amdgcn_s_setprio(1); _Pragma("unroll") for (int m = 0; m < 4; ++m) _Pragma("unroll") for (int n = 0; n < 2; ++n) _Pragma("unroll") for (int k = 0; k < 2; ++k) \
        acc[ai][bj][m][n] = __builtin_amdgcn_mfma_f32_16x16x32_bf16(Bt[n][k], At[m][k], acc[ai][bj][m][n], 0, 0, 0); __builtin_amdgcn_s_setprio(0); } while (0)
#define PG8_WAIT_V(n) asm volatile("s_waitcnt vmcnt(" #n ")" ::: "memory")
#define PG8_WAIT_L(n) asm volatile("s_waitcnt lgkmcnt(" #n ")" ::: "memory")
#define PG8_BAR __builtin_amdgcn_s_barrier()
#define PG8_SCHED __builtin_amdgcn_sched_barrier(0)
    Unit cur, nxt; int ui = 0;
    if (!S.next(0, cur)) return;
    f32x4 acc[2][2][4][2];
#pragma unroll
    for (int a = 0; a < 2; ++a)
#pragma unroll
        for (int b = 0; b < 2; ++b)
#pragma unroll
            for (int m = 0; m < 4; ++m)
#pragma unroll
                for (int n = 0; n < 2; ++n) acc[a][b][m][n] = (f32x4){0.f, 0.f, 0.f, 0.f};
    bf16x8 At[4][2], B0[2][2], B1[2][2];
    const char* cA = (const char*)g.A + (size_t)cur.pm * tstep; const char* cB = (const char*)g.Bt + (size_t)cur.pn * tstep;
    PG8_STAGE(PG8_SB(0, 0), cB, voffA); PG8_STAGE(PG8_SB(0, 1), cB + hstep, voffA); PG8_STAGE(PG8_SA(0, 0), cA, voffA); PG8_STAGE(PG8_SA(0, 1), cA + hstep, voffA);
    if (wr == 1) PG8_BAR;
    PG8_WAIT_V(2); PG8_BAR;
    PG8_STAGE(PG8_SB(1, 0), cB + kstep, voffA); PG8_STAGE(PG8_SA(1, 0), cA + kstep, voffA); PG8_STAGE(PG8_SB(1, 1), cB + hstep + kstep, voffA);
    PG8_WAIT_V(6); PG8_BAR;
    for (;;) {
        const bool has_next = S.next(ui + 1, nxt);
        const char* nA = has_next ? (const char*)g.A + (size_t)nxt.pm * tstep : cA; const char* nB = has_next ? (const char*)g.Bt + (size_t)nxt.pn * tstep : cB;
        for (int t = 0; t < nt; t += 2) {
            const bool last = (t == nt - 2);
            const char* a1 = cA + (size_t)(t + 1) * kstep;
            const char* a2 = last ? nA : cA + (size_t)(t + 2) * kstep; const char* b2 = last ? nB : cB + (size_t)(t + 2) * kstep;
            const char* a3 = a2 + kstep; const char* b3 = b2 + kstep;
            PG8_LDB(B0, 0, 0); PG8_LDB(B1, 0, 1); PG8_SCHED; PG8_LDA(At, 0, 0); PG8_STAGE(PG8_SA(1, 1), a1 + hstep, voffA);
            PG8_WAIT_V(8); PG8_WAIT_L(0); PG8_BAR; PG8_MMA(0, 0, At, B0); PG8_MMA(0, 1, At, B1); PG8_BAR; PG8_SCHED;
            PG8_LDA(At, 0, 1); PG8_STAGE(PG8_SB(0, 0), b2, voffA); PG8_STAGE(PG8_SB(0, 1), b2 + hstep, voffA); PG8_STAGE(PG8_SA(0, 0), a2, voffA);
            PG8_WAIT_V(8); PG8_WAIT_L(0); PG8_BAR; PG8_MMA(1, 0, At, B0); PG8_MMA(1, 1, At, B1); PG8_BAR; PG8_SCHED;
            PG8_LDB(B0, 1, 0); PG8_LDB(B1, 1, 1); PG8_SCHED; PG8_LDA(At, 1, 0); PG8_STAGE(PG8_SA(0, 1), a2 + hstep, voffA);
            PG8_WAIT_V(8); PG8_WAIT_L(0); PG8_BAR; PG8_MMA(0, 0, At, B0); PG8_MMA(0, 1, At, B1); PG8_BAR; PG8_SCHED;
            PG8_LDA(At, 1, 1); PG8_STAGE(PG8_SB(1, 0), b3, voffA); PG8_STAGE(PG8_SB(1, 1), b3 + hstep, voffA); PG8_STAGE(PG8_SA(1, 0), a3, voffA);
            PG8_WAIT_V(8); PG8_WAIT_L(0); PG8_BAR; PG8_MMA(1, 0, At, B0); PG8_MMA(1, 1, At, B1); PG8_BAR; PG8_SCHED;
        }
        if constexpr (ALIGN_EPI) { if (wr == 0) PG8_BAR; }
        E(acc, cur, wr, wc, fr, fq);
        if (!has_next) break;
#pragma unroll
        for (int a = 0; a < 2; ++a)
#pragma unroll
            for (int b = 0; b < 2; ++b)
#pragma unroll
                for (int m = 0; m < 4; ++m)
#pragma unroll
                    for (int n = 0; n < 2; ++n) acc[a][b][m][n] = (f32x4){0.f, 0.f, 0.f, 0.f};
        cur = nxt; cA = nA; cB = nB; ++ui;
        if constexpr (ALIGN_EPI) { if (wr == 1) PG8_BAR; }
    }
    PG8_WAIT_V(0);
    if constexpr (!ALIGN_EPI) { if (wr == 0) PG8_BAR; }
    PG8_BAR;
#undef PG8_SA
#undef PG8_SB
#undef PG8_STAGE
#undef PG8_LDA
#undef PG8_LDB
#undef PG8_MMA
#undef PG8_WAIT_V
#undef PG8_WAIT_L
#undef PG8_BAR
#undef PG8_SCHED
}

struct EpiSwiglu {
    bf16_t* H;
    __device__ __forceinline__ void operator()(const f32x4 (&acc)[2][2][4][2], const Unit& u, int wr, int wc, int fr, int fq) const {
        const int row0 = u.pm * BM + wr * 64 + fr, col0 = u.pn * 128 + wc * 32 + 4 * fq;
#pragma unroll
        for (int ai = 0; ai < 2; ++ai)
#pragma unroll
            for (int m = 0; m < 4; ++m) { bf16_t* rowp = H + (size_t)(row0 + ai * HALF + m * 16) * FF + col0;
#pragma unroll
                for (int n = 0; n < 2; ++n) { const f32x4 gt = acc[ai][0][m][n], up = acc[ai][1][m][n];
                    u32x2 w; w.x = pk2(siluf_(gt[0]) * up[0], siluf_(gt[1]) * up[1]); w.y = pk2(siluf_(gt[2]) * up[2], siluf_(gt[3]) * up[3]);
                    *(u32x2*)(rowp + n * 16) = w; } }
    }
};
struct EpiRes {
    const float* res_lat; const float* res_ctx; float* out_lat; float* out_ctx; const float* gate; float coef;
    __device__ __forceinline__ void operator()(const f32x4 (&acc)[2][2][4][2], const Unit& u, int wr, int wc, int fr, int fq) const {
        const bool isctx = u.pm >= 64; const int mr = isctx ? 4 : (u.pm >> 4);
        const int lrow0 = (isctx ? (u.pm - 64) : u.pm) * BM + wr * 64 + fr, col0 = u.pn * BM + wc * 32 + 4 * fq;
        const float* res = isctx ? res_ctx : res_lat; float* out = isctx ? out_ctx : out_lat;
        const float* gp = gate + (size_t)mr * NMOD + col0;
        f32x4 gv[2][2];
#pragma unroll
        for (int bj = 0; bj < 2; ++bj)
#pragma unroll
            for (int n = 0; n < 2; ++n) gv[bj][n] = *(const f32x4*)(gp + bj * HALF + n * 16) * coef;
#pragma unroll
        for (int ai = 0; ai < 2; ++ai)
#pragma unroll
            for (int m = 0; m < 4; ++m) { const size_t ro = (size_t)(lrow0 + ai * HALF + m * 16) * D + col0;
#pragma unroll
                for (int bj = 0; bj < 2; ++bj)
#pragma unroll
                    for (int n = 0; n < 2; ++n) { const f32x4 r = *(const f32x4*)(res + ro + bj * HALF + n * 16);
                        *(f32x4*)(out + ro + bj * HALF + n * 16) = r + gv[bj][n] * acc[ai][bj][m][n]; } }
    }
};
struct EpiIn {
    bf16_t* PA; bf16_t* PB; float* BA;
    __device__ __forceinline__ void operator()(const f32x4 (&acc)[2][2][4][2], const Unit& u, int wr, int wc, int fr, int fq) const {
        const int row0 = u.pm * BM + wr * 64 + fr;
        if (u.pn == 12) {
            if (wc == 0) {
#pragma unroll
                for (int ai = 0; ai < 2; ++ai)
#pragma unroll
                    for (int m = 0; m < 4; ++m) *(f32x4*)(BA + (size_t)(row0 + ai * HALF + m * 16) * 16 + 4 * fq) = acc[ai][0][m][0];
            }
            return;
        }
        bf16_t* base = (u.pn < 6) ? PA : PB; const int col0 = (u.pn % 6) * BM + wc * 32 + 4 * fq;
#pragma unroll
        for (int ai = 0; ai < 2; ++ai)
#pragma unroll
            for (int m = 0; m < 4; ++m) { bf16_t* rowp = base + (size_t)(row0 + ai * HALF + m * 16) * 1536 + col0;
#pragma unroll
                for (int bj = 0; bj < 2; ++bj)
#pragma unroll
                    for (int n = 0; n < 2; ++n) { const f32x4 v = acc[ai][bj][m][n]; u32x2 w; w.x = pk2(v[0], v[1]); w.y = pk2(v[2], v[3]); *(u32x2*)(rowp + bj * HALF + n * 16) = w; } }
    }
};
}

__device__ __forceinline__ void transpose_item(const float* W, int N, int k0, int src_col0, int nvalid, bf16_t* WT, int Kp, int dst_row0, float* scr, int lane) {
#pragma unroll 8
    for (int i = 0; i < 32; ++i) { const int kk = 2 * i + (lane >> 5), n = lane & 31; scr[kk * 33 + n] = (n < nvalid) ? W[(size_t)(k0 + kk) * N + src_col0 + n] : 0.f; }
    LDS_WAIT();
    const int c = lane & 7;
#pragma unroll
    for (int j = 0; j < 4; ++j) { const int n = (lane >> 3) + 8 * j; const float* s = scr + (8 * c) * 33 + n;
        u32x4 o; o.x = pk2(s[0 * 33], s[1 * 33]); o.y = pk2(s[2 * 33], s[3 * 33]); o.z = pk2(s[4 * 33], s[5 * 33]); o.w = pk2(s[6 * 33], s[7 * 33]);
        *(u32x4*)(WT + (size_t)(dst_row0 + n) * Kp + k0 + 8 * c) = o; }
    LDS_WAIT();
}

struct Ptrs {
    const float *x, *c, *ctx, *cctx, *w_ada, *b_ada, *norm_g, *w1, *w3, *w2, *w_in, *w_out, *gconv, *galog, *gdtb, *gnormw, *lconv, *lconvb, *lwg, *lbg, *llam, *fng;
    float* out; unsigned char* ws;
};

__device__ __forceinline__ void phase_prologue(const Ptrs& P, unsigned char* lds, int tid, int lane, int wave, int bid, int G) {
    float* mods = (float*)(P.ws + WS_MODS);
    {
        float* sc = (float*)lds;
        for (int i = tid; i < 5 * D; i += 512) { const int r = i >> 10, k = i & 1023; const float v = (r < 4) ? P.c[r * D + k] : P.cctx[k]; sc[i] = siluf_(v); }
        __syncthreads();
        float* red = (float*)(lds + 20480);
        for (int it = bid; it < NMOD / 64; it += G) {
            const int n0 = it * 64, cq = tid & 15, kl = tid >> 4;
            float acc[5][4];
#pragma unroll
            for (int r = 0; r < 5; ++r)
#pragma unroll
                for (int j = 0; j < 4; ++j) acc[r][j] = 0.f;
#pragma unroll 4
            for (int i = 0; i < 32; ++i) { const int k = kl + 32 * i; const f32x4 w = *(const f32x4*)(P.w_ada + (size_t)k * NMOD + n0 + 4 * cq);
#pragma unroll
                for (int r = 0; r < 5; ++r) { const float s = sc[r * D + k];
#pragma unroll
                    for (int j = 0; j < 4; ++j) acc[r][j] += s * w[j]; } }
#pragma unroll
            for (int r = 0; r < 5; ++r)
#pragma unroll
                for (int j = 0; j < 4; ++j) red[(kl * 16 + cq) * 20 + r * 4 + j] = acc[r][j];
            __syncthreads();
            if (tid < 320) { const int cq2 = tid / 20, rj = tid % 20; float s = 0.f;
                for (int k2 = 0; k2 < 32; ++k2) s += red[(k2 * 16 + cq2) * 20 + rj];
                const int r = rj >> 2, n = n0 + 4 * cq2 + (rj & 3); mods[r * NMOD + n] = s + P.b_ada[n]; }
            __syncthreads();
        }
        __syncthreads();
    }
    {
        float* scr = (float*)(lds + wave * 16384);
        const int gw = bid * 8 + wave, NGW = G * 8;
        bf16_t* W1A = (bf16_t*)(P.ws + WS_W1A); bf16_t* W2A = (bf16_t*)(P.ws + WS_W2A); bf16_t* W1B = (bf16_t*)(P.ws + WS_W1B); bf16_t* W2B = (bf16_t*)(P.ws + WS_W2B);
        bf16_t* WIN = (bf16_t*)(P.ws + WS_WIN); bf16_t* WOUT = (bf16_t*)(P.ws + WS_WOUT);
        constexpr int I_UP = 16 * 88, I_DN = 44 * 32, I_IN = 16 * 97, I_OUT = 16 * 32;
        constexpr int NITEMS = 6 * I_UP + I_IN + I_OUT;
        static_assert(I_UP == I_DN, "item counts");
        for (int it = gw; it < NITEMS; it += NGW) {
            int r = it;
            if (r < 6 * I_UP) {
                const int seg = r / I_UP; r -= seg * I_UP; const int layer = seg / 3, kind = seg % 3;
                if (kind < 2) { const int kb = r / 88, nbk = r % 88, sc0 = 32 * nbk; const float* W = (kind == 0 ? P.w1 : P.w3) + (size_t)layer * D * FF;
                    transpose_item(W, FF, 64 * kb, sc0, 32, layer ? W1B : W1A, D, 256 * (sc0 / 128) + (sc0 % 128) + (kind ? 128 : 0), scr, lane); }
                else { const int kb = r / 32, nbk = r % 32; transpose_item(P.w2 + (size_t)layer * FF * D, D, 64 * kb, 32 * nbk, 32, layer ? W2B : W2A, FF, 32 * nbk, scr, lane); }
                continue;
            }
            r -= 6 * I_UP;
            if (r < I_IN) { const int kb = r / 97, g = r % 97;
                if (g < 64) transpose_item(P.w_in, IN_COLS, 64 * kb, 32 * g, 32, WIN, D, 32 * g, scr, lane);
                else if (g < 96) transpose_item(P.w_in, IN_COLS, 64 * kb, 2064 + 32 * (g - 64), 32, WIN, D, 2048 + 32 * (g - 64), scr, lane);
                else transpose_item(P.w_in, IN_COLS, 64 * kb, 2048, 16, WIN, D, 3072, scr, lane);
                continue; }
            r -= I_IN;
            { const int kb = r / 32, nbk = r % 32; transpose_item(P.w_out, D, 64 * kb, 32 * nbk, 32, WOUT, D, 32 * nbk, scr, lane); }
        }
        u32x4* z = (u32x4*)(WIN + (size_t)3104 * D);
        for (int i = bid * 512 + tid; i < 224 * D * 2 / 16; i += G * 512) z[i] = (u32x4){0u, 0u, 0u, 0u};
    }
}

__device__ __forceinline__ void phase_norm_mod(const float* src_lat, const float* src_ctx, int nrows, const float* g, const float* mods, int shift_idx, int scale_idx, bf16_t* U, int gw, int NGW, int lane) {
    for (int m = gw; m < nrows; m += NGW) {
        const float* xrow = (m < M_LAT) ? src_lat + (size_t)m * D : src_ctx + (size_t)(m - M_LAT) * D;
        const int mr = (m < M_LAT) ? (m >> 12) : 4;
        const float* sh = mods + (size_t)mr * NMOD + shift_idx * D; const float* sc = mods + (size_t)mr * NMOD + scale_idx * D;
        f32x4 v[4]; float ss = 0.f;
#pragma unroll
        for (int j = 0; j < 4; ++j) { v[j] = *(const f32x4*)(xrow + 4 * lane + 256 * j); ss += (v[j][0] * v[j][0] + v[j][1] * v[j][1]) + (v[j][2] * v[j][2] + v[j][3] * v[j][3]); }
        const float rstd = rsqrtf(wave_sum(ss) * (1.f / D) + EPS);
#pragma unroll
        for (int j = 0; j < 4; ++j) { const int col = 4 * lane + 256 * j;
            const f32x4 gv = *(const f32x4*)(g + col), sv = *(const f32x4*)(sc + col), hv = *(const f32x4*)(sh + col);
            const f32x4 y = v[j] * rstd * gv * (sv + 1.f) + hv;
            u32x2 w; w.x = pk2(y[0], y[1]); w.y = pk2(y[2], y[3]); *(u32x2*)(U + (size_t)m * D + col) = w; }
    }
}

constexpr int KP = 132;
__device__ __attribute__((noinline)) void gdn_solve(const LAS float* src, const LAS float* scl, const LAS float* A, bf16_t* dst, int base, int stride) {
    float x[64];
#pragma unroll
    for (int i = 0; i < 64; ++i) x[i] = 0.f;
#pragma unroll
    for (int i = 0; i < 64; ++i) {
        float s0 = src[base + i * stride] * scl[i], s1 = 0.f, s2 = 0.f, s3 = 0.f;
#pragma unroll
        for (int j4 = 0; j4 < (i + 3) / 4; ++j4) { const f32x4 av = *(const LAS f32x4*)(A + i * 64 + 4 * j4);
            s0 -= av[0] * x[4 * j4]; s1 -= av[1] * x[4 * j4 + 1]; s2 -= av[2] * x[4 * j4 + 2]; s3 -= av[3] * x[4 * j4 + 3]; }
        x[i] = (s0 + s1) + (s2 + s3);
        dst[i * 128] = (bf16_t)f2bf(x[i]);
    }
}
__device__ __forceinline__ void gdn_prep_item(const Ptrs& P, unsigned char* lds, int item, int tid, int lane, int wave) {
    const int b = item / (4 * NCH), h = (item / NCH) & 3, cn = item % NCH;
    const bool isctx = cn < 4; const int cl = isctx ? cn : cn - 4, L = isctx ? CTXL : SEQ;
    const int rowbase = isctx ? M_LAT + b * CTXL : b * SEQ;
    const bf16_t* PA = (const bf16_t*)(P.ws + WS_PA); const float* BA = (const float*)(P.ws + WS_BA);
    int lo_ = 0; asm volatile("" : "+v"(lo_));
    float* KF = (float*)(lds + lo_); float* QF = (float*)(lds + lo_ + 33792); float* VF = (float*)(lds + lo_ + 67584);
    float* KKN = (float*)(lds + lo_ + 101376); float* QKN = (float*)(lds + lo_ + 118016);
    float* GS = (float*)(lds + lo_ + 134656);
    float* RB = GS + 128;
    float* RBE = GS + 256;
    float* AD = QF;
    {
        const int c = tid & 127, tg = tid >> 7;
#pragma unroll
        for (int mat = 0; mat < 3; ++mat) {
            const int ch = mat * 512 + h * 128 + c;
            const float w0 = P.gconv[ch], w1 = P.gconv[1536 + ch], w2 = P.gconv[2 * 1536 + ch], w3 = P.gconv[3 * 1536 + ch];
            const int t0 = cl * 64 + tg * 16;
            const bf16_t* src = PA + (size_t)rowbase * 1536 + ch;
            float xm2 = (t0 - 2 >= 0) ? bf2f(src[(size_t)(t0 - 2) * 1536]) : 0.f;
            float xm1 = (t0 - 1 >= 0) ? bf2f(src[(size_t)(t0 - 1) * 1536]) : 0.f;
            float x0 = bf2f(src[(size_t)t0 * 1536]);
            float* dst = (mat == 0 ? QF : (mat == 1 ? KF : VF)) + (tg * 16) * KP + c;
#pragma unroll 4
            for (int i = 0; i < 16; ++i) { const int t = t0 + i; const float xp1 = (t + 1 < L) ? bf2f(src[(size_t)(t + 1) * 1536]) : 0.f;
                const float y = w0 * xm2 + w1 * xm1 + w2 * x0 + w3 * xp1; dst[i * KP] = siluf_(y); xm2 = xm1; xm1 = x0; x0 = xp1; }
        }
    }
    if (tid < 128) {
        const int d = tid >> 6, i = lane, r = d ? 63 - i : i;
        const float* ba = BA + (size_t)(rowbase + cl * 64 + r) * 16;
        const float beta = sigmoidf_(ba[d * 4 + h]);
        float gg = -__expf(P.galog[d * 4 + h]) * softplusf_(ba[(2 + d) * 4 + h] + P.gdtb[d * 4 + h]);
#pragma unroll
        for (int o = 1; o < 64; o <<= 1) { const float t = __shfl_up(gg, o); if (lane >= o) gg += t; }
        GS[d * 64 + i] = gg; RB[d * 64 + i] = beta; RBE[d * 64 + i] = beta * __expf(gg);
        ((float*)(P.ws + WS_GC))[((size_t)((d * 4 + b) * 4 + h) * NCH + cn) * 64 + i] = gg;
    }
    __syncthreads();
    {
        bf16_t* QG = (bf16_t*)(P.ws + WS_QG) + ((size_t)((b * 4 + h) * NCH + cn) * 64) * 128;
        bf16_t* KG = (bf16_t*)(P.ws + WS_KG) + ((size_t)((b * 4 + h) * NCH + cn) * 64) * 128;
#pragma unroll
        for (int tt = 0; tt < 8; ++tt) { const int tok = wave * 8 + tt;
            f32x2 q = *(f32x2*)(QF + tok * KP + 2 * lane), k = *(f32x2*)(KF + tok * KP + 2 * lane);
            const float sq = wave_sum(q[0] * q[0] + q[1] * q[1]), sk = wave_sum(k[0] * k[0] + k[1] * k[1]);
            q = q * (rsqrtf(sq + EPS) * 0.08838834764831845f); k = k * rsqrtf(sk + EPS);
            *(f32x2*)(QF + tok * KP + 2 * lane) = q; *(f32x2*)(KF + tok * KP + 2 * lane) = k;
            *(unsigned*)(QG + tok * 128 + 2 * lane) = pk2(q[0], q[1]); *(unsigned*)(KG + tok * 128 + 2 * lane) = pk2(k[0], k[1]); }
    }
    __syncthreads();
    {
        const int tp = tid & 255, ti = tp >> 4, tj = tp & 15; const float* X = (tid < 256) ? KF : QF; float* OUT = (tid < 256) ? KKN : QKN;
        float acc[4][4];
#pragma unroll
        for (int a = 0; a < 4; ++a)
#pragma unroll
            for (int c = 0; c < 4; ++c) acc[a][c] = 0.f;
#pragma unroll 2
        for (int kq = 0; kq < 32; ++kq) {
            f32x4 av[4], bv[4];
#pragma unroll
            for (int a = 0; a < 4; ++a) { av[a] = *(const f32x4*)(X + (ti + 16 * a) * KP + 4 * kq); bv[a] = *(const f32x4*)(KF + (tj + 16 * a) * KP + 4 * kq); }
#pragma unroll
            for (int a = 0; a < 4; ++a)
#pragma unroll
                for (int c = 0; c < 4; ++c) acc[a][c] += (av[a][0] * bv[c][0] + av[a][1] * bv[c][1]) + (av[a][2] * bv[c][2] + av[a][3] * bv[c][3]);
        }
#pragma unroll
        for (int a = 0; a < 4; ++a)
#pragma unroll
            for (int c = 0; c < 4; ++c) OUT[(ti + 16 * a) * 65 + tj + 16 * c] = acc[a][c];
    }
    __syncthreads();
    {
        const int d = tid >> 8, tp = tid & 255;
        bf16_t* ATT = (bf16_t*)(P.ws + WS_ATT) + ((size_t)((d * 4 + b) * 4 + h) * NCH + cn) * 4096;
#pragma unroll 4
        for (int e = 0; e < 16; ++e) { const int idx = tp + 256 * e, i = idx >> 6, j = idx & 63, ri = d ? 63 - i : i, rj = d ? 63 - j : j;
            const float dec = (i >= j) ? __expf(GS[d * 64 + i] - GS[d * 64 + j]) : 0.f;
            AD[d * 4096 + idx] = (i > j) ? RB[d * 64 + i] * KKN[ri * 65 + rj] * dec : 0.f;
            ATT[idx] = (bf16_t)f2bf(QKN[ri * 65 + rj] * dec); }
    }
    __syncthreads();
    {
        const int d = tid >> 8, c = tid & 255;
        const float* src = (c < 128) ? VF + c : KF + (c - 128); const float* scl = ((c < 128) ? RB : RBE) + d * 64;
        bf16_t* dst = (bf16_t*)(P.ws + (c < 128 ? WS_UB : WS_WB)) + ((size_t)((d * 4 + b) * 4 + h) * NCH + cn) * 64 * 128 + (c & 127);
        int sb_ = d ? 63 * KP : 0, ss_ = d ? -KP : KP; asm volatile("" : "+v"(sb_), "+v"(ss_));
        gdn_solve((const LAS float*)src, (const LAS float*)scl, (const LAS float*)(AD + d * 4096), dst, sb_, ss_);
    }
    __syncthreads();
}

__device__ __forceinline__ int chunk_of(int d, int s) { return d ? (s < 4 ? 3 - s : 67 - (s - 4)) : s; }
constexpr int TP = 272, AP = 144;
__device__ __forceinline__ bf16x8 ldfrag(const unsigned char* base, int row, int pitch, int kbyte) { return *(const bf16x8*)(base + row * pitch + kbyte); }
__device__ __forceinline__ void gdn_scan_item(const Ptrs& P, unsigned char* lds, int item, int tid, int lane, int wave) {
    const int chain = item & 31, slice = item >> 5, d = chain >> 4, b = (chain >> 2) & 3, h = chain & 3, e0 = slice * 32;
    unsigned char* Wl = lds; unsigned char* Ql = lds + 17408; unsigned char* Kl = lds + 34816; unsigned char* ATl = lds + 52224;
    unsigned char* St = lds + 61440; unsigned char* Vt = lds + 70144; unsigned char* Vdt = lds + 74752; float* gcs = (float*)(lds + 79360);
    const bf16_t* WBp = (const bf16_t*)(P.ws + WS_WB) + (size_t)((d * 4 + b) * 4 + h) * NCH * 8192;
    const bf16_t* UBp = (const bf16_t*)(P.ws + WS_UB) + (size_t)((d * 4 + b) * 4 + h) * NCH * 8192;
    const bf16_t* ATp = (const bf16_t*)(P.ws + WS_ATT) + (size_t)((d * 4 + b) * 4 + h) * NCH * 4096;
    const float* GCp = (const float*)(P.ws + WS_GC) + (size_t)((d * 4 + b) * 4 + h) * NCH * 64;
    const bf16_t* QGp = (const bf16_t*)(P.ws + WS_QG) + (size_t)(b * 4 + h) * NCH * 8192;
    const bf16_t* KGp = (const bf16_t*)(P.ws + WS_KG) + (size_t)(b * 4 + h) * NCH * 8192;
    bf16_t* Op = (bf16_t*)(P.ws + (d ? WS_OB : WS_OF));
    const int fr = lane & 15, fq = lane >> 4, mt = wave & 3, nt = wave >> 2;
    for (int i = tid; i < 8704 / 4; i += 512) ((unsigned*)St)[i] = 0u;
    f32x4 Sacc[2] = {(f32x4){0.f, 0.f, 0.f, 0.f}, (f32x4){0.f, 0.f, 0.f, 0.f}};
    u32x4 rw[2], rq[2], rk[2], ra; float rg = 0.f; bf16_t ru[4];
#define SCAN_PREFETCH(s_) do { const int cn_ = chunk_of(d, s_); \
        const u32x4* w4 = (const u32x4*)(WBp + (size_t)cn_ * 8192); const u32x4* q4 = (const u32x4*)(QGp + (size_t)cn_ * 8192); const u32x4* k4 = (const u32x4*)(KGp + (size_t)cn_ * 8192); \
        rw[0] = w4[tid]; rw[1] = w4[tid + 512]; rq[0] = q4[tid]; rq[1] = q4[tid + 512]; rk[0] = k4[tid]; rk[1] = k4[tid + 512]; \
        ra = ((const u32x4*)(ATp + (size_t)cn_ * 4096))[tid]; if (tid < 64) rg = GCp[cn_ * 64 + tid]; \
        { const bf16_t* up_ = UBp + (size_t)cn_ * 8192 + (mt * 16 + fq * 4) * 128 + e0 + nt * 16 + fr; ru[0] = up_[0]; ru[1] = up_[128]; ru[2] = up_[256]; ru[3] = up_[384]; } } while (0)
    SCAN_PREFETCH(0);
    for (int s = 0; s < NCH; ++s) {
        const int cn = chunk_of(d, s); const bool lat = cn >= 4;
#pragma unroll
        for (int i = 0; i < 2; ++i) { const int idx = tid + 512 * i, row = idx >> 4, cc = idx & 15;
            *(u32x4*)(Wl + row * TP + cc * 16) = rw[i]; *(u32x4*)(Ql + row * TP + cc * 16) = rq[i]; *(u32x4*)(Kl + row * TP + cc * 16) = rk[i]; }
        *(u32x4*)(ATl + (tid >> 3) * AP + (tid & 7) * 16) = ra;
        if (tid < 64) gcs[tid] = rg;
        float uv[4];
#pragma unroll
        for (int jj = 0; jj < 4; ++jj) uv[jj] = bf2f(ru[jj]);
        __syncthreads();
        if (s + 1 < NCH) SCAN_PREFETCH(s + 1);
        const float glast = gcs[63];
        f32x4 acc_a = (f32x4){0.f, 0.f, 0.f, 0.f}, acc_b = (f32x4){0.f, 0.f, 0.f, 0.f};
        { const int qrow = d ? 63 - (mt * 16 + fr) : (mt * 16 + fr);
#pragma unroll
          for (int ks = 0; ks < 4; ++ks) { const bf16x8 bs = ldfrag(St, nt * 16 + fr, TP, ks * 64 + fq * 16);
              const bf16x8 aw = ldfrag(Wl, mt * 16 + fr, TP, ks * 64 + fq * 16);
              acc_a = __builtin_amdgcn_mfma_f32_16x16x32_bf16(aw, bs, acc_a, 0, 0, 0);
              if (lat) { const bf16x8 aq = ldfrag(Ql, qrow, TP, ks * 64 + fq * 16); acc_b = __builtin_amdgcn_mfma_f32_16x16x32_bf16(aq, bs, acc_b, 0, 0, 0); } } }
        { float vn[4], vd[4];
#pragma unroll
          for (int jj = 0; jj < 4; ++jj) { const float gi = gcs[mt * 16 + fq * 4 + jj]; vn[jj] = uv[jj] - acc_a[jj]; vd[jj] = vn[jj] * __expf(glast - gi); acc_b[jj] *= __expf(gi); }
          u32x2 w; w.x = pk2(vn[0], vn[1]); w.y = pk2(vn[2], vn[3]); *(u32x2*)(Vt + (nt * 16 + fr) * AP + (mt * 16 + fq * 4) * 2) = w;
          w.x = pk2(vd[0], vd[1]); w.y = pk2(vd[2], vd[3]); *(u32x2*)(Vdt + (nt * 16 + fr) * AP + (mt * 16 + fq * 4) * 2) = w; }
        __syncthreads();
        if (lat) {
#pragma unroll
            for (int ks = 0; ks < 2; ++ks) { const bf16x8 aa = ldfrag(ATl, mt * 16 + fr, AP, ks * 64 + fq * 16); const bf16x8 bv = ldfrag(Vt, nt * 16 + fr, AP, ks * 64 + fq * 16);
                acc_b = __builtin_amdgcn_mfma_f32_16x16x32_bf16(aa, bv, acc_b, 0, 0, 0); }
            bf16_t* op = Op + (size_t)(b * SEQ + (cn - 4) * 64) * 512 + h * 128 + e0 + nt * 16 + fr;
#pragma unroll
            for (int jj = 0; jj < 4; ++jj) { const int i = mt * 16 + fq * 4 + jj, tok = d ? 63 - i : i; op[(size_t)tok * 512] = (bf16_t)f2bf(acc_b[jj]); }
        }
        { const float eg = __expf(glast);
          bf16x8 ak[2];
#pragma unroll
          for (int ks = 0; ks < 2; ++ks)
#pragma unroll
              for (int jj = 0; jj < 8; ++jj) { const int i = ks * 32 + fq * 8 + jj, row = d ? 63 - i : i; ak[ks][jj] = (short)*(const bf16_t*)(Kl + row * TP + (16 * wave + fr) * 2); }
#pragma unroll
          for (int n2 = 0; n2 < 2; ++n2) { f32x4 a = Sacc[n2] * eg;
#pragma unroll
              for (int ks = 0; ks < 2; ++ks) { const bf16x8 bv = ldfrag(Vdt, n2 * 16 + fr, AP, ks * 64 + fq * 16); a = __builtin_amdgcn_mfma_f32_16x16x32_bf16(ak[ks], bv, a, 0, 0, 0); }
              Sacc[n2] = a;
              u32x2 w; w.x = pk2(a[0], a[1]); w.y = pk2(a[2], a[3]); *(u32x2*)(St + (n2 * 16 + fr) * TP + (16 * wave + fq * 4) * 2) = w; } }
        __syncthreads();
    }
#undef SCAN_PREFETCH
}

__device__ __forceinline__ void gdn_prep_phase(const Ptrs& P, unsigned char* lds, int tid, int lane, int wave, int bid, int G) {
    const bf16_t* PA = (const bf16_t*)(P.ws + WS_PA); const float* BA = (const float*)(P.ws + WS_BA);
    unsigned char* RAW = lds;
    float* QF = (float*)lds;
    unsigned char* Kb = lds + 33792;
    unsigned char* ATs = lds;
    float* AD = (float*)(lds + 18432);
    float* KF = (float*)(lds + 51456); float* VF = (float*)(lds + 85248);
    unsigned char* Qb = lds + 119040;
    float* GS = (float*)(lds + 136448); float* RB = GS + 128; float* RBE = GS + 256;
    const int fr = lane & 15, fq = lane >> 4;
    u32x4 pr[7]; float pba0 = 0.f, pba1 = 0.f;
#define PREP_DECODE(it_, b_, h_, cn_) const int b_ = (it_) / (4 * NCH), h_ = ((it_) / NCH) & 3, cn_ = (it_) % NCH;
#define PREP_PREFETCH(it_) do { PREP_DECODE(it_, pb_, ph_, pcn_) const bool pctx_ = pcn_ < 4; const int pcl_ = pctx_ ? pcn_ : pcn_ - 4, pL_ = pctx_ ? CTXL : SEQ, prb_ = pctx_ ? M_LAT + pb_ * CTXL : pb_ * SEQ; \
        _Pragma("unroll") for (int e_ = 0; e_ < 7; ++e_) { const int q_ = tid + 512 * e_, mat_ = q_ / 1072, rem_ = q_ - mat_ * 1072, row_ = rem_ >> 4, t_ = pcl_ * 64 - 2 + row_; \
            pr[e_] = (q_ < 3216 && t_ >= 0 && t_ < pL_) ? *(const u32x4*)(PA + (size_t)(prb_ + t_) * 1536 + mat_ * 512 + ph_ * 128 + (rem_ & 15) * 8) : (u32x4){0u, 0u, 0u, 0u}; } \
        if (tid < 128) { const int d_ = tid >> 6, r_ = d_ ? 63 - lane : lane; const float* ba_ = BA + (size_t)(prb_ + pcl_ * 64 + r_) * 16; pba0 = ba_[d_ * 4 + ph_]; pba1 = ba_[(2 + d_) * 4 + ph_]; } } while (0)
    if (bid < NB * 4 * NCH) PREP_PREFETCH(bid);
    for (int it = bid; it < NB * 4 * NCH; it += G) {
        PREP_DECODE(it, b, h, cn)
        int lo_ = 0; asm volatile("" : "+v"(lo_));
        const int c = tid & 127, tg = tid >> 7;
        float cw[3][4];
#pragma unroll
        for (int mat = 0; mat < 3; ++mat)
#pragma unroll
            for (int k = 0; k < 4; ++k) cw[mat][k] = P.gconv[k * 1536 + mat * 512 + h * 128 + c];
#pragma unroll
        for (int e = 0; e < 7; ++e) { const int q = tid + 512 * e; if (q < 3216) { const int mat = q / 1072, rem = q - mat * 1072; *(u32x4*)(RAW + lo_ + (mat * 67 + (rem >> 4)) * 256 + (rem & 15) * 16) = pr[e]; } }
        const float ba0 = pba0, ba1 = pba1;
        __syncthreads();
        if (it + G < NB * 4 * NCH) PREP_PREFETCH(it + G);
        if (tid < 128) {
            const int d = tid >> 6, i = lane;
            const float beta = sigmoidf_(ba0);
            float gg = -__expf(P.galog[d * 4 + h]) * softplusf_(ba1 + P.gdtb[d * 4 + h]);
#pragma unroll
            for (int o = 1; o < 64; o <<= 1) { const float t = __shfl_up(gg, o); if (lane >= o) gg += t; }
            GS[lo_ + d * 64 + i] = gg; RB[lo_ + d * 64 + i] = beta; RBE[lo_ + d * 64 + i] = beta * __expf(gg);
            ((float*)(P.ws + WS_GC))[((size_t)((d * 4 + b) * 4 + h) * NCH + cn) * 64 + i] = gg;
        }
        float yq[16];
        {
#pragma unroll
            for (int mat = 0; mat < 3; ++mat) {
                const bf16_t* rp = (const bf16_t*)(RAW + lo_ + (mat * 67 + tg * 16) * 256) + c;
                float xm2 = bf2f(rp[0]), xm1 = bf2f(rp[128]), x0 = bf2f(rp[256]);
#pragma unroll
                for (int i = 0; i < 16; ++i) { const float xp1 = bf2f(rp[(i + 3) * 128]);
                    const float y = siluf_(cw[mat][0] * xm2 + cw[mat][1] * xm1 + cw[mat][2] * x0 + cw[mat][3] * xp1);
                    if (mat == 0) yq[i] = y; else if (mat == 1) KF[lo_ + (tg * 16 + i) * KP + c] = y; else VF[lo_ + (tg * 16 + i) * KP + c] = y;
                    xm2 = xm1; xm1 = x0; x0 = xp1; }
            }
        }
        __syncthreads();
#pragma unroll
        for (int i = 0; i < 16; ++i) QF[lo_ + (tg * 16 + i) * KP + c] = yq[i];
        __syncthreads();
        {
            bf16_t* QG = (bf16_t*)(P.ws + WS_QG) + ((size_t)((b * 4 + h) * NCH + cn) * 64) * 128;
            bf16_t* KG = (bf16_t*)(P.ws + WS_KG) + ((size_t)((b * 4 + h) * NCH + cn) * 64) * 128;
#pragma unroll
            for (int tt = 0; tt < 8; ++tt) { const int tok = wave * 8 + tt;
                f32x2 q = *(f32x2*)(QF + lo_ + tok * KP + 2 * lane), k = *(f32x2*)(KF + lo_ + tok * KP + 2 * lane);
                const float sq = wave_sum(q[0] * q[0] + q[1] * q[1]), sk = wave_sum(k[0] * k[0] + k[1] * k[1]);
                q = q * (rsqrtf(sq + EPS) * 0.08838834764831845f); k = k * rsqrtf(sk + EPS);
                *(f32x2*)(KF + lo_ + tok * KP + 2 * lane) = k;
                const unsigned qp = pk2(q[0], q[1]), kp = pk2(k[0], k[1]);
                *(unsigned*)(Qb + lo_ + tok * TP + 4 * lane) = qp; *(unsigned*)(Kb + lo_ + tok * TP + 4 * lane) = kp;
                *(unsigned*)(QG + tok * 128 + 2 * lane) = qp; *(unsigned*)(KG + tok * 128 + 2 * lane) = kp; }
        }
        __syncthreads();
        const int mi = wave & 3, njp = wave >> 2;
        f32x4 ckk[2], cqk[2];
        ckk[0] = ckk[1] = cqk[0] = cqk[1] = (f32x4){0.f, 0.f, 0.f, 0.f};
#pragma unroll
        for (int ks = 0; ks < 4; ++ks) { const bf16x8 aK = ldfrag(Kb + lo_, mi * 16 + fr, TP, ks * 64 + fq * 16), aQ = ldfrag(Qb + lo_, mi * 16 + fr, TP, ks * 64 + fq * 16);
#pragma unroll
            for (int n2 = 0; n2 < 2; ++n2) { const bf16x8 bK = ldfrag(Kb + lo_, (njp * 2 + n2) * 16 + fr, TP, ks * 64 + fq * 16);
                ckk[n2] = __builtin_amdgcn_mfma_f32_16x16x32_bf16(aK, bK, ckk[n2], 0, 0, 0); cqk[n2] = __builtin_amdgcn_mfma_f32_16x16x32_bf16(aQ, bK, cqk[n2], 0, 0, 0); } }
        __syncthreads();
#pragma unroll
        for (int n2 = 0; n2 < 2; ++n2)
#pragma unroll
            for (int jj = 0; jj < 4; ++jj) { const int r = mi * 16 + fq * 4 + jj, sc = (njp * 2 + n2) * 16 + fr;
                const float e0 = __expf(GS[lo_ + r] - GS[lo_ + sc]), e1 = __expf(GS[lo_ + 64 + 63 - r] - GS[lo_ + 64 + 63 - sc]);
                const float kkv = ckk[n2][jj], qkv = cqk[n2][jj];
                AD[lo_ + r * 64 + sc] = (r > sc) ? RB[lo_ + r] * kkv * e0 : 0.f;
                AD[lo_ + 4096 + (63 - r) * 64 + (63 - sc)] = (r < sc) ? RB[lo_ + 64 + 63 - r] * kkv * e1 : 0.f;
                *(bf16_t*)(ATs + lo_ + r * 144 + sc * 2) = (bf16_t)f2bf((r >= sc) ? qkv * e0 : 0.f);
                *(bf16_t*)(ATs + lo_ + 9216 + (63 - r) * 144 + (63 - sc) * 2) = (bf16_t)f2bf((r <= sc) ? qkv * e1 : 0.f); }
        __syncthreads();
#pragma unroll
        for (int e = 0; e < 2; ++e) { const int idx = tid + 512 * e, d = idx >> 9, row = (idx >> 3) & 63, cc = idx & 7;
            bf16_t* ATT = (bf16_t*)(P.ws + WS_ATT) + ((size_t)((d * 4 + b) * 4 + h) * NCH + cn) * 4096;
            *(u32x4*)(ATT + row * 64 + cc * 8) = *(const u32x4*)(ATs + lo_ + d * 9216 + row * 144 + cc * 16); }
        {
            const int d = tid >> 8, cc = tid & 255;
            const float* src = (cc < 128) ? VF + lo_ + cc : KF + lo_ + (cc - 128); const float* scl = ((cc < 128) ? RB : RBE) + lo_ + d * 64;
            bf16_t* dst = (bf16_t*)(P.ws + (cc < 128 ? WS_UB : WS_WB)) + ((size_t)((d * 4 + b) * 4 + h) * NCH + cn) * 64 * 128 + (cc & 127);
            int sb_ = d ? 63 * KP : 0, ss_ = d ? -KP : KP; asm volatile("" : "+v"(sb_), "+v"(ss_));
            gdn_solve((const LAS float*)src, (const LAS float*)scl, (const LAS float*)(AD + lo_ + d * 4096), dst, sb_, ss_);
        }
        __syncthreads();
    }
#undef PREP_DECODE
#undef PREP_PREFETCH
}

template <int MODE>
__device__ __forceinline__ void lru_item(const Ptrs& P, unsigned char* lds, int b, int cn, int nb, int tid, int lane, int wave) {
    const bool isctx = cn < 4; const int cl = isctx ? cn : cn - 4, L = isctx ? CTXL : SEQ, s0 = cl * 64;
    const bf16_t* PB = (const bf16_t*)(P.ws + WS_PB);
    float* xin = (float*)lds;
    float* xT = (float*)(lds + 17408);
    float* wg = (float*)(lds + 34816);
    f32x2* seg = (f32x2*)(lds + 100352);
#define rowof(s_) (isctx ? (size_t)(M_LAT + b * CTXL + (s_)) : (size_t)(b * SEQ + ((s_) & 63) * 64 + ((s_) >> 6)))
    for (int idx = tid; idx < 67 * 64; idx += 512) { const int si = idx >> 6, c = idx & 63, s = s0 - 2 + si;
        xin[idx] = (s >= 0 && s < L) ? bf2f(PB[rowof(s) * 1536 + 512 + nb * 64 + c]) : 0.f; }
    for (int idx = tid; idx < 4 * 4096; idx += 512) { const int dg = idx >> 12; wg[idx] = P.lwg[((size_t)dg * 8 + nb) * 4096 + (idx & 4095)]; }
    __syncthreads();
    { const int c = tid & 63, ig = tid >> 6, ch = nb * 64 + c;
      const float w0 = P.lconv[ch], w1 = P.lconv[512 + ch], w2 = P.lconv[1024 + ch], w3 = P.lconv[1536 + ch], bias = P.lconvb[ch];
#pragma unroll
      for (int ii = 0; ii < 8; ++ii) { const int i = ig * 8 + ii; xT[c * 68 + i] = bias + w0 * xin[i * 64 + c] + w1 * xin[(i + 1) * 64 + c] + w2 * xin[(i + 2) * 64 + c] + w3 * xin[(i + 3) * 64 + c]; } }
    __syncthreads();
    const int co = tid & 63, ig = tid >> 6, ch = nb * 64 + co;
    float acc[4][8];
#pragma unroll
    for (int q = 0; q < 4; ++q)
#pragma unroll
        for (int ii = 0; ii < 8; ++ii) acc[q][ii] = 0.f;
#pragma unroll 4
    for (int ci = 0; ci < 64; ++ci) { const f32x4 xa = *(const f32x4*)(xT + ci * 68 + ig * 8), xb = *(const f32x4*)(xT + ci * 68 + ig * 8 + 4);
        float wv[4];
#pragma unroll
        for (int q = 0; q < 4; ++q) wv[q] = wg[q * 4096 + ci * 64 + co];
#pragma unroll
        for (int q = 0; q < 4; ++q) {
#pragma unroll
            for (int ii = 0; ii < 4; ++ii) { acc[q][ii] += wv[q] * xa[ii]; acc[q][ii + 4] += wv[q] * xb[ii]; } } }
    float av[2][8], bv[2][8];
#pragma unroll
    for (int d = 0; d < 2; ++d) { const float bgr = P.lbg[(d * 2 + 0) * 512 + ch], bgi = P.lbg[(d * 2 + 1) * 512 + ch], sp = softplusf_(-P.llam[d * 512 + ch]);
#pragma unroll
        for (int ii = 0; ii < 8; ++ii) { const int i = ig * 8 + ii; const float xv = xT[co * 68 + i];
            const float r = sigmoidf_(acc[d * 2][ii] + bgr), ing = sigmoidf_(acc[d * 2 + 1][ii] + bgi), la = -8.f * sp * r;
            float mult = sqrtf(-expm1f(2.f * la));
            if (isctx && ((d == 0 && cn == 0 && i == 0) || (d == 1 && cn == 3 && i == 63))) mult = 1.f;
            av[d][ii] = __expf(la); bv[d][ii] = mult * ing * xv; } }
    { float A0 = 1.f, B0 = 0.f, A1 = 1.f, B1 = 0.f;
#pragma unroll
      for (int ii = 0; ii < 8; ++ii) { B0 = av[0][ii] * B0 + bv[0][ii]; A0 *= av[0][ii]; B1 = av[1][7 - ii] * B1 + bv[1][7 - ii]; A1 *= av[1][7 - ii]; }
      seg[(ig * 2 + 0) * 64 + co] = (f32x2){A0, B0}; seg[(ig * 2 + 1) * 64 + co] = (f32x2){A1, B1}; }
    __syncthreads();
    if constexpr (MODE == 0) {
        if (tid < 128) { const int d = tid >> 6; float At = 1.f, Bt = 0.f;
#pragma unroll
            for (int k = 0; k < 8; ++k) { const int sg = d ? 7 - k : k; const f32x2 v = seg[(sg * 2 + d) * 64 + co]; Bt = v[0] * Bt + v[1]; At *= v[0]; }
            ((f32x2*)(P.ws + WS_LSUM))[((size_t)(b * 2 + d) * NCH + cn) * 512 + ch] = (f32x2){At, Bt}; }
    } else {
        const float* CAR = (const float*)(P.ws + WS_LCAR);
        float hf = CAR[((size_t)(b * 2 + 0) * NCH + cn) * 512 + ch], hb = CAR[((size_t)(b * 2 + 1) * NCH + cn) * 512 + ch];
        for (int k = 0; k < ig; ++k) { const f32x2 v = seg[(k * 2 + 0) * 64 + co]; hf = v[0] * hf + v[1]; }
        for (int k = 7; k > ig; --k) { const f32x2 v = seg[(k * 2 + 1) * 64 + co]; hb = v[0] * hb + v[1]; }
        float o[8];
#pragma unroll
        for (int ii = 0; ii < 8; ++ii) { hf = av[0][ii] * hf + bv[0][ii]; o[ii] = hf; }
#pragma unroll
        for (int ii = 7; ii >= 0; --ii) { hb = av[1][ii] * hb + bv[1][ii]; o[ii] += hb; }
        bf16_t* MIX = (bf16_t*)(P.ws + WS_MIX);
#pragma unroll
        for (int ii = 0; ii < 8; ++ii) { const size_t row = rowof(s0 + ig * 8 + ii); const float gt = bf2f(PB[row * 1536 + 1024 + ch]);
            MIX[row * D + 512 + ch] = (bf16_t)f2bf(o[ii] * geluf_(gt)); }
    }
    __syncthreads();
#undef rowof
}
template <int MODE>
__device__ __forceinline__ void lru_phase(const Ptrs& P, unsigned char* lds, int tid, int lane, int wave, int bid, int G) {
    const int nb = bid & 7, slot = bid >> 3, nslots = G >> 3;
    const bf16_t* PB = (const bf16_t*)(P.ws + WS_PB);
    unsigned char* Wt = lds;
    float* xin = (float*)(lds + 36864);
    unsigned char* xb = lds + 54016;
    float* xc = (float*)(lds + 63232);
    f32x2* seg = (f32x2*)(lds + 80640);
    unsigned char* gtl = lds + 97024;
    unsigned char* otl = lds + 106240;
    for (int idx = tid; idx < 4 * 4096; idx += 512) { const int dg = idx >> 12, ci = (idx >> 6) & 63, co = idx & 63;
        *(bf16_t*)(Wt + dg * 9216 + co * 144 + ci * 2) = (bf16_t)f2bf(P.lwg[((size_t)dg * 8 + nb) * 4096 + (idx & 4095)]); }
    const int fr = lane & 15, fq = lane >> 4, nt = wave & 3, mh = wave >> 2;
    const int cch = nb * 64 + (tid & 63);
    const float cw0 = P.lconv[cch], cw1 = P.lconv[512 + cch], cw2 = P.lconv[1024 + cch], cw3 = P.lconv[1536 + cch], cbias = P.lconvb[cch];
    const int co = nt * 16 + fr, ch = nb * 64 + co;
    float bgr[2], bgi[2], sp[2];
#pragma unroll
    for (int d = 0; d < 2; ++d) { bgr[d] = P.lbg[(d * 2 + 0) * 512 + ch]; bgi[d] = P.lbg[(d * 2 + 1) * 512 + ch]; sp[d] = -8.f * softplusf_(-P.llam[d * 512 + ch]); }
    const int nitems = (MODE == 0) ? NB * NCH : NB * 64;
    u32x4 px[2], pg; px[0] = px[1] = pg = (u32x4){0u, 0u, 0u, 0u};
#define LRU_DECODE(j_, b_, cn_) const int b_ = (MODE == 0) ? (j_) / NCH : (j_) >> 6; const int cn_ = (MODE == 0) ? (j_) % NCH : 4 + ((j_) & 63);
#define LRU_ROW(b_, cn_, s_) ((cn_) < 4 ? (size_t)(M_LAT + (b_) * CTXL + (s_)) : (size_t)((b_) * SEQ + ((s_) & 63) * 64 + ((s_) >> 6)))
#define LRU_PREFETCH(j_) do { LRU_DECODE(j_, pb_, pcn_) const int pL_ = pcn_ < 4 ? CTXL : SEQ, ps0_ = (pcn_ < 4 ? pcn_ : pcn_ - 4) * 64; \
        _Pragma("unroll") for (int e_ = 0; e_ < 2; ++e_) { const int q_ = tid + 512 * e_, si_ = q_ >> 3, s_ = ps0_ - 2 + si_; \
            px[e_] = (q_ < 536 && s_ >= 0 && s_ < pL_) ? *(const u32x4*)(PB + LRU_ROW(pb_, pcn_, s_) * 1536 + 512 + nb * 64 + (q_ & 7) * 8) : (u32x4){0u, 0u, 0u, 0u}; } \
        if (MODE == 1) { const int i_ = tid >> 3; pg = *(const u32x4*)(PB + LRU_ROW(pb_, pcn_, ps0_ + i_) * 1536 + 1024 + nb * 64 + (tid & 7) * 8); } } while (0)
    if (slot < nitems) LRU_PREFETCH(slot);
    __syncthreads();
    for (int j = slot; j < nitems; j += nslots) {
        LRU_DECODE(j, b, cn)
        const bool isctx = cn < 4; const int s0 = (isctx ? cn : cn - 4) * 64;
#pragma unroll
        for (int e = 0; e < 2; ++e) { const int q = tid + 512 * e; if (q < 536) { float* dst = xin + (q >> 3) * 64 + (q & 7) * 8;
#pragma unroll
            for (int k = 0; k < 4; ++k) { dst[2 * k] = bf2f(px[e][k] & 0xffffu); dst[2 * k + 1] = bf2f(px[e][k] >> 16); } } }
        if (MODE == 1) *(u32x4*)(gtl + (tid >> 3) * 144 + (tid & 7) * 16) = pg;
        __syncthreads();
        if (j + nslots < nitems) LRU_PREFETCH(j + nslots);
        { const int c = tid & 63, ig = tid >> 6;
#pragma unroll
          for (int ii = 0; ii < 8; ++ii) { const int i = ig * 8 + ii; const float v = cbias + cw0 * xin[i * 64 + c] + cw1 * xin[(i + 1) * 64 + c] + cw2 * xin[(i + 2) * 64 + c] + cw3 * xin[(i + 3) * 64 + c];
              xc[i * 68 + c] = v; *(bf16_t*)(xb + i * 144 + c * 2) = (bf16_t)f2bf(v); } }
        __syncthreads();
        f32x4 acc[2][4];
#pragma unroll
        for (int m2 = 0; m2 < 2; ++m2)
#pragma unroll
            for (int dg = 0; dg < 4; ++dg) acc[m2][dg] = (f32x4){0.f, 0.f, 0.f, 0.f};
#pragma unroll
        for (int ks = 0; ks < 2; ++ks) { bf16x8 af[2];
#pragma unroll
            for (int m2 = 0; m2 < 2; ++m2) af[m2] = ldfrag(xb, (mh * 2 + m2) * 16 + fr, 144, ks * 64 + fq * 16);
#pragma unroll
            for (int dg = 0; dg < 4; ++dg) { const bf16x8 bfr = ldfrag(Wt + dg * 9216, nt * 16 + fr, 144, ks * 64 + fq * 16);
#pragma unroll
                for (int m2 = 0; m2 < 2; ++m2) acc[m2][dg] = __builtin_amdgcn_mfma_f32_16x16x32_bf16(af[m2], bfr, acc[m2][dg], 0, 0, 0); } }
        float av[2][2][4], bv[2][2][4];
#pragma unroll
        for (int m2 = 0; m2 < 2; ++m2)
#pragma unroll
            for (int jj = 0; jj < 4; ++jj) { const int i = (mh * 2 + m2) * 16 + fq * 4 + jj; const float xv = xc[i * 68 + co];
#pragma unroll
                for (int d = 0; d < 2; ++d) { const float r = sigmoidf_(acc[m2][d * 2][jj] + bgr[d]), ing = sigmoidf_(acc[m2][d * 2 + 1][jj] + bgi[d]), la = sp[d] * r;
                    float mult = sqrtf(-expm1f(2.f * la));
                    if (isctx && ((d == 0 && cn == 0 && i == 0) || (d == 1 && cn == 3 && i == 63))) mult = 1.f;
                    av[d][m2][jj] = __expf(la); bv[d][m2][jj] = mult * ing * xv; } }
#pragma unroll
        for (int m2 = 0; m2 < 2; ++m2) { const int sg = (mh * 2 + m2) * 4 + fq; float A0 = 1.f, B0 = 0.f, A1 = 1.f, B1 = 0.f;
#pragma unroll
            for (int jj = 0; jj < 4; ++jj) { B0 = av[0][m2][jj] * B0 + bv[0][m2][jj]; A0 *= av[0][m2][jj]; B1 = av[1][m2][3 - jj] * B1 + bv[1][m2][3 - jj]; A1 *= av[1][m2][3 - jj]; }
            seg[(sg * 2 + 0) * 64 + co] = (f32x2){A0, B0}; seg[(sg * 2 + 1) * 64 + co] = (f32x2){A1, B1}; }
        __syncthreads();
        if constexpr (MODE == 0) {
            if (tid < 128) { const int d = tid >> 6, c2 = tid & 63; float At = 1.f, Bt = 0.f;
#pragma unroll
                for (int k = 0; k < 16; ++k) { const int sg = d ? 15 - k : k; const f32x2 v = seg[(sg * 2 + d) * 64 + c2]; Bt = v[0] * Bt + v[1]; At *= v[0]; }
                ((f32x2*)(P.ws + WS_LSUM))[((size_t)(b * 2 + d) * NCH + cn) * 512 + nb * 64 + c2] = (f32x2){At, Bt}; }
        } else {
            const float* CAR = (const float*)(P.ws + WS_LCAR);
            float hf = CAR[((size_t)(b * 2 + 0) * NCH + cn) * 512 + ch], hb = CAR[((size_t)(b * 2 + 1) * NCH + cn) * 512 + ch];
            const int sg0 = (mh * 2) * 4 + fq;
            for (int k = 0; k < sg0; ++k) { const f32x2 v = seg[(k * 2 + 0) * 64 + co]; hf = v[0] * hf + v[1]; }
            for (int k = 15; k > sg0 + 4; --k) { const f32x2 v = seg[(k * 2 + 1) * 64 + co]; hb = v[0] * hb + v[1]; }
            float o[2][4];
#pragma unroll
            for (int jj = 0; jj < 4; ++jj) { hf = av[0][0][jj] * hf + bv[0][0][jj]; o[0][jj] = hf; }
#pragma unroll
            for (int k = 1; k < 4; ++k) { const f32x2 v = seg[((sg0 + k) * 2 + 0) * 64 + co]; hf = v[0] * hf + v[1]; }
#pragma unroll
            for (int jj = 0; jj < 4; ++jj) { hf = av[0][1][jj] * hf + bv[0][1][jj]; o[1][jj] = hf; }
#pragma unroll
            for (int jj = 3; jj >= 0; --jj) { hb = av[1][1][jj] * hb + bv[1][1][jj]; o[1][jj] += hb; }
#pragma unroll
            for (int k = 3; k >= 1; --k) { const f32x2 v = seg[((sg0 + k) * 2 + 1) * 64 + co]; hb = v[0] * hb + v[1]; }
#pragma unroll
            for (int jj = 3; jj >= 0; --jj) { hb = av[1][0][jj] * hb + bv[1][0][jj]; o[0][jj] += hb; }
#pragma unroll
            for (int m2 = 0; m2 < 2; ++m2)
#pragma unroll
                for (int jj = 0; jj < 4; ++jj) { const int i = (mh * 2 + m2) * 16 + fq * 4 + jj; const float gt = bf2f(*(const bf16_t*)(gtl + i * 144 + co * 2));
                    *(bf16_t*)(otl + i * 144 + co * 2) = (bf16_t)f2bf(o[m2][jj] * geluf_(gt)); }
            __syncthreads();
            { const int i = tid >> 3; bf16_t* MIX = (bf16_t*)(P.ws + WS_MIX);
              *(u32x4*)(MIX + LRU_ROW(b, cn, s0 + i) * D + 512 + nb * 64 + (tid & 7) * 8) = *(const u32x4*)(otl + i * 144 + (tid & 7) * 16); }
        }
        __syncthreads();
    }
#undef LRU_DECODE
#undef LRU_ROW
#undef LRU_PREFETCH
}
__device__ __forceinline__ void lru_carry(const Ptrs& P, int gt) {
    const int b = gt >> 10, d = (gt >> 9) & 1, ch = gt & 511;
    const f32x2* SUM = (const f32x2*)(P.ws + WS_LSUM) + (size_t)(b * 2 + d) * NCH * 512 + ch; float* CAR = (float*)(P.ws + WS_LCAR) + (size_t)(b * 2 + d) * NCH * 512 + ch;
    float carry = 0.f;
    for (int s0 = 0; s0 < NCH; s0 += 17) {
        f32x2 v[17];
#pragma unroll
        for (int k = 0; k < 17; ++k) v[k] = SUM[(size_t)chunk_of(d, s0 + k) * 512];
#pragma unroll
        for (int k = 0; k < 17; ++k) { CAR[(size_t)chunk_of(d, s0 + k) * 512] = carry; carry = v[k][0] * carry + v[k][1]; }
    }
}

__device__ __forceinline__ void gdn_combine(const Ptrs& P, int gw, int NGW, int lane) {
    const bf16_t* OF = (const bf16_t*)(P.ws + WS_OF); const bf16_t* OB = (const bf16_t*)(P.ws + WS_OB); const bf16_t* PB = (const bf16_t*)(P.ws + WS_PB); bf16_t* MIX = (bf16_t*)(P.ws + WS_MIX);
    float nw[8];
#pragma unroll
    for (int j = 0; j < 8; ++j) nw[j] = P.gnormw[(lane * 8 + j) & 127];
    for (int m = gw; m < M_LAT; m += NGW) {
        const u32x4 a = *(const u32x4*)(OF + (size_t)m * 512 + lane * 8), c = *(const u32x4*)(OB + (size_t)m * 512 + lane * 8), z = *(const u32x4*)(PB + (size_t)m * 1536 + lane * 8);
        float o[8], zz[8]; float ss = 0.f;
#pragma unroll
        for (int j = 0; j < 4; ++j) { o[2 * j] = bf2f(a[j] & 0xffffu) + bf2f(c[j] & 0xffffu); o[2 * j + 1] = bf2f(a[j] >> 16) + bf2f(c[j] >> 16); zz[2 * j] = bf2f(z[j] & 0xffffu); zz[2 * j + 1] = bf2f(z[j] >> 16); }
#pragma unroll
        for (int j = 0; j < 8; ++j) ss += o[j] * o[j];
        ss += __shfl_xor(ss, 1); ss += __shfl_xor(ss, 2); ss += __shfl_xor(ss, 4); ss += __shfl_xor(ss, 8);
        const float rs = rsqrtf(ss * (1.f / 128.f) + EPS);
        u32x4 w;
        w.x = pk2(o[0] * rs * nw[0] * siluf_(zz[0]), o[1] * rs * nw[1] * siluf_(zz[1])); w.y = pk2(o[2] * rs * nw[2] * siluf_(zz[2]), o[3] * rs * nw[3] * siluf_(zz[3]));
        w.z = pk2(o[4] * rs * nw[4] * siluf_(zz[4]), o[5] * rs * nw[5] * siluf_(zz[5])); w.w = pk2(o[6] * rs * nw[6] * siluf_(zz[6]), o[7] * rs * nw[7] * siluf_(zz[7]));
        *(u32x4*)(MIX + (size_t)m * D + lane * 8) = w;
    }
}

#define RLX_AGENT __ATOMIC_RELAXED, __HIP_MEMORY_SCOPE_AGENT
#define XB_TMO      128
#define XB_XCNT(j)  (256  + 64 * (j))
#define XB_XSUB(j)  (1280 + 64 * (j))
#define XB_XGEN(j)  (2304 + 64 * (j))
#define XB_TOP      3328
#define XB_TOPGEN   3392
#define XCD_BAR_WORDS 3456
#define XB_SPIN_CAP (1u << 18)

__device__ __forceinline__ unsigned xb_ld(unsigned* p)              { return __hip_atomic_load(p, __ATOMIC_RELAXED, __HIP_MEMORY_SCOPE_AGENT); }
__device__ __forceinline__ unsigned xb_add(unsigned* p, unsigned v) { return __hip_atomic_fetch_add(p, v, __ATOMIC_RELAXED, __HIP_MEMORY_SCOPE_AGENT); }
__device__ __forceinline__ unsigned xb_xcc_id() { return (unsigned)__builtin_amdgcn_s_getreg((3 << 11) | 20) & 0xFu; }
#define XB_SPIN(cond, bar) do { unsigned _sp = 0; while (cond) { __builtin_amdgcn_s_sleep(1); \
    if ((++_sp & 255u) == 0u) { if (xb_ld(&(bar)[XB_TMO])) break; if (_sp > XB_SPIN_CAP) { atomicAdd(&(bar)[XB_TMO], 1u); break; } } } } while (0)

struct XcdBarrier {
    unsigned* bar; unsigned x;
    volatile LAS unsigned* st;
};

__device__ __forceinline__ XcdBarrier xcd_barrier_post(unsigned* bar, volatile LAS unsigned* st) {
    XcdBarrier b; b.bar = bar; b.x = xb_xcc_id(); b.st = st;
    if (threadIdx.x == 0) (void)xb_add(&bar[XB_XCNT(b.x)], 1u);
    return b;
}
__device__ __forceinline__ void xcd_barrier_complete(unsigned* bar, unsigned x, unsigned& nloc, unsigned& nx) {
    const unsigned G = gridDim.x * gridDim.y * gridDim.z;
    unsigned sum, cnt, mine, sp = 0u;
    for (;;) {
        sum = 0u; cnt = 0u; mine = 0u;
#pragma unroll
        for (unsigned j = 0; j < 16; ++j) { const unsigned c = xb_ld(&bar[XB_XCNT(j)]); sum += c; cnt += (c > 0u) ? 1u : 0u; mine = (j == x) ? c : mine; }
        if (sum == G) break;
        __builtin_amdgcn_s_sleep(1);
        if ((++sp & 255u) == 0u) { if (xb_ld(&bar[XB_TMO])) break; if (sp > XB_SPIN_CAP) { atomicAdd(&bar[XB_TMO], 1u); break; } }
    }
    nloc = mine > 0u ? mine : 1u; nx = cnt > 0u ? cnt : 1u;
}

__device__ __forceinline__ void xcd_barrier(const XcdBarrier& b) {
    asm volatile("s_waitcnt vmcnt(0)" ::: "memory");
    __syncthreads();
    if (threadIdx.x == 0) {
        unsigned* bar = b.bar;
        __builtin_amdgcn_s_waitcnt(0);
        unsigned nloc = b.st[0], nx = b.st[1];
        if (nloc == 0u) { xcd_barrier_complete(bar, b.x, nloc, nx); b.st[0] = nloc; b.st[1] = nx; }
        const unsigned old = xb_add(&bar[XB_XSUB(b.x)], 1u);
        const unsigned gen = old / nloc;
        if (old + 1u == (gen + 1u) * nloc) {
            __builtin_amdgcn_fence(__ATOMIC_RELEASE, "agent");
            asm volatile("s_waitcnt vmcnt(0)" ::: "memory");
            const unsigned og = xb_add(&bar[XB_TOP], 1u);
            const unsigned tg = og / nx;
            if (og + 1u == (tg + 1u) * nx) xb_add(&bar[XB_TOPGEN], 1u);
            else XB_SPIN(xb_ld(&bar[XB_TOPGEN]) == tg, bar);
            __builtin_amdgcn_fence(__ATOMIC_ACQUIRE, "agent");
            xb_add(&bar[XB_XGEN(b.x)], 1u);
            asm volatile("s_waitcnt vmcnt(0)" ::: "memory");
        } else {
            XB_SPIN(xb_ld(&bar[XB_XGEN(b.x)]) == gen, bar);
            __builtin_amdgcn_fence(__ATOMIC_ACQUIRE, "agent");
            asm volatile("s_waitcnt vmcnt(0)" ::: "memory");
        }
    }
    __syncthreads();
}


struct Args { const float* in[22]; float* out; unsigned char* ws; int ph_lo, ph_hi; };
constexpr int N_PHASES = 14;

__global__ void __launch_bounds__(512, 2) fwd_kernel(Args args) {
    extern __shared__ __attribute__((aligned(16))) unsigned char lds[];
    const int tid = threadIdx.x, lane = tid & 63, wave = __builtin_amdgcn_readfirstlane(tid >> 6);
    const int G = gridDim.x, bid = blockIdx.x, gw = bid * 8 + wave, NGW = G * 8;
    Ptrs P;
    P.x = args.in[0]; P.c = args.in[1]; P.ctx = args.in[2]; P.cctx = args.in[3]; P.w_ada = args.in[4]; P.b_ada = args.in[5]; P.norm_g = args.in[6];
    P.w1 = args.in[7]; P.w3 = args.in[8]; P.w2 = args.in[9]; P.w_in = args.in[10]; P.w_out = args.in[11]; P.gconv = args.in[12]; P.galog = args.in[13]; P.gdtb = args.in[14];
    P.gnormw = args.in[15]; P.lconv = args.in[16]; P.lconvb = args.in[17]; P.lwg = args.in[18]; P.lbg = args.in[19]; P.llam = args.in[20]; P.fng = args.in[21];
    P.out = args.out; P.ws = args.ws;
    unsigned char* ws = args.ws;
    const float* mods = (const float*)(ws + WS_MODS);
    bf16_t* U = (bf16_t*)(ws + WS_U); bf16_t* HID = (bf16_t*)(ws + WS_HID); float* H1CTX = (float*)(ws + WS_H1CTX);
    LAS unsigned char* ldsl = (LAS unsigned char*)lds;
    const int lo = args.ph_lo, hi = args.ph_hi;
#ifndef REP_MASK
#define REP_MASK 0
#endif
#ifndef SKIP_MASK
#define SKIP_MASK 0
#endif
#define IN(k) (!((SKIP_MASK >> (k)) & 1) && lo <= (k) && (k) < hi)
#define SEAM(k) do { if (IN(k) && IN((k) + 1)) { if ((k) == 0) cg::this_grid().sync(); else xcd_barrier(bar); } } while (0)
    volatile LAS unsigned* MISC = (volatile LAS unsigned*)(ldsl + LDS_BYTES - 64);
    if (tid == 0) { MISC[0] = 0u; MISC[1] = 0u; }
    __syncthreads();
    XcdBarrier bar = xcd_barrier_post((unsigned*)ws + 4096, MISC);

    if (IN(0)) for (int rep_ = 0; rep_ < 1 + ((REP_MASK >> 0) & 1); ++rep_) { if (rep_) __syncthreads(); phase_prologue(P, lds, tid, lane, wave, bid, G); } SEAM(0);
    if (IN(1)) for (int rep_ = 0; rep_ < 1 + ((REP_MASK >> 1) & 1); ++rep_) { if (rep_) __syncthreads(); phase_norm_mod(P.x, P.ctx, M_TOT, P.norm_g, mods, 0, 1, U, gw, NGW, lane); } SEAM(1);
    if (IN(2)) for (int rep_ = 0; rep_ < 1 + ((REP_MASK >> 2) & 1); ++rep_) { if (rep_) __syncthreads(); pg8::Gemm g{U, (const bf16_t*)(ws + WS_W1A), M_TOT, 2 * FF, D}; pg8::StaticOrder S; S.init(M_TOT, 2 * FF, G, bid); pg8::EpiSwiglu E{HID};
        pg8::gemm_phase<pg8::EpiSwiglu, true>(ldsl, g, S, E); } SEAM(2);
    if (IN(3)) for (int rep_ = 0; rep_ < 1 + ((REP_MASK >> 3) & 1); ++rep_) { if (rep_) __syncthreads(); pg8::Gemm g{HID, (const bf16_t*)(ws + WS_W2A), M_TOT, D, FF}; pg8::StaticOrder S; S.init(M_TOT, D, G, bid);
        pg8::EpiRes E{P.x, P.ctx, P.out, H1CTX, mods + 2 * D, 0.5f}; pg8::gemm_phase<pg8::EpiRes, true>(ldsl, g, S, E); } SEAM(3);
    if (IN(4)) for (int rep_ = 0; rep_ < 1 + ((REP_MASK >> 4) & 1); ++rep_) { if (rep_) __syncthreads(); phase_norm_mod(P.out, H1CTX, M_TOT, P.norm_g + D, mods, 3, 4, U, gw, NGW, lane); } SEAM(4);
    if (IN(5)) for (int rep_ = 0; rep_ < 1 + ((REP_MASK >> 5) & 1); ++rep_) { if (rep_) __syncthreads(); pg8::Gemm g{U, (const bf16_t*)(ws + WS_WIN), M_TOT, NIN, D}; pg8::StaticOrder S; S.init(M_TOT, NIN, G, bid);
        pg8::EpiIn E{(bf16_t*)(ws + WS_PA), (bf16_t*)(ws + WS_PB), (float*)(ws + WS_BA)}; pg8::gemm_phase<pg8::EpiIn, true>(ldsl, g, S, E); } SEAM(5);
    if (IN(6)) for (int rep_ = 0; rep_ < 1 + ((REP_MASK >> 6) & 1); ++rep_) { if (rep_) __syncthreads();
        gdn_prep_phase(P, lds, tid, lane, wave, bid, G);
        __syncthreads(); lru_phase<0>(P, lds, tid, lane, wave, bid, G);
    } SEAM(6);
    if (IN(7)) for (int rep_ = 0; rep_ < 1 + ((REP_MASK >> 7) & 1); ++rep_) { if (rep_) __syncthreads();
        for (int j = 0; j < 8; ++j) if ((G - 1 - j) % G == bid) lru_carry(P, j * 512 + tid);
        for (int it = bid; it < 128; it += G) { gdn_scan_item(P, lds, it, tid, lane, wave); __syncthreads(); }
    } SEAM(7);
    if (IN(8)) for (int rep_ = 0; rep_ < 1 + ((REP_MASK >> 8) & 1); ++rep_) { if (rep_) __syncthreads();
        gdn_combine(P, gw, NGW, lane);
        __syncthreads(); lru_phase<1>(P, lds, tid, lane, wave, bid, G);
    } SEAM(8);
    if (IN(9)) for (int rep_ = 0; rep_ < 1 + ((REP_MASK >> 9) & 1); ++rep_) { if (rep_) __syncthreads(); pg8::Gemm g{(const bf16_t*)(ws + WS_MIX), (const bf16_t*)(ws + WS_WOUT), M_LAT, D, D}; pg8::StaticOrder S; S.init(M_LAT, D, G, bid);
        pg8::EpiRes E{P.out, P.out, P.out, P.out, mods + 5 * D, 1.0f}; pg8::gemm_phase<pg8::EpiRes, true>(ldsl, g, S, E); } SEAM(9);
    if (IN(10)) for (int rep_ = 0; rep_ < 1 + ((REP_MASK >> 10) & 1); ++rep_) { if (rep_) __syncthreads(); phase_norm_mod(P.out, P.out, M_LAT, P.norm_g + 2 * D, mods, 6, 7, U, gw, NGW, lane); } SEAM(10);
    if (IN(11)) for (int rep_ = 0; rep_ < 1 + ((REP_MASK >> 11) & 1); ++rep_) { if (rep_) __syncthreads(); pg8::Gemm g{U, (const bf16_t*)(ws + WS_W1B), M_LAT, 2 * FF, D}; pg8::StaticOrder S; S.init(M_LAT, 2 * FF, G, bid); pg8::EpiSwiglu E{HID};
        pg8::gemm_phase<pg8::EpiSwiglu, true>(ldsl, g, S, E); } SEAM(11);
    if (IN(12)) for (int rep_ = 0; rep_ < 1 + ((REP_MASK >> 12) & 1); ++rep_) { if (rep_) __syncthreads(); pg8::Gemm g{HID, (const bf16_t*)(ws + WS_W2B), M_LAT, D, FF}; pg8::StaticOrder S; S.init(M_LAT, D, G, bid);
        pg8::EpiRes E{P.out, P.out, P.out, P.out, mods + 8 * D, 0.5f}; pg8::gemm_phase<pg8::EpiRes, true>(ldsl, g, S, E); } SEAM(12);
    if (IN(13)) for (int rep_ = 0; rep_ < 1 + ((REP_MASK >> 13) & 1); ++rep_) { if (rep_) __syncthreads();
        for (int m = gw; m < M_LAT; m += NGW) { float* row = P.out + (size_t)m * D; f32x4 v[4]; float ss = 0.f;
#pragma unroll
            for (int j = 0; j < 4; ++j) { v[j] = *(const f32x4*)(row + 4 * lane + 256 * j); ss += (v[j][0] * v[j][0] + v[j][1] * v[j][1]) + (v[j][2] * v[j][2] + v[j][3] * v[j][3]); }
            const float rstd = rsqrtf(wave_sum(ss) * (1.f / D) + EPS);
#pragma unroll
            for (int j = 0; j < 4; ++j) { const f32x4 gv = *(const f32x4*)(P.fng + 4 * lane + 256 * j); *(f32x4*)(row + 4 * lane + 256 * j) = v[j] * rstd * gv; } }
    }
#undef IN
#undef SEAM
}

extern "C" void kernel_launch(void* const* d_in, const int* in_sizes, int n_in, void* d_out, int out_size, void* d_ws, size_t ws_size, hipStream_t stream) {
    static int grid = 0;
    if (grid == 0) {
        if (n_in != 22 || out_size != M_LAT * D || ws_size < WS_END) { fprintf(stderr, "kernel_launch: unexpected shapes (n_in %d, out %d, ws %zu)\n", n_in, out_size, ws_size); grid = -1; return; }
        int dev = 0, cus = 0, per_cu = 0;
        hipGetDevice(&dev); hipDeviceGetAttribute(&cus, hipDeviceAttributeMultiprocessorCount, dev);
        if (hipFuncSetAttribute((const void*)fwd_kernel, hipFuncAttributeMaxDynamicSharedMemorySize, LDS_BYTES) != hipSuccess) { fprintf(stderr, "kernel_launch: hipFuncSetAttribute failed\n"); grid = -1; return; }
        if (hipOccupancyMaxActiveBlocksPerMultiprocessor(&per_cu, (const void*)fwd_kernel, 512, LDS_BYTES) != hipSuccess || per_cu < 1) { fprintf(stderr, "kernel_launch: occupancy query gives %d\n", per_cu); per_cu = 1; }
        (void)hipGetLastError();
        grid = cus;
        fprintf(stderr, "kernel_launch: grid %d (cus %d, per_cu %d)\n", grid, cus, per_cu);
    }
    if (grid < 0) return;
    Args a{};
    for (int i = 0; i < 22; ++i) a.in[i] = (const float*)d_in[i];
    a.out = (float*)d_out; a.ws = (unsigned char*)d_ws;
    if (hipMemsetAsync(d_ws, 0, 65536, stream) != hipSuccess) { fprintf(stderr, "kernel_launch: memset failed\n"); return; }
#if ONE_LAUNCH
    a.ph_lo = 0; a.ph_hi = N_PHASES;
    void* kargs[] = {&a};
    hipError_t e = hipLaunchCooperativeKernel((const void*)fwd_kernel, dim3(grid), dim3(512), kargs, LDS_BYTES, stream);
    if (e != hipSuccess) fprintf(stderr, "kernel_launch: cooperative launch failed: %s\n", hipGetErrorString(e));
#else
    for (int p = 0; p < N_PHASES; ++p) { a.ph_lo = p; a.ph_hi = p + 1; hipLaunchKernelGGL(fwd_kernel, dim3(grid), dim3(512), LDS_BYTES, stream, a); }
#endif
}
```

```cpp
#include <hip/hip_runtime.h>
#include <hip/hip_cooperative_groups.h>
#include <cstdio>
#include <cstdint>
namespace cg = cooperative_groups;

#ifndef ONE_LAUNCH
#define ONE_LAUNCH 1
#endif

#define LAS __attribute__((address_space(3)))
typedef unsigned short bf16_t;
typedef short bf16x8 __attribute__((ext_vector_type(8)));
typedef float f32x4 __attribute__((ext_vector_type(4)));
typedef float f32x2 __attribute__((ext_vector_type(2)));
typedef unsigned u32x4 __attribute__((ext_vector_type(4)));
typedef unsigned u32x2 __attribute__((ext_vector_type(2)));

constexpr int D = 1024, NB = 4, SEQ = 4096, CTXL = 256, FF = 2816;
constexpr int M_LAT = NB * SEQ, M_CTX = NB * CTXL, M_TOT = M_LAT + M_CTX;
constexpr int NMOD = 9 * D;
constexpr int IN_COLS = 3088, NIN = 3328;
constexpr int NCH = 68;
constexpr float EPS = 1e-6f;

constexpr size_t MiB = 1u << 20;
constexpr size_t WS_MODS = 1 * MiB, WS_BA = 2 * MiB, WS_GC = 4 * MiB, WS_LSUM = 5 * MiB, WS_LCAR = 7 * MiB + MiB / 2;
constexpr size_t WS_WOUT = 10 * MiB, WS_W1B = 12 * MiB, WS_W2B = 23 * MiB;
constexpr size_t WS_PA = 29 * MiB, WS_PB = 80 * MiB, WS_HID = 29 * MiB, WS_OF = 29 * MiB, WS_OB = 45 * MiB;
constexpr size_t WS_U = 131 * MiB, WS_W1A = 165 * MiB, WS_W2A = 176 * MiB, WS_WIN = 182 * MiB, WS_H1CTX = 189 * MiB;
constexpr size_t WS_QG = 131 * MiB, WS_KG = 148 * MiB, WS_WB = 165 * MiB, WS_UB = 199 * MiB, WS_ATT = 233 * MiB, WS_MIX = 131 * MiB;
constexpr size_t WS_END = 256 * MiB;
constexpr int LDS_BYTES = 147456;

__device__ __forceinline__ unsigned f2bf(float f) { unsigned u = __builtin_bit_cast(unsigned, f); return (u + 0x7fffu + ((u >> 16) & 1u)) >> 16; }
__device__ __forceinline__ unsigned pk2(float lo, float hi) { return f2bf(lo) | (f2bf(hi) << 16); }
__device__ __forceinline__ float bf2f(unsigned h) { return __builtin_bit_cast(float, h << 16); }
__device__ __forceinline__ float wave_sum(float v) {
#pragma unroll
    for (int o = 1; o < 64; o <<= 1) v += __shfl_xor(v, o);
    return v;
}
__device__ __forceinline__ float sigmoidf_(float x) { return __builtin_amdgcn_rcpf(1.f + __expf(-x)); }
__device__ __forceinline__ float siluf_(float x) { return x * __builtin_amdgcn_rcpf(1.f + __expf(-x)); }
__device__ __forceinline__ float softplusf_(float x) { return x > 20.f ? x : log1pf(__expf(x)); }
__device__ __forceinline__ float geluf_(float x) { const float t = 0.7978845608f * (x + 0.044715f * x * x * x); return x * __builtin_amdgcn_rcpf(1.f + __expf(-2.f * t)); }
#define LDS_WAIT() asm volatile("s_waitcnt lgkmcnt(0)" ::: "memory")

namespace pg8 {
constexpr int BM = 256, BK = 64, HALF = 128, HTB = HALF * BK * 2, NXCD = 8, WGM = 8;
__host__ __device__ __forceinline__ int lds_byte(int r, int c) { const int st = (r >> 4) * 2 + (c >> 5), rr = r & 15, cc = c & 31, ob = rr * 64 + cc * 2; return st * 1024 + (ob ^ (((ob >> 9) & 1) << 5)); }
__host__ __device__ __forceinline__ void stage_rc(int b, int& R, int& C) { const int st = b / 1024, sb = b % 1024, swz = sb ^ (((sb >> 9) & 1) << 5); R = (st >> 1) * 16 + swz / 64; C = (st & 1) * 32 + (swz % 64) / 2; }
struct Unit { int pm, pn; };
struct Gemm { const bf16_t* A; const bf16_t* Bt; int M, N, K; };
struct StaticOrder {
    int nM, nN, nwg, G, c;
    __device__ void init(int M, int N, int G_, int c_) { nM = M / BM; nN = N / BM; nwg = nM * nN; G = G_; c = c_; }
    __device__ bool next(int i, Unit& u) const {
        const long L = (long)i * G + c; if (L >= nwg) return false;
        int wgid = (int)L; { const int q = nwg / NXCD, r = nwg % NXCD, xcd = wgid % NXCD, off = wgid / NXCD; wgid = (xcd < r ? xcd * (q + 1) : r * (q + 1) + (xcd - r) * q) + off; }
        const int nig = WGM * nN, gid = wgid / nig, fm = gid * WGM, gsz = (nM - fm) < WGM ? (nM - fm) : WGM;
        u.pm = fm + ((wgid % nig) % gsz); u.pn = (wgid % nig) / gsz; return true;
    }
};
template <class Epi, bool ALIGN_EPI>
__device__ __forceinline__ void gemm_phase(LAS unsigned char* lds, const Gemm g, const StaticOrder& S, const Epi& E) {
    const int tid = threadIdx.x, wid = __builtin_amdgcn_readfirstlane(tid >> 6), lane = tid & 63, wr = wid >> 2, wc = wid & 3, fr = lane & 15, fq = lane >> 4;
    const int K = g.K, nt = K / BK;
    unsigned voffA[2];
#pragma unroll
    for (int i = 0; i < 2; ++i) { int R, C; stage_rc(tid * 16 + i * 8192, R, C); voffA[i] = (unsigned)(R * K + C) * 2u; }
    const size_t kstep = (size_t)(BK * 2);
    const size_t hstep = (size_t)HALF * K * 2;
    const size_t tstep = 2 * hstep;
    const unsigned ldsw = (unsigned)wid * 1024u;
    const int aoff = lds_byte(wr * 64 + fr, fq * 8), boff = lds_byte(wc * 32 + fr, fq * 8);
#define PG8_SA(b, h) (((b) * 2 + (h)) * HTB)
#define PG8_SB(b, h) ((4 + (b) * 2 + (h)) * HTB)
#define PG8_STAGE(bufoff, gbase, voff) do { _Pragma("unroll") for (int _i = 0; _i < 2; ++_i) \
        __builtin_amdgcn_global_load_lds((const unsigned*)((const char*)(gbase) + (voff)[_i]), (LAS unsigned*)(lds + (bufoff) + ldsw + _i * 8192), 16, 0, 0); } while (0)
#define PG8_LDA(dst, b, h) do { _Pragma("unroll") for (int m = 0; m < 4; ++m) _Pragma("unroll") for (int k = 0; k < 2; ++k) dst[m][k] = *(const LAS bf16x8*)(lds + PG8_SA(b, h) + aoff + m * 2048 + k * 1024); } while (0)
#define PG8_LDB(dst, b, h) do { _Pragma("unroll") for (int n = 0; n < 2; ++n) _Pragma("unroll") for (int k = 0; k < 2; ++k) dst[n][k] = *(const LAS bf16x8*)(lds + PG8_SB(b, h) + boff + n * 2048 + k * 1024); } while (0)
#define PG8_MMA(ai, bj, At, Bt) do { __builtin_amdgcn_s_setprio(1); _Pragma("unroll") for (int m = 0; m < 4; ++m) _Pragma("unroll") for (int n = 0; n < 2; ++n) _Pragma("unroll") for (int k = 0; k < 2; ++k) \
        acc[ai][bj][m][n] = __builtin_amdgcn_mfma_f32_16x16x32_bf16(Bt[n][k], At[m][k], acc[ai][bj][m][n], 0, 0, 0); __builtin_amdgcn_s_setprio(0); } while (0)
#define PG8_WAIT_V(n) asm volatile("s_waitcnt vmcnt(" #n ")" ::: "memory")
#define PG8_WAIT_L(n) asm volatile("s_waitcnt lgkmcnt(" #n ")" ::: "memory")
#define PG8_BAR __builtin_amdgcn_s_barrier()
#define PG8_SCHED __builtin_amdgcn_sched_barrier(0)
    Unit cur, nxt; int ui = 0;
    if (!S.next(0, cur)) return;
    f32x4 acc[2][2][4][2];
#pragma unroll
    for (int a = 0; a < 2; ++a)
#pragma unroll
        for (int b = 0; b < 2; ++b)
#pragma unroll
            for (int m = 0; m < 4; ++m)
#pragma unroll
                for (int n = 0; n < 2; ++n) acc[a][b][m][n] = (f32x4){0.f, 0.f, 0.f, 0.f};
    bf16x8 At[4][2], B0[2][2], B1[2][2];
    const char* cA = (const char*)g.A + (size_t)cur.pm * tstep; const char* cB = (const char*)g.Bt + (size_t)cur.pn * tstep;
    PG8_STAGE(PG8_SB(0, 0), cB, voffA); PG8_STAGE(PG8_SB(0, 1), cB + hstep, voffA); PG8_STAGE(PG8_SA(0, 0), cA, voffA); PG8_STAGE(PG8_SA(0, 1), cA + hstep, voffA);
    if (wr == 1) PG8_BAR;
    PG8_WAIT_V(2); PG8_BAR;
    PG8_STAGE(PG8_SB(1, 0), cB + kstep, voffA); PG8_STAGE(PG8_SA(1, 0), cA + kstep, voffA); PG8_STAGE(PG8_SB(1, 1), cB + hstep + kstep, voffA);
    PG8_WAIT_V(6); PG8_BAR;
    for (;;) {
        const bool has_next = S.next(ui + 1, nxt);
        const char* nA = has_next ? (const char*)g.A + (size_t)nxt.pm * tstep : cA; const char* nB = has_next ? (const char*)g.Bt + (size_t)nxt.pn * tstep : cB;
        for (int t = 0; t < nt; t += 2) {
            const bool last = (t == nt - 2);
            const char* a1 = cA + (size_t)(t + 1) * kstep;
            const char* a2 = last ? nA : cA + (size_t)(t + 2) * kstep; const char* b2 = last ? nB : cB + (size_t)(t + 2) * kstep;
            const char* a3 = a2 + kstep; const char* b3 = b2 + kstep;
            PG8_LDB(B0, 0, 0); PG8_LDB(B1, 0, 1); PG8_SCHED; PG8_LDA(At, 0, 0); PG8_STAGE(PG8_SA(1, 1), a1 + hstep, voffA);
            PG8_WAIT_V(8); PG8_WAIT_L(0); PG8_BAR; PG8_MMA(0, 0, At, B0); PG8_MMA(0, 1, At, B1); PG8_BAR; PG8_SCHED;
            PG8_LDA(At, 0, 1); PG8_STAGE(PG8_SB(0, 0), b2, voffA); PG8_STAGE(PG8_SB(0, 1), b2 + hstep, voffA); PG8_STAGE(PG8_SA(0, 0), a2, voffA);
            PG8_WAIT_V(8); PG8_WAIT_L(0); PG8_BAR; PG8_MMA(1, 0, At, B0); PG8_MMA(1, 1, At, B1); PG8_BAR; PG8_SCHED;
            PG8_LDB(B0, 1, 0); PG8_LDB(B1, 1, 1); PG8_SCHED; PG8_LDA(At, 1, 0); PG8_STAGE(PG8_SA(0, 1), a2 + hstep, voffA);
            PG8_WAIT_V(8); PG8_WAIT_L(0); PG8_BAR; PG8_MMA(0, 0, At, B0); PG8_MMA(0, 1, At, B1); PG8_BAR; PG8_SCHED;
            PG8_LDA(At, 1, 1); PG8_STAGE(PG8_SB(1, 0), b3, voffA); PG8_STAGE(PG8_SB(1, 1), b3 + hstep, voffA); PG8_STAGE(PG8_SA(1, 0), a3, voffA);
            PG8_WAIT_V(8); PG8_WAIT_L(0); PG8_BAR; PG8_MMA(1, 0, At, B0); PG8_MMA(1, 1, At, B1); PG8_BAR; PG8_SCHED;
        }
        if constexpr (ALIGN_EPI) { if (wr == 0) PG8_BAR; }
        E(acc, cur, wr, wc, fr, fq);
        if (!has_next) break;
#pragma unroll
        for (int a = 0; a < 2; ++a)
#pragma unroll
            for (int b = 0; b < 2; ++b)
#pragma unroll
                for (int m = 0; m < 4; ++m)
#pragma unroll
                    for (int n = 0; n < 2; ++n) acc[a][b][m][n] = (f32x4){0.f, 0.f, 0.f, 0.f};
        cur = nxt; cA = nA; cB = nB; ++ui;
        if constexpr (ALIGN_EPI) { if (wr == 1) PG8_BAR; }
    }
    PG8_WAIT_V(0);
    if constexpr (!ALIGN_EPI) { if (wr == 0) PG8_BAR; }
    PG8_BAR;
#undef PG8_SA
#undef PG8_SB
#undef PG8_STAGE
#undef PG8_LDA
#undef PG8_LDB
#undef PG8_MMA
#undef PG8_WAIT_V
#undef PG8_WAIT_L
#undef PG8_BAR
#undef PG8_SCHED
}

struct EpiSwiglu {
    bf16_t* H;
    __device__ __forceinline__ void operator()(const f32x4 (&acc)[2][2][4][2], const Unit& u, int wr, int wc, int fr, int fq) const {
        const int row0 = u.pm * BM + wr * 64 + fr, col0 = u.pn * 128 + wc * 32 + 4 * fq;
#pragma unroll
        for (int ai = 0; ai < 2; ++ai)
#pragma unroll
            for (int m = 0; m < 4; ++m) { bf16_t* rowp = H + (size_t)(row0 + ai * HALF + m * 16) * FF + col0;
#pragma unroll
                for (int n = 0; n < 2; ++n) { const f32x4 gt = acc[ai][0][m][n], up = acc[ai][1][m][n];
                    u32x2 w; w.x = pk2(siluf_(gt[0]) * up[0], siluf_(gt[1]) * up[1]); w.y = pk2(siluf_(gt[2]) * up[2], siluf_(gt[3]) * up[3]);
                    *(u32x2*)(rowp + n * 16) = w; } }
    }
};
struct EpiRes {
    const float* res_lat; const float* res_ctx; float* out_lat; float* out_ctx; const float* gate; float coef;
    __device__ __forceinline__ void operator()(const f32x4 (&acc)[2][2][4][2], const Unit& u, int wr, int wc, int fr, int fq) const {
        const bool isctx = u.pm >= 64; const int mr = isctx ? 4 : (u.pm >> 4);
        const int lrow0 = (isctx ? (u.pm - 64) : u.pm) * BM + wr * 64 + fr, col0 = u.pn * BM + wc * 32 + 4 * fq;
        const float* res = isctx ? res_ctx : res_lat; float* out = isctx ? out_ctx : out_lat;
        const float* gp = gate + (size_t)mr * NMOD + col0;
        f32x4 gv[2][2];
#pragma unroll
        for (int bj = 0; bj < 2; ++bj)
#pragma unroll
            for (int n = 0; n < 2; ++n) gv[bj][n] = *(const f32x4*)(gp + bj * HALF + n * 16) * coef;
#pragma unroll
        for (int ai = 0; ai < 2; ++ai)
#pragma unroll
            for (int m = 0; m < 4; ++m) { const size_t ro = (size_t)(lrow0 + ai * HALF + m * 16) * D + col0;
#pragma unroll
                for (int bj = 0; bj < 2; ++bj)
#pragma unroll
                    for (int n = 0; n < 2; ++n) { const f32x4 r = *(const f32x4*)(res + ro + bj * HALF + n * 16);
                        *(f32x4*)(out + ro + bj * HALF + n * 16) = r + gv[bj][n] * acc[ai][bj][m][n]; } }
    }
};
struct EpiIn {
    bf16_t* PA; bf16_t* PB; float* BA;
    __device__ __forceinline__ void operator()(const f32x4 (&acc)[2][2][4][2], const Unit& u, int wr, int wc, int fr, int fq) const {
        const int row0 = u.pm * BM + wr * 64 + fr;
        if (u.pn == 12) {
            if (wc == 0) {
#pragma unroll
                for (int ai = 0; ai < 2; ++ai)
#pragma unroll
                    for (int m = 0; m < 4; ++m) *(f32x4*)(BA + (size_t)(row0 + ai * HALF + m * 16) * 16 + 4 * fq) = acc[ai][0][m][0];
            }
            return;
        }
        bf16_t* base = (u.pn < 6) ? PA : PB; const int col0 = (u.pn % 6) * BM + wc * 32 + 4 * fq;
#pragma unroll
        for (int ai = 0; ai < 2; ++ai)
#pragma unroll
            for (int m = 0; m < 4; ++m) { bf16_t* rowp = base + (size_t)(row0 + ai * HALF + m * 16) * 1536 + col0;
#pragma unroll
                for (int bj = 0; bj < 2; ++bj)
#pragma unroll
                    for (int n = 0; n < 2; ++n) { const f32x4 v = acc[ai][bj][m][n]; u32x2 w; w.x = pk2(v[0], v[1]); w.y = pk2(v[2], v[3]); *(u32x2*)(rowp + bj * HALF + n * 16) = w; } }
    }
};
}

__device__ __forceinline__ void transpose_item(const float* W, int N, int k0, int src_col0, int nvalid, bf16_t* WT, int Kp, int dst_row0, float* scr, int lane) {
#pragma unroll 8
    for (int i = 0; i < 32; ++i) { const int kk = 2 * i + (lane >> 5), n = lane & 31; scr[kk * 33 + n] = (n < nvalid) ? W[(size_t)(k0 + kk) * N + src_col0 + n] : 0.f; }
    LDS_WAIT();
    const int c = lane & 7;
#pragma unroll
    for (int j = 0; j < 4; ++j) { const int n = (lane >> 3) + 8 * j; const float* s = scr + (8 * c) * 33 + n;
        u32x4 o; o.x = pk2(s[0 * 33], s[1 * 33]); o.y = pk2(s[2 * 33], s[3 * 33]); o.z = pk2(s[4 * 33], s[5 * 33]); o.w = pk2(s[6 * 33], s[7 * 33]);
        *(u32x4*)(WT + (size_t)(dst_row0 + n) * Kp + k0 + 8 * c) = o; }
    LDS_WAIT();
}

struct Ptrs {
    const float *x, *c, *ctx, *cctx, *w_ada, *b_ada, *norm_g, *w1, *w3, *w2, *w_in, *w_out, *gconv, *galog, *gdtb, *gnormw, *lconv, *lconvb, *lwg, *lbg, *llam, *fng;
    float* out; unsigned char* ws;
};

__device__ __forceinline__ void phase_prologue(const Ptrs& P, unsigned char* lds, int tid, int lane, int wave, int bid, int G) {
    float* mods = (float*)(P.ws + WS_MODS);
    {
        float* sc = (float*)lds;
        for (int i = tid; i < 5 * D; i += 512) { const int r = i >> 10, k = i & 1023; const float v = (r < 4) ? P.c[r * D + k] : P.cctx[k]; sc[i] = siluf_(v); }
        __syncthreads();
        float* red = (float*)(lds + 20480);
        for (int it = bid; it < NMOD / 64; it += G) {
            const int n0 = it * 64, cq = tid & 15, kl = tid >> 4;
            float acc[5][4];
#pragma unroll
            for (int r = 0; r < 5; ++r)
#pragma unroll
                for (int j = 0; j < 4; ++j) acc[r][j] = 0.f;
#pragma unroll 4
            for (int i = 0; i < 32; ++i) { const int k = kl + 32 * i; const f32x4 w = *(const f32x4*)(P.w_ada + (size_t)k * NMOD + n0 + 4 * cq);
#pragma unroll
                for (int r = 0; r < 5; ++r) { const float s = sc[r * D + k];
#pragma unroll
                    for (int j = 0; j < 4; ++j) acc[r][j] += s * w[j]; } }
#pragma unroll
            for (int r = 0; r < 5; ++r)
#pragma unroll
                for (int j = 0; j < 4; ++j) red[(kl * 16 + cq) * 20 + r * 4 + j] = acc[r][j];
            __syncthreads();
            if (tid < 320) { const int cq2 = tid / 20, rj = tid % 20; float s = 0.f;
                for (int k2 = 0; k2 < 32; ++k2) s += red[(k2 * 16 + cq2) * 20 + rj];
                const int r = rj >> 2, n = n0 + 4 * cq2 + (rj & 3); mods[r * NMOD + n] = s + P.b_ada[n]; }
            __syncthreads();
        }
        __syncthreads();
    }
    {
        float* scr = (float*)(lds + wave * 16384);
        const int gw = bid * 8 + wave, NGW = G * 8;
        bf16_t* W1A = (bf16_t*)(P.ws + WS_W1A); bf16_t* W2A = (bf16_t*)(P.ws + WS_W2A); bf16_t* W1B = (bf16_t*)(P.ws + WS_W1B); bf16_t* W2B = (bf16_t*)(P.ws + WS_W2B);
        bf16_t* WIN = (bf16_t*)(P.ws + WS_WIN); bf16_t* WOUT = (bf16_t*)(P.ws + WS_WOUT);
        constexpr int I_UP = 16 * 88, I_DN = 44 * 32, I_IN = 16 * 97, I_OUT = 16 * 32;
        constexpr int NITEMS = 6 * I_UP + I_IN + I_OUT;
        static_assert(I_UP == I_DN, "item counts");
        for (int it = gw; it < NITEMS; it += NGW) {
            int r = it;
            if (r < 6 * I_UP) {
                const int seg = r / I_UP; r -= seg * I_UP; const int layer = seg / 3, kind = seg % 3;
                if (kind < 2) { const int kb = r / 88, nbk = r % 88, sc0 = 32 * nbk; const float* W = (kind == 0 ? P.w1 : P.w3) + (size_t)layer * D * FF;
                    transpose_item(W, FF, 64 * kb, sc0, 32, layer ? W1B : W1A, D, 256 * (sc0 / 128) + (sc0 % 128) + (kind ? 128 : 0), scr, lane); }
                else { const int kb = r / 32, nbk = r % 32; transpose_item(P.w2 + (size_t)layer * FF * D, D, 64 * kb, 32 * nbk, 32, layer ? W2B : W2A, FF, 32 * nbk, scr, lane); }
                continue;
            }
            r -= 6 * I_UP;
            if (r < I_IN) { const int kb = r / 97, g = r % 97;
                if (g < 64) transpose_item(P.w_in, IN_COLS, 64 * kb, 32 * g, 32, WIN, D, 32 * g, scr, lane);
                else if (g < 96) transpose_item(P.w_in, IN_COLS, 64 * kb, 2064 + 32 * (g - 64), 32, WIN, D, 2048 + 32 * (g - 64), scr, lane);
                else transpose_item(P.w_in, IN_COLS, 64 * kb, 2048, 16, WIN, D, 3072, scr, lane);
                continue; }
            r -= I_IN;
            { const int kb = r / 32, nbk = r % 32; transpose_item(P.w_out, D, 64 * kb, 32 * nbk, 32, WOUT, D, 32 * nbk, scr, lane); }
        }
        u32x4* z = (u32x4*)(WIN + (size_t)3104 * D);
        for (int i = bid * 512 + tid; i < 224 * D * 2 / 16; i += G * 512) z[i] = (u32x4){0u, 0u, 0u, 0u};
    }
}

__device__ __forceinline__ void phase_norm_mod(const float* src_lat, const float* src_ctx, int nrows, const float* g, const float* mods, int shift_idx, int scale_idx, bf16_t* U, int gw, int NGW, int lane) {
    for (int m = gw; m < nrows; m += NGW) {
        const float* xrow = (m < M_LAT) ? src_lat + (size_t)m * D : src_ctx + (size_t)(m - M_LAT) * D;
        const int mr = (m < M_LAT) ? (m >> 12) : 4;
        const float* sh = mods + (size_t)mr * NMOD + shift_idx * D; const float* sc = mods + (size_t)mr * NMOD + scale_idx * D;
        f32x4 v[4]; float ss = 0.f;
#pragma unroll
        for (int j = 0; j < 4; ++j) { v[j] = *(const f32x4*)(xrow + 4 * lane + 256 * j); ss += (v[j][0] * v[j][0] + v[j][1] * v[j][1]) + (v[j][2] * v[j][2] + v[j][3] * v[j][3]); }
        const float rstd = rsqrtf(wave_sum(ss) * (1.f / D) + EPS);
#pragma unroll
        for (int j = 0; j < 4; ++j) { const int col = 4 * lane + 256 * j;
            const f32x4 gv = *(const f32x4*)(g + col), sv = *(const f32x4*)(sc + col), hv = *(const f32x4*)(sh + col);
            const f32x4 y = v[j] * rstd * gv * (sv + 1.f) + hv;
            u32x2 w; w.x = pk2(y[0], y[1]); w.y = pk2(y[2], y[3]); *(u32x2*)(U + (size_t)m * D + col) = w; }
    }
}

constexpr int KP = 132;
__device__ __attribute__((noinline)) void gdn_solve(const LAS float* src, const LAS float* scl, const LAS float* A, bf16_t* dst, int base, int stride) {
    float x[64];
#pragma unroll
    for (int i = 0; i < 64; ++i) x[i] = 0.f;
#pragma unroll
    for (int i = 0; i < 64; ++i) {
        float s0 = src[base + i * stride] * scl[i], s1 = 0.f, s2 = 0.f, s3 = 0.f;
#pragma unroll
        for (int j4 = 0; j4 < (i + 3) / 4; ++j4) { const f32x4 av = *(const LAS f32x4*)(A + i * 64 + 4 * j4);
            s0 -= av[0] * x[4 * j4]; s1 -= av[1] * x[4 * j4 + 1]; s2 -= av[2] * x[4 * j4 + 2]; s3 -= av[3] * x[4 * j4 + 3]; }
        x[i] = (s0 + s1) + (s2 + s3);
        dst[i * 128] = (bf16_t)f2bf(x[i]);
    }
}
__device__ __forceinline__ void gdn_prep_item(const Ptrs& P, unsigned char* lds, int item, int tid, int lane, int wave) {
    const int b = item / (4 * NCH), h = (item / NCH) & 3, cn = item % NCH;
    const bool isctx = cn < 4; const int cl = isctx ? cn : cn - 4, L = isctx ? CTXL : SEQ;
    const int rowbase = isctx ? M_LAT + b * CTXL : b * SEQ;
    const bf16_t* PA = (const bf16_t*)(P.ws + WS_PA); const float* BA = (const float*)(P.ws + WS_BA);
    int lo_ = 0; asm volatile("" : "+v"(lo_));
    float* KF = (float*)(lds + lo_); float* QF = (float*)(lds + lo_ + 33792); float* VF = (float*)(lds + lo_ + 67584);
    float* KKN = (float*)(lds + lo_ + 101376); float* QKN = (float*)(lds + lo_ + 118016);
    float* GS = (float*)(lds + lo_ + 134656);
    float* RB = GS + 128;
    float* RBE = GS + 256;
    float* AD = QF;
    {
        const int c = tid & 127, tg = tid >> 7;
#pragma unroll
        for (int mat = 0; mat < 3; ++mat) {
            const int ch = mat * 512 + h * 128 + c;
            const float w0 = P.gconv[ch], w1 = P.gconv[1536 + ch], w2 = P.gconv[2 * 1536 + ch], w3 = P.gconv[3 * 1536 + ch];
            const int t0 = cl * 64 + tg * 16;
            const bf16_t* src = PA + (size_t)rowbase * 1536 + ch;
            float xm2 = (t0 - 2 >= 0) ? bf2f(src[(size_t)(t0 - 2) * 1536]) : 0.f;
            float xm1 = (t0 - 1 >= 0) ? bf2f(src[(size_t)(t0 - 1) * 1536]) : 0.f;
            float x0 = bf2f(src[(size_t)t0 * 1536]);
            float* dst = (mat == 0 ? QF : (mat == 1 ? KF : VF)) + (tg * 16) * KP + c;
#pragma unroll 4
            for (int i = 0; i < 16; ++i) { const int t = t0 + i; const float xp1 = (t + 1 < L) ? bf2f(src[(size_t)(t + 1) * 1536]) : 0.f;
                const float y = w0 * xm2 + w1 * xm1 + w2 * x0 + w3 * xp1; dst[i * KP] = siluf_(y); xm2 = xm1; xm1 = x0; x0 = xp1; }
        }
    }
    if (tid < 128) {
        const int d = tid >> 6, i = lane, r = d ? 63 - i : i;
        const float* ba = BA + (size_t)(rowbase + cl * 64 + r) * 16;
        const float beta = sigmoidf_(ba[d * 4 + h]);
        float gg = -__expf(P.galog[d * 4 + h]) * softplusf_(ba[(2 + d) * 4 + h] + P.gdtb[d * 4 + h]);
#pragma unroll
        for (int o = 1; o < 64; o <<= 1) { const float t = __shfl_up(gg, o); if (lane >= o) gg += t; }
        GS[d * 64 + i] = gg; RB[d * 64 + i] = beta; RBE[d * 64 + i] = beta * __expf(gg);
        ((float*)(P.ws + WS_GC))[((size_t)((d * 4 + b) * 4 + h) * NCH + cn) * 64 + i] = gg;
    }
    __syncthreads();
    {
        bf16_t* QG = (bf16_t*)(P.ws + WS_QG) + ((size_t)((b * 4 + h) * NCH + cn) * 64) * 128;
        bf16_t* KG = (bf16_t*)(P.ws + WS_KG) + ((size_t)((b * 4 + h) * NCH + cn) * 64) * 128;
#pragma unroll
        for (int tt = 0; tt < 8; ++tt) { const int tok = wave * 8 + tt;
            f32x2 q = *(f32x2*)(QF + tok * KP + 2 * lane), k = *(f32x2*)(KF + tok * KP + 2 * lane);
            const float sq = wave_sum(q[0] * q[0] + q[1] * q[1]), sk = wave_sum(k[0] * k[0] + k[1] * k[1]);
            q = q * (rsqrtf(sq + EPS) * 0.08838834764831845f); k = k * rsqrtf(sk + EPS);
            *(f32x2*)(QF + tok * KP + 2 * lane) = q; *(f32x2*)(KF + tok * KP + 2 * lane) = k;
            *(unsigned*)(QG + tok * 128 + 2 * lane) = pk2(q[0], q[1]); *(unsigned*)(KG + tok * 128 + 2 * lane) = pk2(k[0], k[1]); }
    }
    __syncthreads();
    {
        const int tp = tid & 255, ti = tp >> 4, tj = tp & 15; const float* X = (tid < 256) ? KF : QF; float* OUT = (tid < 256) ? KKN : QKN;
        float acc[4][4];
#pragma unroll
        for (int a = 0; a < 4; ++a)
#pragma unroll
            for (int c = 0; c < 4; ++c) acc[a][c] = 0.f;
#pragma unroll 2
        for (int kq = 0; kq < 32; ++kq) {
            f32x4 av[4], bv[4];
#pragma unroll
            for (int a = 0; a < 4; ++a) { av[a] = *(const f32x4*)(X + (ti + 16 * a) * KP + 4 * kq); bv[a] = *(const f32x4*)(KF + (tj + 16 * a) * KP + 4 * kq); }
#pragma unroll
            for (int a = 0; a < 4; ++a)
#pragma unroll
                for (int c = 0; c < 4; ++c) acc[a][c] += (av[a][0] * bv[c][0] + av[a][1] * bv[c][1]) + (av[a][2] * bv[c][2] + av[a][3] * bv[c][3]);
        }
#pragma unroll
        for (int a = 0; a < 4; ++a)
#pragma unroll
            for (int c = 0; c < 4; ++c) OUT[(ti + 16 * a) * 65 + tj + 16 * c] = acc[a][c];
    }
    __syncthreads();
    {
        const int d = tid >> 8, tp = tid & 255;
        bf16_t* ATT = (bf16_t*)(P.ws + WS_ATT) + ((size_t)((d * 4 + b) * 4 + h) * NCH + cn) * 4096;
#pragma unroll 4
        for (int e = 0; e < 16; ++e) { const int idx = tp + 256 * e, i = idx >> 6, j = idx & 63, ri = d ? 63 - i : i, rj = d ? 63 - j : j;
            const float dec = (i >= j) ? __expf(GS[d * 64 + i] - GS[d * 64 + j]) : 0.f;
            AD[d * 4096 + idx] = (i > j) ? RB[d * 64 + i] * KKN[ri * 65 + rj] * dec : 0.f;
            ATT[idx] = (bf16_t)f2bf(QKN[ri * 65 + rj] * dec); }
    }
    __syncthreads();
    {
        const int d = tid >> 8, c = tid & 255;
        const float* src = (c < 128) ? VF + c : KF + (c - 128); const float* scl = ((c < 128) ? RB : RBE) + d * 64;
        bf16_t* dst = (bf16_t*)(P.ws + (c < 128 ? WS_UB : WS_WB)) + ((size_t)((d * 4 + b) * 4 + h) * NCH + cn) * 64 * 128 + (c & 127);
        int sb_ = d ? 63 * KP : 0, ss_ = d ? -KP : KP; asm volatile("" : "+v"(sb_), "+v"(ss_));
        gdn_solve((const LAS float*)src, (const LAS float*)scl, (const LAS float*)(AD + d * 4096), dst, sb_, ss_);
    }
    __syncthreads();
}

__device__ __forceinline__ int chunk_of(int d, int s) { return d ? (s < 4 ? 3 - s : 67 - (s - 4)) : s; }
constexpr int TP = 272, AP = 144;
__device__ __forceinline__ bf16x8 ldfrag(const unsigned char* base, int row, int pitch, int kbyte) { return *(const bf16x8*)(base + row * pitch + kbyte); }
__device__ __forceinline__ void gdn_scan_item(const Ptrs& P, unsigned char* lds, int item, int tid, int lane, int wave) {
    const int chain = item & 31, slice = item >> 5, d = chain >> 4, b = (chain >> 2) & 3, h = chain & 3, e0 = slice * 32;
    unsigned char* Wl = lds; unsigned char* Ql = lds + 17408; unsigned char* Kl = lds + 34816; unsigned char* ATl = lds + 52224;
    unsigned char* St = lds + 61440; unsigned char* Vt = lds + 70144; unsigned char* Vdt = lds + 74752; float* gcs = (float*)(lds + 79360);
    const bf16_t* WBp = (const bf16_t*)(P.ws + WS_WB) + (size_t)((d * 4 + b) * 4 + h) * NCH * 8192;
    const bf16_t* UBp = (const bf16_t*)(P.ws + WS_UB) + (size_t)((d * 4 + b) * 4 + h) * NCH * 8192;
    const bf16_t* ATp = (const bf16_t*)(P.ws + WS_ATT) + (size_t)((d * 4 + b) * 4 + h) * NCH * 4096;
    const float* GCp = (const float*)(P.ws + WS_GC) + (size_t)((d * 4 + b) * 4 + h) * NCH * 64;
    const bf16_t* QGp = (const bf16_t*)(P.ws + WS_QG) + (size_t)(b * 4 + h) * NCH * 8192;
    const bf16_t* KGp = (const bf16_t*)(P.ws + WS_KG) + (size_t)(b * 4 + h) * NCH * 8192;
    bf16_t* Op = (bf16_t*)(P.ws + (d ? WS_OB : WS_OF));
    const int fr = lane & 15, fq = lane >> 4, mt = wave & 3, nt = wave >> 2;
    for (int i = tid; i < 8704 / 4; i += 512) ((unsigned*)St)[i] = 0u;
    f32x4 Sacc[2] = {(f32x4){0.f, 0.f, 0.f, 0.f}, (f32x4){0.f, 0.f, 0.f, 0.f}};
    u32x4 rw[2], rq[2], rk[2], ra; float rg = 0.f; bf16_t ru[4];
#define SCAN_PREFETCH(s_) do { const int cn_ = chunk_of(d, s_); \
        const u32x4* w4 = (const u32x4*)(WBp + (size_t)cn_ * 8192); const u32x4* q4 = (const u32x4*)(QGp + (size_t)cn_ * 8192); const u32x4* k4 = (const u32x4*)(KGp + (size_t)cn_ * 8192); \
        rw[0] = w4[tid]; rw[1] = w4[tid + 512]; rq[0] = q4[tid]; rq[1] = q4[tid + 512]; rk[0] = k4[tid]; rk[1] = k4[tid + 512]; \
        ra = ((const u32x4*)(ATp + (size_t)cn_ * 4096))[tid]; if (tid < 64) rg = GCp[cn_ * 64 + tid]; \
        { const bf16_t* up_ = UBp + (size_t)cn_ * 8192 + (mt * 16 + fq * 4) * 128 + e0 + nt * 16 + fr; ru[0] = up_[0]; ru[1] = up_[128]; ru[2] = up_[256]; ru[3] = up_[384]; } } while (0)
    SCAN_PREFETCH(0);
    for (int s = 0; s < NCH; ++s) {
        const int cn = chunk_of(d, s); const bool lat = cn >= 4;
#pragma unroll
        for (int i = 0; i < 2; ++i) { const int idx = tid + 512 * i, row = idx >> 4, cc = idx & 15;
            *(u32x4*)(Wl + row * TP + cc * 16) = rw[i]; *(u32x4*)(Ql + row * TP + cc * 16) = rq[i]; *(u32x4*)(Kl + row * TP + cc * 16) = rk[i]; }
        *(u32x4*)(ATl + (tid >> 3) * AP + (tid & 7) * 16) = ra;
        if (tid < 64) gcs[tid] = rg;
        float uv[4];
#pragma unroll
        for (int jj = 0; jj < 4; ++jj) uv[jj] = bf2f(ru[jj]);
        __syncthreads();
        if (s + 1 < NCH) SCAN_PREFETCH(s + 1);
        const float glast = gcs[63];
        f32x4 acc_a = (f32x4){0.f, 0.f, 0.f, 0.f}, acc_b = (f32x4){0.f, 0.f, 0.f, 0.f};
        { const int qrow = d ? 63 - (mt * 16 + fr) : (mt * 16 + fr);
#pragma unroll
          for (int ks = 0; ks < 4; ++ks) { const bf16x8 bs = ldfrag(St, nt * 16 + fr, TP, ks * 64 + fq * 16);
              const bf16x8 aw = ldfrag(Wl, mt * 16 + fr, TP, ks * 64 + fq * 16);
              acc_a = __builtin_amdgcn_mfma_f32_16x16x32_bf16(aw, bs, acc_a, 0, 0, 0);
              if (lat) { const bf16x8 aq = ldfrag(Ql, qrow, TP, ks * 64 + fq * 16); acc_b = __builtin_amdgcn_mfma_f32_16x16x32_bf16(aq, bs, acc_b, 0, 0, 0); } } }
        { float vn[4], vd[4];
#pragma unroll
          for (int jj = 0; jj < 4; ++jj) { const float gi = gcs[mt * 16 + fq * 4 + jj]; vn[jj] = uv[jj] - acc_a[jj]; vd[jj] = vn[jj] * __expf(glast - gi); acc_b[jj] *= __expf(gi); }
          u32x2 w; w.x = pk2(vn[0], vn[1]); w.y = pk2(vn[2], vn[3]); *(u32x2*)(Vt + (nt * 16 + fr) * AP + (mt * 16 + fq * 4) * 2) = w;
          w.x = pk2(vd[0], vd[1]); w.y = pk2(vd[2], vd[3]); *(u32x2*)(Vdt + (nt * 16 + fr) * AP + (mt * 16 + fq * 4) * 2) = w; }
        __syncthreads();
        if (lat) {
#pragma unroll
            for (int ks = 0; ks < 2; ++ks) { const bf16x8 aa = ldfrag(ATl, mt * 16 + fr, AP, ks * 64 + fq * 16); const bf16x8 bv = ldfrag(Vt, nt * 16 + fr, AP, ks * 64 + fq * 16);
                acc_b = __builtin_amdgcn_mfma_f32_16x16x32_bf16(aa, bv, acc_b, 0, 0, 0); }
            bf16_t* op = Op + (size_t)(b * SEQ + (cn - 4) * 64) * 512 + h * 128 + e0 + nt * 16 + fr;
#pragma unroll
            for (int jj = 0; jj < 4; ++jj) { const int i = mt * 16 + fq * 4 + jj, tok = d ? 63 - i : i; op[(size_t)tok * 512] = (bf16_t)f2bf(acc_b[jj]); }
        }
        { const float eg = __expf(glast);
          bf16x8 ak[2];
#pragma unroll
          for (int ks = 0; ks < 2; ++ks)
#pragma unroll
              for (int jj = 0; jj < 8; ++jj) { const int i = ks * 32 + fq * 8 + jj, row = d ? 63 - i : i; ak[ks][jj] = (short)*(const bf16_t*)(Kl + row * TP + (16 * wave + fr) * 2); }
#pragma unroll
          for (int n2 = 0; n2 < 2; ++n2) { f32x4 a = Sacc[n2] * eg;
#pragma unroll
              for (int ks = 0; ks < 2; ++ks) { const bf16x8 bv = ldfrag(Vdt, n2 * 16 + fr, AP, ks * 64 + fq * 16); a = __builtin_amdgcn_mfma_f32_16x16x32_bf16(ak[ks], bv, a, 0, 0, 0); }
              Sacc[n2] = a;
              u32x2 w; w.x = pk2(a[0], a[1]); w.y = pk2(a[2], a[3]); *(u32x2*)(St + (n2 * 16 + fr) * TP + (16 * wave + fq * 4) * 2) = w; } }
        __syncthreads();
    }
#undef SCAN_PREFETCH
}

__device__ __forceinline__ void gdn_prep_phase(const Ptrs& P, unsigned char* lds, int tid, int lane, int wave, int bid, int G) {
    const bf16_t* PA = (const bf16_t*)(P.ws + WS_PA); const float* BA = (const float*)(P.ws + WS_BA);
    unsigned char* RAW = lds;
    float* QF = (float*)lds;
    unsigned char* Kb = lds + 33792;
    unsigned char* ATs = lds;
    float* AD = (float*)(lds + 18432);
    float* KF = (float*)(lds + 51456); float* VF = (float*)(lds + 85248);
    unsigned char* Qb = lds + 119040;
    float* GS = (float*)(lds + 136448); float* RB = GS + 128; float* RBE = GS + 256;
    const int fr = lane & 15, fq = lane >> 4;
    u32x4 pr[7]; float pba0 = 0.f, pba1 = 0.f;
#define PREP_DECODE(it_, b_, h_, cn_) const int b_ = (it_) / (4 * NCH), h_ = ((it_) / NCH) & 3, cn_ = (it_) % NCH;
#define PREP_PREFETCH(it_) do { PREP_DECODE(it_, pb_, ph_, pcn_) const bool pctx_ = pcn_ < 4; const int pcl_ = pctx_ ? pcn_ : pcn_ - 4, pL_ = pctx_ ? CTXL : SEQ, prb_ = pctx_ ? M_LAT + pb_ * CTXL : pb_ * SEQ; \
        _Pragma("unroll") for (int e_ = 0; e_ < 7; ++e_) { const int q_ = tid + 512 * e_, mat_ = q_ / 1072, rem_ = q_ - mat_ * 1072, row_ = rem_ >> 4, t_ = pcl_ * 64 - 2 + row_; \
            pr[e_] = (q_ < 3216 && t_ >= 0 && t_ < pL_) ? *(const u32x4*)(PA + (size_t)(prb_ + t_) * 1536 + mat_ * 512 + ph_ * 128 + (rem_ & 15) * 8) : (u32x4){0u, 0u, 0u, 0u}; } \
        if (tid < 128) { const int d_ = tid >> 6, r_ = d_ ? 63 - lane : lane; const float* ba_ = BA + (size_t)(prb_ + pcl_ * 64 + r_) * 16; pba0 = ba_[d_ * 4 + ph_]; pba1 = ba_[(2 + d_) * 4 + ph_]; } } while (0)
    if (bid < NB * 4 * NCH) PREP_PREFETCH(bid);
    for (int it = bid; it < NB * 4 * NCH; it += G) {
        PREP_DECODE(it, b, h, cn)
        int lo_ = 0; asm volatile("" : "+v"(lo_));
        const int c = tid & 127, tg = tid >> 7;
        float cw[3][4];
#pragma unroll
        for (int mat = 0; mat < 3; ++mat)
#pragma unroll
            for (int k = 0; k < 4; ++k) cw[mat][k] = P.gconv[k * 1536 + mat * 512 + h * 128 + c];
#pragma unroll
        for (int e = 0; e < 7; ++e) { const int q = tid + 512 * e; if (q < 3216) { const int mat = q / 1072, rem = q - mat * 1072; *(u32x4*)(RAW + lo_ + (mat * 67 + (rem >> 4)) * 256 + (rem & 15) * 16) = pr[e]; } }
        const float ba0 = pba0, ba1 = pba1;
        __syncthreads();
        if (it + G < NB * 4 * NCH) PREP_PREFETCH(it + G);
        if (tid < 128) {
            const int d = tid >> 6, i = lane;
            const float beta = sigmoidf_(ba0);
            float gg = -__expf(P.galog[d * 4 + h]) * softplusf_(ba1 + P.gdtb[d * 4 + h]);
#pragma unroll
            for (int o = 1; o < 64; o <<= 1) { const float t = __shfl_up(gg, o); if (lane >= o) gg += t; }
            GS[lo_ + d * 64 + i] = gg; RB[lo_ + d * 64 + i] = beta; RBE[lo_ + d * 64 + i] = beta * __expf(gg);
            ((float*)(P.ws + WS_GC))[((size_t)((d * 4 + b) * 4 + h) * NCH + cn) * 64 + i] = gg;
        }
        float yq[16];
        {
#pragma unroll
            for (int mat = 0; mat < 3; ++mat) {
                const bf16_t* rp = (const bf16_t*)(RAW + lo_ + (mat * 67 + tg * 16) * 256) + c;
                float xm2 = bf2f(rp[0]), xm1 = bf2f(rp[128]), x0 = bf2f(rp[256]);
#pragma unroll
                for (int i = 0; i < 16; ++i) { const float xp1 = bf2f(rp[(i + 3) * 128]);
                    const float y = siluf_(cw[mat][0] * xm2 + cw[mat][1] * xm1 + cw[mat][2] * x0 + cw[mat][3] * xp1);
                    if (mat == 0) yq[i] = y; else if (mat == 1) KF[lo_ + (tg * 16 + i) * KP + c] = y; else VF[lo_ + (tg * 16 + i) * KP + c] = y;
                    xm2 = xm1; xm1 = x0; x0 = xp1; }
            }
        }
        __syncthreads();
#pragma unroll
        for (int i = 0; i < 16; ++i) QF[lo_ + (tg * 16 + i) * KP + c] = yq[i];
        __syncthreads();
        {
            bf16_t* QG = (bf16_t*)(P.ws + WS_QG) + ((size_t)((b * 4 + h) * NCH + cn) * 64) * 128;
            bf16_t* KG = (bf16_t*)(P.ws + WS_KG) + ((size_t)((b * 4 + h) * NCH + cn) * 64) * 128;
#pragma unroll
            for (int tt = 0; tt < 8; ++tt) { const int tok = wave * 8 + tt;
                f32x2 q = *(f32x2*)(QF + lo_ + tok * KP + 2 * lane), k = *(f32x2*)(KF + lo_ + tok * KP + 2 * lane);
                const float sq = wave_sum(q[0] * q[0] + q[1] * q[1]), sk = wave_sum(k[0] * k[0] + k[1] * k[1]);
                q = q * (rsqrtf(sq + EPS) * 0.08838834764831845f); k = k * rsqrtf(sk + EPS);
                *(f32x2*)(KF + lo_ + tok * KP + 2 * lane) = k;
                const unsigned qp = pk2(q[0], q[1]), kp = pk2(k[0], k[1]);
                *(unsigned*)(Qb + lo_ + tok * TP + 4 * lane) = qp; *(unsigned*)(Kb + lo_ + tok * TP + 4 * lane) = kp;
                *(unsigned*)(QG + tok * 128 + 2 * lane) = qp; *(unsigned*)(KG + tok * 128 + 2 * lane) = kp; }
        }
        __syncthreads();
        const int mi = wave & 3, njp = wave >> 2;
        f32x4 ckk[2], cqk[2];
        ckk[0] = ckk[1] = cqk[0] = cqk[1] = (f32x4){0.f, 0.f, 0.f, 0.f};
#pragma unroll
        for (int ks = 0; ks < 4; ++ks) { const bf16x8 aK = ldfrag(Kb + lo_, mi * 16 + fr, TP, ks * 64 + fq * 16), aQ = ldfrag(Qb + lo_, mi * 16 + fr, TP, ks * 64 + fq * 16);
#pragma unroll
            for (int n2 = 0; n2 < 2; ++n2) { const bf16x8 bK = ldfrag(Kb + lo_, (njp * 2 + n2) * 16 + fr, TP, ks * 64 + fq * 16);
                ckk[n2] = __builtin_amdgcn_mfma_f32_16x16x32_bf16(aK, bK, ckk[n2], 0, 0, 0); cqk[n2] = __builtin_amdgcn_mfma_f32_16x16x32_bf16(aQ, bK, cqk[n2], 0, 0, 0); } }
        __syncthreads();
#pragma unroll
        for (int n2 = 0; n2 < 2; ++n2)
#pragma unroll
            for (int jj = 0; jj < 4; ++jj) { const int r = mi * 16 + fq * 4 + jj, sc = (njp * 2 + n2) * 16 + fr;
                const float e0 = __expf(GS[lo_ + r] - GS[lo_ + sc]), e1 = __expf(GS[lo_ + 64 + 63 - r] - GS[lo_ + 64 + 63 - sc]);
                const float kkv = ckk[n2][jj], qkv = cqk[n2][jj];
                AD[lo_ + r * 64 + sc] = (r > sc) ? RB[lo_ + r] * kkv * e0 : 0.f;
                AD[lo_ + 4096 + (63 - r) * 64 + (63 - sc)] = (r < sc) ? RB[lo_ + 64 + 63 - r] * kkv * e1 : 0.f;
                *(bf16_t*)(ATs + lo_ + r * 144 + sc * 2) = (bf16_t)f2bf((r >= sc) ? qkv * e0 : 0.f);
                *(bf16_t*)(ATs + lo_ + 9216 + (63 - r) * 144 + (63 - sc) * 2) = (bf16_t)f2bf((r <= sc) ? qkv * e1 : 0.f); }
        __syncthreads();
#pragma unroll
        for (int e = 0; e < 2; ++e) { const int idx = tid + 512 * e, d = idx >> 9, row = (idx >> 3) & 63, cc = idx & 7;
            bf16_t* ATT = (bf16_t*)(P.ws + WS_ATT) + ((size_t)((d * 4 + b) * 4 + h) * NCH + cn) * 4096;
            *(u32x4*)(ATT + row * 64 + cc * 8) = *(const u32x4*)(ATs + lo_ + d * 9216 + row * 144 + cc * 16); }
        {
            const int d = tid >> 8, cc = tid & 255;
            const float* src = (cc < 128) ? VF + lo_ + cc : KF + lo_ + (cc - 128); const float* scl = ((cc < 128) ? RB : RBE) + lo_ + d * 64;
            bf16_t* dst = (bf16_t*)(P.ws + (cc < 128 ? WS_UB : WS_WB)) + ((size_t)((d * 4 + b) * 4 + h) * NCH + cn) * 64 * 128 + (cc & 127);
            int sb_ = d ? 63 * KP : 0, ss_ = d ? -KP : KP; asm volatile("" : "+v"(sb_), "+v"(ss_));
            gdn_solve((const LAS float*)src, (const LAS float*)scl, (const LAS float*)(AD + lo_ + d * 4096), dst, sb_, ss_);
        }
        __syncthreads();
    }
#undef PREP_DECODE
#undef PREP_PREFETCH
}

template <int MODE>
__device__ __forceinline__ void lru_item(const Ptrs& P, unsigned char* lds, int b, int cn, int nb, int tid, int lane, int wave) {
    const bool isctx = cn < 4; const int cl = isctx ? cn : cn - 4, L = isctx ? CTXL : SEQ, s0 = cl * 64;
    const bf16_t* PB = (const bf16_t*)(P.ws + WS_PB);
    float* xin = (float*)lds;
    float* xT = (float*)(lds + 17408);
    float* wg = (float*)(lds + 34816);
    f32x2* seg = (f32x2*)(lds + 100352);
#define rowof(s_) (isctx ? (size_t)(M_LAT + b * CTXL + (s_)) : (size_t)(b * SEQ + ((s_) & 63) * 64 + ((s_) >> 6)))
    for (int idx = tid; idx < 67 * 64; idx += 512) { const int si = idx >> 6, c = idx & 63, s = s0 - 2 + si;
        xin[idx] = (s >= 0 && s < L) ? bf2f(PB[rowof(s) * 1536 + 512 + nb * 64 + c]) : 0.f; }
    for (int idx = tid; idx < 4 * 4096; idx += 512) { const int dg = idx >> 12; wg[idx] = P.lwg[((size_t)dg * 8 + nb) * 4096 + (idx & 4095)]; }
    __syncthreads();
    { const int c = tid & 63, ig = tid >> 6, ch = nb * 64 + c;
      const float w0 = P.lconv[ch], w1 = P.lconv[512 + ch], w2 = P.lconv[1024 + ch], w3 = P.lconv[1536 + ch], bias = P.lconvb[ch];
#pragma unroll
      for (int ii = 0; ii < 8; ++ii) { const int i = ig * 8 + ii; xT[c * 68 + i] = bias + w0 * xin[i * 64 + c] + w1 * xin[(i + 1) * 64 + c] + w2 * xin[(i + 2) * 64 + c] + w3 * xin[(i + 3) * 64 + c]; } }
    __syncthreads();
    const int co = tid & 63, ig = tid >> 6, ch = nb * 64 + co;
    float acc[4][8];
#pragma unroll
    for (int q = 0; q < 4; ++q)
#pragma unroll
        for (int ii = 0; ii < 8; ++ii) acc[q][ii] = 0.f;
#pragma unroll 4
    for (int ci = 0; ci < 64; ++ci) { const f32x4 xa = *(const f32x4*)(xT + ci * 68 + ig * 8), xb = *(const f32x4*)(xT + ci * 68 + ig * 8 + 4);
        float wv[4];
#pragma unroll
        for (int q = 0; q < 4; ++q) wv[q] = wg[q * 4096 + ci * 64 + co];
#pragma unroll
        for (int q = 0; q < 4; ++q) {
#pragma unroll
            for (int ii = 0; ii < 4; ++ii) { acc[q][ii] += wv[q] * xa[ii]; acc[q][ii + 4] += wv[q] * xb[ii]; } } }
    float av[2][8], bv[2][8];
#pragma unroll
    for (int d = 0; d < 2; ++d) { const float bgr = P.lbg[(d * 2 + 0) * 512 + ch], bgi = P.lbg[(d * 2 + 1) * 512 + ch], sp = softplusf_(-P.llam[d * 512 + ch]);
#pragma unroll
        for (int ii = 0; ii < 8; ++ii) { const int i = ig * 8 + ii; const float xv = xT[co * 68 + i];
            const float r = sigmoidf_(acc[d * 2][ii] + bgr), ing = sigmoidf_(acc[d * 2 + 1][ii] + bgi), la = -8.f * sp * r;
            float mult = sqrtf(-expm1f(2.f * la));
            if (isctx && ((d == 0 && cn == 0 && i == 0) || (d == 1 && cn == 3 && i == 63))) mult = 1.f;
            av[d][ii] = __expf(la); bv[d][ii] = mult * ing * xv; } }
    { float A0 = 1.f, B0 = 0.f, A1 = 1.f, B1 = 0.f;
#pragma unroll
      for (int ii = 0; ii < 8; ++ii) { B0 = av[0][ii] * B0 + bv[0][ii]; A0 *= av[0][ii]; B1 = av[1][7 - ii] * B1 + bv[1][7 - ii]; A1 *= av[1][7 - ii]; }
      seg[(ig * 2 + 0) * 64 + co] = (f32x2){A0, B0}; seg[(ig * 2 + 1) * 64 + co] = (f32x2){A1, B1}; }
    __syncthreads();
    if constexpr (MODE == 0) {
        if (tid < 128) { const int d = tid >> 6; float At = 1.f, Bt = 0.f;
#pragma unroll
            for (int k = 0; k < 8; ++k) { const int sg = d ? 7 - k : k; const f32x2 v = seg[(sg * 2 + d) * 64 + co]; Bt = v[0] * Bt + v[1]; At *= v[0]; }
            ((f32x2*)(P.ws + WS_LSUM))[((size_t)(b * 2 + d) * NCH + cn) * 512 + ch] = (f32x2){At, Bt}; }
    } else {
        const float* CAR = (const float*)(P.ws + WS_LCAR);
        float hf = CAR[((size_t)(b * 2 + 0) * NCH + cn) * 512 + ch], hb = CAR[((size_t)(b * 2 + 1) * NCH + cn) * 512 + ch];
        for (int k = 0; k < ig; ++k) { const f32x2 v = seg[(k * 2 + 0) * 64 + co]; hf = v[0] * hf + v[1]; }
        for (int k = 7; k > ig; --k) { const f32x2 v = seg[(k * 2 + 1) * 64 + co]; hb = v[0] * hb + v[1]; }
        float o[8];
#pragma unroll
        for (int ii = 0; ii < 8; ++ii) { hf = av[0][ii] * hf + bv[0][ii]; o[ii] = hf; }
#pragma unroll
        for (int ii = 7; ii >= 0; --ii) { hb = av[1][ii] * hb + bv[1][ii]; o[ii] += hb; }
        bf16_t* MIX = (bf16_t*)(P.ws + WS_MIX);
#pragma unroll
        for (int ii = 0; ii < 8; ++ii) { const size_t row = rowof(s0 + ig * 8 + ii); const float gt = bf2f(PB[row * 1536 + 1024 + ch]);
            MIX[row * D + 512 + ch] = (bf16_t)f2bf(o[ii] * geluf_(gt)); }
    }
    __syncthreads();
#undef rowof
}
template <int MODE>
__device__ __forceinline__ void lru_phase(const Ptrs& P, unsigned char* lds, int tid, int lane, int wave, int nb, int slot, int nslots) {
    const bf16_t* PB = (const bf16_t*)(P.ws + WS_PB);
    unsigned char* Wt = lds;
    float* xin = (float*)(lds + 36864);
    unsigned char* xb = lds + 54016;
    float* xc = (float*)(lds + 63232);
    f32x2* seg = (f32x2*)(lds + 80640);
    unsigned char* gtl = lds + 97024;
    unsigned char* otl = lds + 106240;
    for (int idx = tid; idx < 4 * 4096; idx += 512) { const int dg = idx >> 12, ci = (idx >> 6) & 63, co = idx & 63;
        *(bf16_t*)(Wt + dg * 9216 + co * 144 + ci * 2) = (bf16_t)f2bf(P.lwg[((size_t)dg * 8 + nb) * 4096 + (idx & 4095)]); }
    const int fr = lane & 15, fq = lane >> 4, nt = wave & 3, mh = wave >> 2;
    const int cch = nb * 64 + (tid & 63);
    const float cw0 = P.lconv[cch], cw1 = P.lconv[512 + cch], cw2 = P.lconv[1024 + cch], cw3 = P.lconv[1536 + cch], cbias = P.lconvb[cch];
    const int co = nt * 16 + fr, ch = nb * 64 + co;
    float bgr[2], bgi[2], sp[2];
#pragma unroll
    for (int d = 0; d < 2; ++d) { bgr[d] = P.lbg[(d * 2 + 0) * 512 + ch]; bgi[d] = P.lbg[(d * 2 + 1) * 512 + ch]; sp[d] = -8.f * softplusf_(-P.llam[d * 512 + ch]); }
    const int nitems = (MODE == 0) ? NB * NCH : NB * 64;
    u32x4 px[2], pg; px[0] = px[1] = pg = (u32x4){0u, 0u, 0u, 0u};
#define LRU_DECODE(j_, b_, cn_) const int b_ = (MODE == 0) ? (j_) / NCH : (j_) >> 6; const int cn_ = (MODE == 0) ? (j_) % NCH : 4 + ((j_) & 63);
#define LRU_ROW(b_, cn_, s_) ((cn_) < 4 ? (size_t)(M_LAT + (b_) * CTXL + (s_)) : (size_t)((b_) * SEQ + ((s_) & 63) * 64 + ((s_) >> 6)))
#define LRU_PREFETCH(j_) do { LRU_DECODE(j_, pb_, pcn_) const int pL_ = pcn_ < 4 ? CTXL : SEQ, ps0_ = (pcn_ < 4 ? pcn_ : pcn_ - 4) * 64; \
        _Pragma("unroll") for (int e_ = 0; e_ < 2; ++e_) { const int q_ = tid + 512 * e_, si_ = q_ >> 3, s_ = ps0_ - 2 + si_; \
            px[e_] = (q_ < 536 && s_ >= 0 && s_ < pL_) ? *(const u32x4*)(PB + LRU_ROW(pb_, pcn_, s_) * 1536 + 512 + nb * 64 + (q_ & 7) * 8) : (u32x4){0u, 0u, 0u, 0u}; } \
        if (MODE == 1) { const int i_ = tid >> 3; pg = *(const u32x4*)(PB + LRU_ROW(pb_, pcn_, ps0_ + i_) * 1536 + 1024 + nb * 64 + (tid & 7) * 8); } } while (0)
    if (slot < nitems) LRU_PREFETCH(slot);
    __syncthreads();
    for (int j = slot; j < nitems; j += nslots) {
        LRU_DECODE(j, b, cn)
        const bool isctx = cn < 4; const int s0 = (isctx ? cn : cn - 4) * 64;
#pragma unroll
        for (int e = 0; e < 2; ++e) { const int q = tid + 512 * e; if (q < 536) { float* dst = xin + (q >> 3) * 64 + (q & 7) * 8;
#pragma unroll
            for (int k = 0; k < 4; ++k) { dst[2 * k] = bf2f(px[e][k] & 0xffffu); dst[2 * k + 1] = bf2f(px[e][k] >> 16); } } }
        if (MODE == 1) *(u32x4*)(gtl + (tid >> 3) * 144 + (tid & 7) * 16) = pg;
        __syncthreads();
        if (j + nslots < nitems) LRU_PREFETCH(j + nslots);
        { const int c = tid & 63, ig = tid >> 6;
#pragma unroll
          for (int ii = 0; ii < 8; ++ii) { const int i = ig * 8 + ii; const float v = cbias + cw0 * xin[i * 64 + c] + cw1 * xin[(i + 1) * 64 + c] + cw2 * xin[(i + 2) * 64 + c] + cw3 * xin[(i + 3) * 64 + c];
              xc[i * 68 + c] = v; *(bf16_t*)(xb + i * 144 + c * 2) = (bf16_t)f2bf(v); } }
        __syncthreads();
        f32x4 acc[2][4];
#pragma unroll
        for (int m2 = 0; m2 < 2; ++m2)
#pragma unroll
            for (int dg = 0; dg < 4; ++dg) acc[m2][dg] = (f32x4){0.f, 0.f, 0.f, 0.f};
#pragma unroll
        for (int ks = 0; ks < 2; ++ks) { bf16x8 af[2];
#pragma unroll
            for (int m2 = 0; m2 < 2; ++m2) af[m2] = ldfrag(xb, (mh * 2 + m2) * 16 + fr, 144, ks * 64 + fq * 16);
#pragma unroll
            for (int dg = 0; dg < 4; ++dg) { const bf16x8 bfr = ldfrag(Wt + dg * 9216, nt * 16 + fr, 144, ks * 64 + fq * 16);
#pragma unroll
                for (int m2 = 0; m2 < 2; ++m2) acc[m2][dg] = __builtin_amdgcn_mfma_f32_16x16x32_bf16(af[m2], bfr, acc[m2][dg], 0, 0, 0); } }
        float av[2][2][4], bv[2][2][4];
#pragma unroll
        for (int m2 = 0; m2 < 2; ++m2)
#pragma unroll
            for (int jj = 0; jj < 4; ++jj) { const int i = (mh * 2 + m2) * 16 + fq * 4 + jj; const float xv = xc[i * 68 + co];
#pragma unroll
                for (int d = 0; d < 2; ++d) { const float r = sigmoidf_(acc[m2][d * 2][jj] + bgr[d]), ing = sigmoidf_(acc[m2][d * 2 + 1][jj] + bgi[d]), la = sp[d] * r;
                    const float aa = __expf(la);
                    float mult = __builtin_amdgcn_sqrtf(fmaxf(1.f - aa * aa, 0.f));
                    if (isctx && ((d == 0 && cn == 0 && i == 0) || (d == 1 && cn == 3 && i == 63))) mult = 1.f;
                    av[d][m2][jj] = aa; bv[d][m2][jj] = mult * ing * xv; } }
#pragma unroll
        for (int m2 = 0; m2 < 2; ++m2) { const int sg = (mh * 2 + m2) * 4 + fq; float A0 = 1.f, B0 = 0.f, A1 = 1.f, B1 = 0.f;
#pragma unroll
            for (int jj = 0; jj < 4; ++jj) { B0 = av[0][m2][jj] * B0 + bv[0][m2][jj]; A0 *= av[0][m2][jj]; B1 = av[1][m2][3 - jj] * B1 + bv[1][m2][3 - jj]; A1 *= av[1][m2][3 - jj]; }
            seg[(sg * 2 + 0) * 64 + co] = (f32x2){A0, B0}; seg[(sg * 2 + 1) * 64 + co] = (f32x2){A1, B1}; }
        __syncthreads();
        if constexpr (MODE == 0) {
            if (tid < 128) { const int d = tid >> 6, c2 = tid & 63; float At = 1.f, Bt = 0.f;
#pragma unroll
                for (int k = 0; k < 16; ++k) { const int sg = d ? 15 - k : k; const f32x2 v = seg[(sg * 2 + d) * 64 + c2]; Bt = v[0] * Bt + v[1]; At *= v[0]; }
                ((f32x2*)(P.ws + WS_LSUM))[((size_t)(b * 2 + d) * NCH + cn) * 512 + nb * 64 + c2] = (f32x2){At, Bt}; }
        } else {
            const float* CAR = (const float*)(P.ws + WS_LCAR);
            float hf = CAR[((size_t)(b * 2 + 0) * NCH + cn) * 512 + ch], hb = CAR[((size_t)(b * 2 + 1) * NCH + cn) * 512 + ch];
            const int sg0 = (mh * 2) * 4 + fq;
            for (int k = 0; k < sg0; ++k) { const f32x2 v = seg[(k * 2 + 0) * 64 + co]; hf = v[0] * hf + v[1]; }
            for (int k = 15; k > sg0 + 4; --k) { const f32x2 v = seg[(k * 2 + 1) * 64 + co]; hb = v[0] * hb + v[1]; }
            float o[2][4];
#pragma unroll
            for (int jj = 0; jj < 4; ++jj) { hf = av[0][0][jj] * hf + bv[0][0][jj]; o[0][jj] = hf; }
#pragma unroll
            for (int k = 1; k < 4; ++k) { const f32x2 v = seg[((sg0 + k) * 2 + 0) * 64 + co]; hf = v[0] * hf + v[1]; }
#pragma unroll
            for (int jj = 0; jj < 4; ++jj) { hf = av[0][1][jj] * hf + bv[0][1][jj]; o[1][jj] = hf; }
#pragma unroll
            for (int jj = 3; jj >= 0; --jj) { hb = av[1][1][jj] * hb + bv[1][1][jj]; o[1][jj] += hb; }
#pragma unroll
            for (int k = 3; k >= 1; --k) { const f32x2 v = seg[((sg0 + k) * 2 + 1) * 64 + co]; hb = v[0] * hb + v[1]; }
#pragma unroll
            for (int jj = 3; jj >= 0; --jj) { hb = av[1][0][jj] * hb + bv[1][0][jj]; o[0][jj] += hb; }
#pragma unroll
            for (int m2 = 0; m2 < 2; ++m2)
#pragma unroll
                for (int jj = 0; jj < 4; ++jj) { const int i = (mh * 2 + m2) * 16 + fq * 4 + jj; const float gt = bf2f(*(const bf16_t*)(gtl + i * 144 + co * 2));
                    *(bf16_t*)(otl + i * 144 + co * 2) = (bf16_t)f2bf(o[m2][jj] * geluf_(gt)); }
            __syncthreads();
            { const int i = tid >> 3; bf16_t* PBw = (bf16_t*)(P.ws + WS_PB);
              *(u32x4*)(PBw + LRU_ROW(b, cn, s0 + i) * 1536 + 1024 + nb * 64 + (tid & 7) * 8) = *(const u32x4*)(otl + i * 144 + (tid & 7) * 16); }
        }
        __syncthreads();
    }
#undef LRU_DECODE
#undef LRU_ROW
#undef LRU_PREFETCH
}
__device__ __forceinline__ void lru_carry(const Ptrs& P, int gt) {
    const int b = gt >> 10, d = (gt >> 9) & 1, ch = gt & 511;
    const f32x2* SUM = (const f32x2*)(P.ws + WS_LSUM) + (size_t)(b * 2 + d) * NCH * 512 + ch; float* CAR = (float*)(P.ws + WS_LCAR) + (size_t)(b * 2 + d) * NCH * 512 + ch;
    float carry = 0.f;
    for (int s0 = 0; s0 < NCH; s0 += 17) {
        f32x2 v[17];
#pragma unroll
        for (int k = 0; k < 17; ++k) v[k] = SUM[(size_t)chunk_of(d, s0 + k) * 512];
#pragma unroll
        for (int k = 0; k < 17; ++k) { CAR[(size_t)chunk_of(d, s0 + k) * 512] = carry; carry = v[k][0] * carry + v[k][1]; }
    }
}

__device__ __forceinline__ void gdn_combine(const Ptrs& P, int gw, int NGW, int lane) {
    const bf16_t* OF = (const bf16_t*)(P.ws + WS_OF); const bf16_t* OB = (const bf16_t*)(P.ws + WS_OB); const bf16_t* PB = (const bf16_t*)(P.ws + WS_PB); bf16_t* MIX = (bf16_t*)(P.ws + WS_MIX);
    float nw[8];
#pragma unroll
    for (int j = 0; j < 8; ++j) nw[j] = P.gnormw[(lane * 8 + j) & 127];
    for (int m = gw; m < M_LAT; m += NGW) {
        const u32x4 a = *(const u32x4*)(OF + (size_t)m * 512 + lane * 8), c = *(const u32x4*)(OB + (size_t)m * 512 + lane * 8), z = *(const u32x4*)(PB + (size_t)m * 1536 + lane * 8);
        float o[8], zz[8]; float ss = 0.f;
#pragma unroll
        for (int j = 0; j < 4; ++j) { o[2 * j] = bf2f(a[j] & 0xffffu) + bf2f(c[j] & 0xffffu); o[2 * j + 1] = bf2f(a[j] >> 16) + bf2f(c[j] >> 16); zz[2 * j] = bf2f(z[j] & 0xffffu); zz[2 * j + 1] = bf2f(z[j] >> 16); }
#pragma unroll
        for (int j = 0; j < 8; ++j) ss += o[j] * o[j];
        ss += __shfl_xor(ss, 1); ss += __shfl_xor(ss, 2); ss += __shfl_xor(ss, 4); ss += __shfl_xor(ss, 8);
        const float rs = rsqrtf(ss * (1.f / 128.f) + EPS);
        u32x4 w;
        w.x = pk2(o[0] * rs * nw[0] * siluf_(zz[0]), o[1] * rs * nw[1] * siluf_(zz[1])); w.y = pk2(o[2] * rs * nw[2] * siluf_(zz[2]), o[3] * rs * nw[3] * siluf_(zz[3]));
        w.z = pk2(o[4] * rs * nw[4] * siluf_(zz[4]), o[5] * rs * nw[5] * siluf_(zz[5])); w.w = pk2(o[6] * rs * nw[6] * siluf_(zz[6]), o[7] * rs * nw[7] * siluf_(zz[7]));
        *(u32x4*)(MIX + (size_t)m * D + lane * 8) = w;
        *(u32x4*)(MIX + (size_t)m * D + 512 + lane * 8) = *(const u32x4*)(PB + (size_t)m * 1536 + 1024 + lane * 8);
    }
}

#define RLX_AGENT __ATOMIC_RELAXED, __HIP_MEMORY_SCOPE_AGENT
#define XB_TMO      128
#define XB_XCNT(j)  (256  + 64 * (j))
#define XB_XSUB(j)  (1280 + 64 * (j))
#define XB_XGEN(j)  (2304 + 64 * (j))
#define XB_TOP      3328
#define XB_TOPGEN   3392
#define XCD_BAR_WORDS 3456
#define XB_SPIN_CAP (1u << 18)

__device__ __forceinline__ unsigned xb_ld(unsigned* p)              { return __hip_atomic_load(p, __ATOMIC_RELAXED, __HIP_MEMORY_SCOPE_AGENT); }
__device__ __forceinline__ unsigned xb_add(unsigned* p, unsigned v) { return __hip_atomic_fetch_add(p, v, __ATOMIC_RELAXED, __HIP_MEMORY_SCOPE_AGENT); }
__device__ __forceinline__ unsigned xb_xcc_id() { return (unsigned)__builtin_amdgcn_s_getreg((3 << 11) | 20) & 0xFu; }
#define XB_SPIN(cond, bar) do { unsigned _sp = 0; while (cond) { __builtin_amdgcn_s_sleep(1); \
    if ((++_sp & 255u) == 0u) { if (xb_ld(&(bar)[XB_TMO])) break; if (_sp > XB_SPIN_CAP) { atomicAdd(&(bar)[XB_TMO], 1u); break; } } } } while (0)

struct XcdBarrier {
    unsigned* bar; unsigned x;
    volatile LAS unsigned* st;
};

__device__ __forceinline__ XcdBarrier xcd_barrier_post(unsigned* bar, volatile LAS unsigned* st) {
    XcdBarrier b; b.bar = bar; b.x = xb_xcc_id(); b.st = st;
    if (threadIdx.x == 0) (void)xb_add(&bar[XB_XCNT(b.x)], 1u);
    return b;
}
__device__ __forceinline__ void xcd_barrier_complete(unsigned* bar, unsigned x, unsigned& nloc, unsigned& nx) {
    const unsigned G = gridDim.x * gridDim.y * gridDim.z;
    unsigned sum, cnt, mine, sp = 0u;
    for (;;) {
        sum = 0u; cnt = 0u; mine = 0u;
#pragma unroll
        for (unsigned j = 0; j < 16; ++j) { const unsigned c = xb_ld(&bar[XB_XCNT(j)]); sum += c; cnt += (c > 0u) ? 1u : 0u; mine = (j == x) ? c : mine; }
        if (sum == G) break;
        __builtin_amdgcn_s_sleep(1);
        if ((++sp & 255u) == 0u) { if (xb_ld(&bar[XB_TMO])) break; if (sp > XB_SPIN_CAP) { atomicAdd(&bar[XB_TMO], 1u); break; } }
    }
    nloc = mine > 0u ? mine : 1u; nx = cnt > 0u ? cnt : 1u;
}

__device__ __forceinline__ void xcd_barrier(const XcdBarrier& b) {
    asm volatile("s_waitcnt vmcnt(0)" ::: "memory");
    __syncthreads();
    if (threadIdx.x == 0) {
        unsigned* bar = b.bar;
        __builtin_amdgcn_s_waitcnt(0);
        unsigned nloc = b.st[0], nx = b.st[1];
        if (nloc == 0u) { xcd_barrier_complete(bar, b.x, nloc, nx); b.st[0] = nloc; b.st[1] = nx; }
        const unsigned old = xb_add(&bar[XB_XSUB(b.x)], 1u);
        const unsigned gen = old / nloc;
        if (old + 1u == (gen + 1u) * nloc) {
            __builtin_amdgcn_fence(__ATOMIC_RELEASE, "agent");
            asm volatile("s_waitcnt vmcnt(0)" ::: "memory");
            const unsigned og = xb_add(&bar[XB_TOP], 1u);
            const unsigned tg = og / nx;
            if (og + 1u == (tg + 1u) * nx) xb_add(&bar[XB_TOPGEN], 1u);
            else XB_SPIN(xb_ld(&bar[XB_TOPGEN]) == tg, bar);
            __builtin_amdgcn_fence(__ATOMIC_ACQUIRE, "agent");
            xb_add(&bar[XB_XGEN(b.x)], 1u);
            asm volatile("s_waitcnt vmcnt(0)" ::: "memory");
        } else {
            XB_SPIN(xb_ld(&bar[XB_XGEN(b.x)]) == gen, bar);
            __builtin_amdgcn_fence(__ATOMIC_ACQUIRE, "agent");
            asm volatile("s_waitcnt vmcnt(0)" ::: "memory");
        }
    }
    __syncthreads();
}


__device__ __forceinline__ void sub_barrier(unsigned* cnt, unsigned target) {
    asm volatile("s_waitcnt vmcnt(0)" ::: "memory");
    __syncthreads();
    if (threadIdx.x == 0) {
        __builtin_amdgcn_fence(__ATOMIC_RELEASE, "agent");
        asm volatile("s_waitcnt vmcnt(0)" ::: "memory");
        (void)__hip_atomic_fetch_add(cnt, 1u, __ATOMIC_RELAXED, __HIP_MEMORY_SCOPE_AGENT);
        unsigned sp = 0u;
        while (__hip_atomic_load(cnt, __ATOMIC_RELAXED, __HIP_MEMORY_SCOPE_AGENT) < target) { __builtin_amdgcn_s_sleep(1); if (++sp > (1u << 22)) break; }
        __builtin_amdgcn_fence(__ATOMIC_ACQUIRE, "agent");
        asm volatile("s_waitcnt vmcnt(0)" ::: "memory");
    }
    __syncthreads();
}

struct Args { const float* in[22]; float* out; unsigned char* ws; int ph_lo, ph_hi; };
constexpr int N_PHASES = 14;

__global__ void __launch_bounds__(512, 2) fwd_kernel(Args args) {
    extern __shared__ __attribute__((aligned(16))) unsigned char lds[];
    const int tid = threadIdx.x, lane = tid & 63, wave = __builtin_amdgcn_readfirstlane(tid >> 6);
    const int G = gridDim.x, bid = blockIdx.x, gw = bid * 8 + wave, NGW = G * 8;
    Ptrs P;
    P.x = args.in[0]; P.c = args.in[1]; P.ctx = args.in[2]; P.cctx = args.in[3]; P.w_ada = args.in[4]; P.b_ada = args.in[5]; P.norm_g = args.in[6];
    P.w1 = args.in[7]; P.w3 = args.in[8]; P.w2 = args.in[9]; P.w_in = args.in[10]; P.w_out = args.in[11]; P.gconv = args.in[12]; P.galog = args.in[13]; P.gdtb = args.in[14];
    P.gnormw = args.in[15]; P.lconv = args.in[16]; P.lconvb = args.in[17]; P.lwg = args.in[18]; P.lbg = args.in[19]; P.llam = args.in[20]; P.fng = args.in[21];
    P.out = args.out; P.ws = args.ws;
    unsigned char* ws = args.ws;
    const float* mods = (const float*)(ws + WS_MODS);
    bf16_t* U = (bf16_t*)(ws + WS_U); bf16_t* HID = (bf16_t*)(ws + WS_HID); float* H1CTX = (float*)(ws + WS_H1CTX);
    LAS unsigned char* ldsl = (LAS unsigned char*)lds;
    const int lo = args.ph_lo, hi = args.ph_hi;
#ifndef REP_MASK
#define REP_MASK 0
#endif
#ifndef SKIP_MASK
#define SKIP_MASK 0
#endif
#define IN(k) (!((SKIP_MASK >> (k)) & 1) && lo <= (k) && (k) < hi)
#define SEAM(k) do { if (IN(k) && IN((k) + 1)) { if ((k) == 0) cg::this_grid().sync(); else xcd_barrier(bar); } } while (0)
    volatile LAS unsigned* MISC = (volatile LAS unsigned*)(ldsl + LDS_BYTES - 64);
    if (tid == 0) { MISC[0] = 0u; MISC[1] = 0u; }
    __syncthreads();
    XcdBarrier bar = xcd_barrier_post((unsigned*)ws + 4096, MISC);

    if (IN(0)) for (int rep_ = 0; rep_ < 1 + ((REP_MASK >> 0) & 1); ++rep_) { if (rep_) __syncthreads(); phase_prologue(P, lds, tid, lane, wave, bid, G); } SEAM(0);
    if (IN(1)) for (int rep_ = 0; rep_ < 1 + ((REP_MASK >> 1) & 1); ++rep_) { if (rep_) __syncthreads(); phase_norm_mod(P.x, P.ctx, M_TOT, P.norm_g, mods, 0, 1, U, gw, NGW, lane); } SEAM(1);
    if (IN(2)) for (int rep_ = 0; rep_ < 1 + ((REP_MASK >> 2) & 1); ++rep_) { if (rep_) __syncthreads(); pg8::Gemm g{U, (const bf16_t*)(ws + WS_W1A), M_TOT, 2 * FF, D}; pg8::StaticOrder S; S.init(M_TOT, 2 * FF, G, bid); pg8::EpiSwiglu E{HID};
        pg8::gemm_phase<pg8::EpiSwiglu, true>(ldsl, g, S, E); } SEAM(2);
    if (IN(3)) for (int rep_ = 0; rep_ < 1 + ((REP_MASK >> 3) & 1); ++rep_) { if (rep_) __syncthreads(); pg8::Gemm g{HID, (const bf16_t*)(ws + WS_W2A), M_TOT, D, FF}; pg8::StaticOrder S; S.init(M_TOT, D, G, bid);
        pg8::EpiRes E{P.x, P.ctx, P.out, H1CTX, mods + 2 * D, 0.5f}; pg8::gemm_phase<pg8::EpiRes, true>(ldsl, g, S, E); } SEAM(3);
    if (IN(4)) for (int rep_ = 0; rep_ < 1 + ((REP_MASK >> 4) & 1); ++rep_) { if (rep_) __syncthreads(); phase_norm_mod(P.out, H1CTX, M_TOT, P.norm_g + D, mods, 3, 4, U, gw, NGW, lane); } SEAM(4);
    if (IN(5)) for (int rep_ = 0; rep_ < 1 + ((REP_MASK >> 5) & 1); ++rep_) { if (rep_) __syncthreads(); pg8::Gemm g{U, (const bf16_t*)(ws + WS_WIN), M_TOT, NIN, D}; pg8::StaticOrder S; S.init(M_TOT, NIN, G, bid);
        pg8::EpiIn E{(bf16_t*)(ws + WS_PA), (bf16_t*)(ws + WS_PB), (float*)(ws + WS_BA)}; pg8::gemm_phase<pg8::EpiIn, true>(ldsl, g, S, E); } SEAM(5);
    if (IN(6)) for (int rep_ = 0; rep_ < 1 + ((REP_MASK >> 6) & 1); ++rep_) { if (rep_) __syncthreads();
        gdn_prep_phase(P, lds, tid, lane, wave, bid, G);
    } SEAM(6);
    if (IN(7)) for (int rep_ = 0; rep_ < 1 + ((REP_MASK >> 7) & 1); ++rep_) { if (rep_) __syncthreads();
        if (bid < 128) { gdn_scan_item(P, lds, bid, tid, lane, wave); }
        else {
            unsigned* cnt = (unsigned*)ws + 8192;
            const int nb = bid & 7, slot = (bid - 128) >> 3;
            lru_phase<0>(P, lds, tid, lane, wave, nb, slot, 16);
            sub_barrier(cnt, 128u);
            if (slot == 0) lru_carry(P, nb * 512 + tid);
            sub_barrier(cnt + 64, 128u);
            lru_phase<1>(P, lds, tid, lane, wave, nb, slot, 16);
        }
    } SEAM(7);
    if (IN(8)) for (int rep_ = 0; rep_ < 1 + ((REP_MASK >> 8) & 1); ++rep_) { if (rep_) __syncthreads();
        gdn_combine(P, gw, NGW, lane);
    } SEAM(8);
    if (IN(9)) for (int rep_ = 0; rep_ < 1 + ((REP_MASK >> 9) & 1); ++rep_) { if (rep_) __syncthreads(); pg8::Gemm g{(const bf16_t*)(ws + WS_MIX), (const bf16_t*)(ws + WS_WOUT), M_LAT, D, D}; pg8::StaticOrder S; S.init(M_LAT, D, G, bid);
        pg8::EpiRes E{P.out, P.out, P.out, P.out, mods + 5 * D, 1.0f}; pg8::gemm_phase<pg8::EpiRes, true>(ldsl, g, S, E); } SEAM(9);
    if (IN(10)) for (int rep_ = 0; rep_ < 1 + ((REP_MASK >> 10) & 1); ++rep_) { if (rep_) __syncthreads(); phase_norm_mod(P.out, P.out, M_LAT, P.norm_g + 2 * D, mods, 6, 7, U, gw, NGW, lane); } SEAM(10);
    if (IN(11)) for (int rep_ = 0; rep_ < 1 + ((REP_MASK >> 11) & 1); ++rep_) { if (rep_) __syncthreads(); pg8::Gemm g{U, (const bf16_t*)(ws + WS_W1B), M_LAT, 2 * FF, D}; pg8::StaticOrder S; S.init(M_LAT, 2 * FF, G, bid); pg8::EpiSwiglu E{HID};
        pg8::gemm_phase<pg8::EpiSwiglu, true>(ldsl, g, S, E); } SEAM(11);
    if (IN(12)) for (int rep_ = 0; rep_ < 1 + ((REP_MASK >> 12) & 1); ++rep_) { if (rep_) __syncthreads(); pg8::Gemm g{HID, (const bf16_t*)(ws + WS_W2B), M_LAT, D, FF}; pg8::StaticOrder S; S.init(M_LAT, D, G, bid);
        pg8::EpiRes E{P.out, P.out, P.out, P.out, mods + 8 * D, 0.5f}; pg8::gemm_phase<pg8::EpiRes, true>(ldsl, g, S, E); } SEAM(12);
    if (IN(13)) for (int rep_ = 0; rep_ < 1 + ((REP_MASK >> 13) & 1); ++rep_) { if (rep_) __syncthreads();
        for (int m = gw; m < M_LAT; m += NGW) { float* row = P.out + (size_t)m * D; f32x4 v[4]; float ss = 0.f;
#pragma unroll
            for (int j = 0; j < 4; ++j) { v[j] = *(const f32x4*)(row + 4 * lane + 256 * j); ss += (v[j][0] * v[j][0] + v[j][1] * v[j][1]) + (v[j][2] * v[j][2] + v[j][3] * v[j][3]); }
            const float rstd = rsqrtf(wave_sum(ss) * (1.f / D) + EPS);
#pragma unroll
            for (int j = 0; j < 4; ++j) { const f32x4 gv = *(const f32x4*)(P.fng + 4 * lane + 256 * j); *(f32x4*)(row + 4 * lane + 256 * j) = v[j] * rstd * gv; } }
    }
#undef IN
#undef SEAM
}

extern "C" void kernel_launch(void* const* d_in, const int* in_sizes, int n_in, void* d_out, int out_size, void* d_ws, size_t ws_size, hipStream_t stream) {
    static int grid = 0;
    if (grid == 0) {
        if (n_in != 22 || out_size != M_LAT * D || ws_size < WS_END) { fprintf(stderr, "kernel_launch: unexpected shapes (n_in %d, out %d, ws %zu)\n", n_in, out_size, ws_size); grid = -1; return; }
        int dev = 0, cus = 0, per_cu = 0;
        hipGetDevice(&dev); hipDeviceGetAttribute(&cus, hipDeviceAttributeMultiprocessorCount, dev);
        if (hipFuncSetAttribute((const void*)fwd_kernel, hipFuncAttributeMaxDynamicSharedMemorySize, LDS_BYTES) != hipSuccess) { fprintf(stderr, "kernel_launch: hipFuncSetAttribute failed\n"); grid = -1; return; }
        if (hipOccupancyMaxActiveBlocksPerMultiprocessor(&per_cu, (const void*)fwd_kernel, 512, LDS_BYTES) != hipSuccess || per_cu < 1) { fprintf(stderr, "kernel_launch: occupancy query gives %d\n", per_cu); per_cu = 1; }
        (void)hipGetLastError();
        grid = 256;
        if (cus * per_cu < 256) { fprintf(stderr, "kernel_launch: device too small (%d x %d)\n", cus, per_cu); grid = -1; return; }
        fprintf(stderr, "kernel_launch: grid %d (cus %d, per_cu %d)\n", grid, cus, per_cu);
    }
    if (grid < 0) return;
    Args a{};
    for (int i = 0; i < 22; ++i) a.in[i] = (const float*)d_in[i];
    a.out = (float*)d_out; a.ws = (unsigned char*)d_ws;
    if (hipMemsetAsync(d_ws, 0, 65536, stream) != hipSuccess) { fprintf(stderr, "kernel_launch: memset failed\n"); return; }
#if ONE_LAUNCH
    a.ph_lo = 0; a.ph_hi = N_PHASES;
    void* kargs[] = {&a};
    hipError_t e = hipLaunchCooperativeKernel((const void*)fwd_kernel, dim3(grid), dim3(512), kargs, LDS_BYTES, stream);
    if (e != hipSuccess) fprintf(stderr, "kernel_launch: cooperative launch failed: %s\n", hipGetErrorString(e));
#else
    for (int p = 0; p < N_PHASES; ++p) { a.ph_lo = p; a.ph_hi = p + 1; hipLaunchKernelGGL(fwd_kernel, dim3(grid), dim3(512), LDS_BYTES, stream, a); }
#endif
}
```

```cpp
#include <hip/hip_runtime.h>
#include <hip/hip_cooperative_groups.h>
#include <cstdio>
#include <cstdint>
namespace cg = cooperative_groups;

#ifndef ONE_LAUNCH
#define ONE_LAUNCH 1
#endif

#define LAS __attribute__((address_space(3)))
typedef unsigned short bf16_t;
typedef short bf16x8 __attribute__((ext_vector_type(8)));
typedef float f32x4 __attribute__((ext_vector_type(4)));
typedef float f32x2 __attribute__((ext_vector_type(2)));
typedef unsigned u32x4 __attribute__((ext_vector_type(4)));
typedef unsigned u32x2 __attribute__((ext_vector_type(2)));

constexpr int D = 1024, NB = 4, SEQ = 4096, CTXL = 256, FF = 2816;
constexpr int M_LAT = NB * SEQ, M_CTX = NB * CTXL, M_TOT = M_LAT + M_CTX;
constexpr int NMOD = 9 * D;
constexpr int IN_COLS = 3088, NIN = 3328;
constexpr int NCH = 68;
constexpr float EPS = 1e-6f;

constexpr size_t MiB = 1u << 20;
constexpr size_t WS_MODS = 1 * MiB, WS_BA = 2 * MiB, WS_GC = 4 * MiB, WS_LSUM = 5 * MiB, WS_LCAR = 7 * MiB + MiB / 2;
constexpr size_t WS_WOUT = 10 * MiB, WS_W1B = 12 * MiB, WS_W2B = 23 * MiB;
constexpr size_t WS_PA = 29 * MiB, WS_PB = 80 * MiB, WS_HID = 29 * MiB, WS_OF = 29 * MiB, WS_OB = 45 * MiB;
constexpr size_t WS_U = 131 * MiB, WS_W1A = 165 * MiB, WS_W2A = 176 * MiB, WS_WIN = 182 * MiB, WS_H1CTX = 189 * MiB;
constexpr size_t WS_QG = 131 * MiB, WS_KG = 148 * MiB, WS_WB = 165 * MiB, WS_UB = 199 * MiB, WS_ATT = 233 * MiB, WS_MIX = 131 * MiB;
constexpr size_t WS_END = 256 * MiB;
constexpr int LDS_BYTES = 147456;

__device__ __forceinline__ unsigned f2bf(float f) { unsigned u = __builtin_bit_cast(unsigned, f); return (u + 0x7fffu + ((u >> 16) & 1u)) >> 16; }
__device__ __forceinline__ unsigned pk2(float lo, float hi) { return f2bf(lo) | (f2bf(hi) << 16); }
__device__ __forceinline__ float bf2f(unsigned h) { return __builtin_bit_cast(float, h << 16); }
__device__ __forceinline__ float wave_sum(float v) {
#pragma unroll
    for (int o = 1; o < 64; o <<= 1) v += __shfl_xor(v, o);
    return v;
}
__device__ __forceinline__ float sigmoidf_(float x) { return __builtin_amdgcn_rcpf(1.f + __expf(-x)); }
__device__ __forceinline__ float siluf_(float x) { return x * __builtin_amdgcn_rcpf(1.f + __expf(-x)); }
__device__ __forceinline__ float softplusf_(float x) { return x > 20.f ? x : log1pf(__expf(x)); }
__device__ __forceinline__ float geluf_(float x) { const float t = 0.7978845608f * (x + 0.044715f * x * x * x); return x * __builtin_amdgcn_rcpf(1.f + __expf(-2.f * t)); }
#define LDS_WAIT() asm volatile("s_waitcnt lgkmcnt(0)" ::: "memory")
#define BAR_LDS() do { asm volatile("s_waitcnt lgkmcnt(0)" ::: "memory"); __builtin_amdgcn_s_barrier(); asm volatile("" ::: "memory"); } while (0)

namespace pg8 {
constexpr int BM = 256, BK = 64, HALF = 128, HTB = HALF * BK * 2, NXCD = 8, WGM = 8;
__host__ __device__ __forceinline__ int lds_byte(int r, int c) { const int st = (r >> 4) * 2 + (c >> 5), rr = r & 15, cc = c & 31, ob = rr * 64 + cc * 2; return st * 1024 + (ob ^ (((ob >> 9) & 1) << 5)); }
__host__ __device__ __forceinline__ void stage_rc(int b, int& R, int& C) { const int st = b / 1024, sb = b % 1024, swz = sb ^ (((sb >> 9) & 1) << 5); R = (st >> 1) * 16 + swz / 64; C = (st & 1) * 32 + (swz % 64) / 2; }
struct Unit { int pm, pn; };
struct Gemm { const bf16_t* A; const bf16_t* Bt; int M, N, K; };
struct StaticOrder {
    int nM, nN, nwg, G, c;
    __device__ void init(int M, int N, int G_, int c_) { nM = M / BM; nN = N / BM; nwg = nM * nN; G = G_; c = c_; }
    __device__ bool next(int i, Unit& u) const {
        const long L = (long)i * G + c; if (L >= nwg) return false;
        int wgid = (int)L; { const int q = nwg / NXCD, r = nwg % NXCD, xcd = wgid % NXCD, off = wgid / NXCD; wgid = (xcd < r ? xcd * (q + 1) : r * (q + 1) + (xcd - r) * q) + off; }
        const int nig = WGM * nN, gid = wgid / nig, fm = gid * WGM, gsz = (nM - fm) < WGM ? (nM - fm) : WGM;
        u.pm = fm + ((wgid % nig) % gsz); u.pn = (wgid % nig) / gsz; return true;
    }
};
template <class Epi, bool ALIGN_EPI>
__device__ __forceinline__ void gemm_phase(LAS unsigned char* lds, const Gemm g, const StaticOrder& S, const Epi& E) {
    const int tid = threadIdx.x, wid = __builtin_amdgcn_readfirstlane(tid >> 6), lane = tid & 63, wr = wid >> 2, wc = wid & 3, fr = lane & 15, fq = lane >> 4;
    const int K = g.K, nt = K / BK;
    unsigned voffA[2];
#pragma unroll
    for (int i = 0; i < 2; ++i) { int R, C; stage_rc(tid * 16 + i * 8192, R, C); voffA[i] = (unsigned)(R * K + C) * 2u; }
    const size_t kstep = (size_t)(BK * 2);
    const size_t hstep = (size_t)HALF * K * 2;
    const size_t tstep = 2 * hstep;
    const unsigned ldsw = (unsigned)wid * 1024u;
    const int aoff = lds_byte(wr * 64 + fr, fq * 8), boff = lds_byte(wc * 32 + fr, fq * 8);
#define PG8_SA(b, h) (((b) * 2 + (h)) * HTB)
#define PG8_SB(b, h) ((4 + (b) * 2 + (h)) * HTB)
#define PG8_STAGE(bufoff, gbase, voff) do { _Pragma("unroll") for (int _i = 0; _i < 2; ++_i) \
        __builtin_amdgcn_global_load_lds((const unsigned*)((const char*)(gbase) + (voff)[_i]), (LAS unsigned*)(lds + (bufoff) + ldsw + _i * 8192), 16, 0, 0); } while (0)
#define PG8_LDA(dst, b, h) do { _Pragma("unroll") for (int m = 0; m < 4; ++m) _Pragma("unroll") for (int k = 0; k < 2; ++k) dst[m][k] = *(const LAS bf16x8*)(lds + PG8_SA(b, h) + aoff + m * 2048 + k * 1024); } while (0)
#define PG8_LDB(dst, b, h) do { _Pragma("unroll") for (int n = 0; n < 2; ++n) _Pragma("unroll") for (int k = 0; k < 2; ++k) dst[n][k] = *(const LAS bf16x8*)(lds + PG8_SB(b, h) + boff + n * 2048 + k * 1024); } while (0)
#define PG8_MMA(ai, bj, At, Bt) do { __builtin_amdgcn_s_setprio(1); _Pragma("unroll") for (int m = 0; m < 4; ++m) _Pragma("unroll") for (int n = 0; n < 2; ++n) _Pragma("unroll") for (int k = 0; k < 2; ++k) \
        acc[ai][bj][m][n] = __builtin_amdgcn_mfma_f32_16x16x32_bf16(Bt[n][k], At[m][k], acc[ai][bj][m][n], 0, 0, 0); __builtin_amdgcn_s_setprio(0); } while (0)
#define PG8_WAIT_V(n) asm volatile("s_waitcnt vmcnt(" #n ")" ::: "memory")
#define PG8_WAIT_L(n) asm volatile("s_waitcnt lgkmcnt(" #n ")" ::: "memory")
#define PG8_BAR __builtin_amdgcn_s_barrier()
#define PG8_SCHED __builtin_amdgcn_sched_barrier(0)
    Unit cur, nxt; int ui = 0;
    if (!S.next(0, cur)) return;
    f32x4 acc[2][2][4][2];
#pragma unroll
    for (int a = 0; a < 2; ++a)
#pragma unroll
        for (int b = 0; b < 2; ++b)
#pragma unroll
            for (int m = 0; m < 4; ++m)
#pragma unroll
                for (int n = 0; n < 2; ++n) acc[a][b][m][n] = (f32x4){0.f, 0.f, 0.f, 0.f};
    bf16x8 At[4][2], B0[2][2], B1[2][2];
    const char* cA = (const char*)g.A + (size_t)cur.pm * tstep; const char* cB = (const char*)g.Bt + (size_t)cur.pn * tstep;
    PG8_STAGE(PG8_SB(0, 0), cB, voffA); PG8_STAGE(PG8_SB(0, 1), cB + hstep, voffA); PG8_STAGE(PG8_SA(0, 0), cA, voffA); PG8_STAGE(PG8_SA(0, 1), cA + hstep, voffA);
    if (wr == 1) PG8_BAR;
    PG8_WAIT_V(2); PG8_BAR;
    PG8_STAGE(PG8_SB(1, 0), cB + kstep, voffA); PG8_STAGE(PG8_SA(1, 0), cA + kstep, voffA); PG8_STAGE(PG8_SB(1, 1), cB + hstep + kstep, voffA);
    PG8_WAIT_V(6); PG8_BAR;
    for (;;) {
        const bool has_next = S.next(ui + 1, nxt);
        const char* nA = has_next ? (const char*)g.A + (size_t)nxt.pm * tstep : cA; const char* nB = has_next ? (const char*)g.Bt + (size_t)nxt.pn * tstep : cB;
        for (int t = 0; t < nt; t += 2) {
            const bool last = (t == nt - 2);
            const char* a1 = cA + (size_t)(t + 1) * kstep;
            const char* a2 = last ? nA : cA + (size_t)(t + 2) * kstep; const char* b2 = last ? nB : cB + (size_t)(t + 2) * kstep;
            const char* a3 = a2 + kstep; const char* b3 = b2 + kstep;
            PG8_LDB(B0, 0, 0); PG8_LDB(B1, 0, 1); PG8_SCHED; PG8_LDA(At, 0, 0); PG8_STAGE(PG8_SA(1, 1), a1 + hstep, voffA);
            PG8_WAIT_V(8); PG8_WAIT_L(0); PG8_BAR; PG8_MMA(0, 0, At, B0); PG8_MMA(0, 1, At, B1); PG8_BAR; PG8_SCHED;
            PG8_LDA(At, 0, 1); PG8_STAGE(PG8_SB(0, 0), b2, voffA); PG8_STAGE(PG8_SB(0, 1), b2 + hstep, voffA); PG8_STAGE(PG8_SA(0, 0), a2, voffA);
            PG8_WAIT_V(8); PG8_WAIT_L(0); PG8_BAR; PG8_MMA(1, 0, At, B0); PG8_MMA(1, 1, At, B1); PG8_BAR; PG8_SCHED;
            PG8_LDB(B0, 1, 0); PG8_LDB(B1, 1, 1); PG8_SCHED; PG8_LDA(At, 1, 0); PG8_STAGE(PG8_SA(0, 1), a2 + hstep, voffA);
            PG8_WAIT_V(8); PG8_WAIT_L(0); PG8_BAR; PG8_MMA(0, 0, At, B0); PG8_MMA(0, 1, At, B1); PG8_BAR; PG8_SCHED;
            PG8_LDA(At, 1, 1); PG8_STAGE(PG8_SB(1, 0), b3, voffA); PG8_STAGE(PG8_SB(1, 1), b3 + hstep, voffA); PG8_STAGE(PG8_SA(1, 0), a3, voffA);
            PG8_WAIT_V(8); PG8_WAIT_L(0); PG8_BAR; PG8_MMA(1, 0, At, B0); PG8_MMA(1, 1, At, B1); PG8_BAR; PG8_SCHED;
        }
        if constexpr (ALIGN_EPI) { if (wr == 0) PG8_BAR; }
        E(acc, cur, wr, wc, fr, fq);
        if (!has_next) break;
#pragma unroll
        for (int a = 0; a < 2; ++a)
#pragma unroll
            for (int b = 0; b < 2; ++b)
#pragma unroll
                for (int m = 0; m < 4; ++m)
#pragma unroll
                    for (int n = 0; n < 2; ++n) acc[a][b][m][n] = (f32x4){0.f, 0.f, 0.f, 0.f};
        cur = nxt; cA = nA; cB = nB; ++ui;
        if constexpr (ALIGN_EPI) { if (wr == 1) PG8_BAR; }
    }
    PG8_WAIT_V(0);
    if constexpr (!ALIGN_EPI) { if (wr == 0) PG8_BAR; }
    PG8_BAR;
#undef PG8_SA
#undef PG8_SB
#undef PG8_STAGE
#undef PG8_LDA
#undef PG8_LDB
#undef PG8_MMA
#undef PG8_WAIT_V
#undef PG8_WAIT_L
#undef PG8_BAR
#undef PG8_SCHED
}

struct EpiSwiglu {
    bf16_t* H;
    __device__ __forceinline__ void operator()(const f32x4 (&acc)[2][2][4][2], const Unit& u, int wr, int wc, int fr, int fq) const {
        const int row0 = u.pm * BM + wr * 64 + fr, col0 = u.pn * 128 + wc * 32 + 4 * fq;
#pragma unroll
        for (int ai = 0; ai < 2; ++ai)
#pragma unroll
            for (int m = 0; m < 4; ++m) { bf16_t* rowp = H + (size_t)(row0 + ai * HALF + m * 16) * FF + col0;
#pragma unroll
                for (int n = 0; n < 2; ++n) { const f32x4 gt = acc[ai][0][m][n], up = acc[ai][1][m][n];
                    u32x2 w; w.x = pk2(siluf_(gt[0]) * up[0], siluf_(gt[1]) * up[1]); w.y = pk2(siluf_(gt[2]) * up[2], siluf_(gt[3]) * up[3]);
                    *(u32x2*)(rowp + n * 16) = w; } }
    }
};
struct EpiRes {
    const float* res_lat; const float* res_ctx; float* out_lat; float* out_ctx; const float* gate; float coef;
    __device__ __forceinline__ void operator()(const f32x4 (&acc)[2][2][4][2], const Unit& u, int wr, int wc, int fr, int fq) const {
        const bool isctx = u.pm >= 64; const int mr = isctx ? 4 : (u.pm >> 4);
        const int lrow0 = (isctx ? (u.pm - 64) : u.pm) * BM + wr * 64 + fr, col0 = u.pn * BM + wc * 32 + 4 * fq;
        const float* res = isctx ? res_ctx : res_lat; float* out = isctx ? out_ctx : out_lat;
        const float* gp = gate + (size_t)mr * NMOD + col0;
        f32x4 gv[2][2];
#pragma unroll
        for (int bj = 0; bj < 2; ++bj)
#pragma unroll
            for (int n = 0; n < 2; ++n) gv[bj][n] = *(const f32x4*)(gp + bj * HALF + n * 16) * coef;
#pragma unroll
        for (int ai = 0; ai < 2; ++ai)
#pragma unroll
            for (int m = 0; m < 4; ++m) { const size_t ro = (size_t)(lrow0 + ai * HALF + m * 16) * D + col0;
#pragma unroll
                for (int bj = 0; bj < 2; ++bj)
#pragma unroll
                    for (int n = 0; n < 2; ++n) { const f32x4 r = *(const f32x4*)(res + ro + bj * HALF + n * 16);
                        *(f32x4*)(out + ro + bj * HALF + n * 16) = r + gv[bj][n] * acc[ai][bj][m][n]; } }
    }
};
struct EpiIn {
    bf16_t* PA; bf16_t* PB; float* BA;
    __device__ __forceinline__ void operator()(const f32x4 (&acc)[2][2][4][2], const Unit& u, int wr, int wc, int fr, int fq) const {
        const int row0 = u.pm * BM + wr * 64 + fr;
        if (u.pn == 12) {
            if (wc == 0) {
#pragma unroll
                for (int ai = 0; ai < 2; ++ai)
#pragma unroll
                    for (int m = 0; m < 4; ++m) *(f32x4*)(BA + (size_t)(row0 + ai * HALF + m * 16) * 16 + 4 * fq) = acc[ai][0][m][0];
            }
            return;
        }
        bf16_t* base = (u.pn < 6) ? PA : PB; const int col0 = (u.pn % 6) * BM + wc * 32 + 4 * fq;
#pragma unroll
        for (int ai = 0; ai < 2; ++ai)
#pragma unroll
            for (int m = 0; m < 4; ++m) { bf16_t* rowp = base + (size_t)(row0 + ai * HALF + m * 16) * 1536 + col0;
#pragma unroll
                for (int bj = 0; bj < 2; ++bj)
#pragma unroll
                    for (int n = 0; n < 2; ++n) { const f32x4 v = acc[ai][bj][m][n]; u32x2 w; w.x = pk2(v[0], v[1]); w.y = pk2(v[2], v[3]); *(u32x2*)(rowp + bj * HALF + n * 16) = w; } }
    }
};
}

__device__ __forceinline__ void transpose_item(const float* W, int N, int k0, int src_col0, int nvalid, bf16_t* WT, int Kp, int dst_row0, float* scr, int lane) {
#pragma unroll 8
    for (int i = 0; i < 32; ++i) { const int kk = 2 * i + (lane >> 5), n = lane & 31; scr[kk * 33 + n] = (n < nvalid) ? W[(size_t)(k0 + kk) * N + src_col0 + n] : 0.f; }
    LDS_WAIT();
    const int c = lane & 7;
#pragma unroll
    for (int j = 0; j < 4; ++j) { const int n = (lane >> 3) + 8 * j; const float* s = scr + (8 * c) * 33 + n;
        u32x4 o; o.x = pk2(s[0 * 33], s[1 * 33]); o.y = pk2(s[2 * 33], s[3 * 33]); o.z = pk2(s[4 * 33], s[5 * 33]); o.w = pk2(s[6 * 33], s[7 * 33]);
        *(u32x4*)(WT + (size_t)(dst_row0 + n) * Kp + k0 + 8 * c) = o; }
    LDS_WAIT();
}

struct Ptrs {
    const float *x, *c, *ctx, *cctx, *w_ada, *b_ada, *norm_g, *w1, *w3, *w2, *w_in, *w_out, *gconv, *galog, *gdtb, *gnormw, *lconv, *lconvb, *lwg, *lbg, *llam, *fng;
    float* out; unsigned char* ws;
};

__device__ __forceinline__ void phase_prologue(const Ptrs& P, unsigned char* lds, int tid, int lane, int wave, int bid, int G) {
    float* mods = (float*)(P.ws + WS_MODS);
    {
        float* sc = (float*)lds;
        for (int i = tid; i < 5 * D; i += 512) { const int r = i >> 10, k = i & 1023; const float v = (r < 4) ? P.c[r * D + k] : P.cctx[k]; sc[i] = siluf_(v); }
        __syncthreads();
        float* red = (float*)(lds + 20480);
        for (int it = bid; it < NMOD / 64; it += G) {
            const int n0 = it * 64, cq = tid & 15, kl = tid >> 4;
            float acc[5][4];
#pragma unroll
            for (int r = 0; r < 5; ++r)
#pragma unroll
                for (int j = 0; j < 4; ++j) acc[r][j] = 0.f;
#pragma unroll 4
            for (int i = 0; i < 32; ++i) { const int k = kl + 32 * i; const f32x4 w = *(const f32x4*)(P.w_ada + (size_t)k * NMOD + n0 + 4 * cq);
#pragma unroll
                for (int r = 0; r < 5; ++r) { const float s = sc[r * D + k];
#pragma unroll
                    for (int j = 0; j < 4; ++j) acc[r][j] += s * w[j]; } }
#pragma unroll
            for (int r = 0; r < 5; ++r)
#pragma unroll
                for (int j = 0; j < 4; ++j) red[(kl * 16 + cq) * 20 + r * 4 + j] = acc[r][j];
            __syncthreads();
            if (tid < 320) { const int cq2 = tid / 20, rj = tid % 20; float s = 0.f;
                for (int k2 = 0; k2 < 32; ++k2) s += red[(k2 * 16 + cq2) * 20 + rj];
                const int r = rj >> 2, n = n0 + 4 * cq2 + (rj & 3); mods[r * NMOD + n] = s + P.b_ada[n]; }
            __syncthreads();
        }
        __syncthreads();
    }
    {
        float* scr = (float*)(lds + wave * 16384);
        const int gw = bid * 8 + wave, NGW = G * 8;
        bf16_t* W1A = (bf16_t*)(P.ws + WS_W1A); bf16_t* W2A = (bf16_t*)(P.ws + WS_W2A); bf16_t* W1B = (bf16_t*)(P.ws + WS_W1B); bf16_t* W2B = (bf16_t*)(P.ws + WS_W2B);
        bf16_t* WIN = (bf16_t*)(P.ws + WS_WIN); bf16_t* WOUT = (bf16_t*)(P.ws + WS_WOUT);
        constexpr int I_UP = 16 * 88, I_DN = 44 * 32, I_IN = 16 * 97, I_OUT = 16 * 32;
        constexpr int NITEMS = 6 * I_UP + I_IN + I_OUT;
        static_assert(I_UP == I_DN, "item counts");
        for (int it = gw; it < NITEMS; it += NGW) {
            int r = it;
            if (r < 6 * I_UP) {
                const int seg = r / I_UP; r -= seg * I_UP; const int layer = seg / 3, kind = seg % 3;
                if (kind < 2) { const int kb = r / 88, nbk = r % 88, sc0 = 32 * nbk; const float* W = (kind == 0 ? P.w1 : P.w3) + (size_t)layer * D * FF;
                    transpose_item(W, FF, 64 * kb, sc0, 32, layer ? W1B : W1A, D, 256 * (sc0 / 128) + (sc0 % 128) + (kind ? 128 : 0), scr, lane); }
                else { const int kb = r / 32, nbk = r % 32; transpose_item(P.w2 + (size_t)layer * FF * D, D, 64 * kb, 32 * nbk, 32, layer ? W2B : W2A, FF, 32 * nbk, scr, lane); }
                continue;
            }
            r -= 6 * I_UP;
            if (r < I_IN) { const int kb = r / 97, g = r % 97;
                if (g < 64) transpose_item(P.w_in, IN_COLS, 64 * kb, 32 * g, 32, WIN, D, 32 * g, scr, lane);
                else if (g < 96) transpose_item(P.w_in, IN_COLS, 64 * kb, 2064 + 32 * (g - 64), 32, WIN, D, 2048 + 32 * (g - 64), scr, lane);
                else transpose_item(P.w_in, IN_COLS, 64 * kb, 2048, 16, WIN, D, 3072, scr, lane);
                continue; }
            r -= I_IN;
            { const int kb = r / 32, nbk = r % 32; transpose_item(P.w_out, D, 64 * kb, 32 * nbk, 32, WOUT, D, 32 * nbk, scr, lane); }
        }
        u32x4* z = (u32x4*)(WIN + (size_t)3104 * D);
        for (int i = bid * 512 + tid; i < 224 * D * 2 / 16; i += G * 512) z[i] = (u32x4){0u, 0u, 0u, 0u};
    }
}

__device__ __forceinline__ void phase_norm_mod(const float* src_lat, const float* src_ctx, int nrows, const float* g, const float* mods, int shift_idx, int scale_idx, bf16_t* U, int gw, int NGW, int lane) {
    for (int m = gw; m < nrows; m += NGW) {
        const float* xrow = (m < M_LAT) ? src_lat + (size_t)m * D : src_ctx + (size_t)(m - M_LAT) * D;
        const int mr = (m < M_LAT) ? (m >> 12) : 4;
        const float* sh = mods + (size_t)mr * NMOD + shift_idx * D; const float* sc = mods + (size_t)mr * NMOD + scale_idx * D;
        f32x4 v[4]; float ss = 0.f;
#pragma unroll
        for (int j = 0; j < 4; ++j) { v[j] = *(const f32x4*)(xrow + 4 * lane + 256 * j); ss += (v[j][0] * v[j][0] + v[j][1] * v[j][1]) + (v[j][2] * v[j][2] + v[j][3] * v[j][3]); }
        const float rstd = rsqrtf(wave_sum(ss) * (1.f / D) + EPS);
#pragma unroll
        for (int j = 0; j < 4; ++j) { const int col = 4 * lane + 256 * j;
            const f32x4 gv = *(const f32x4*)(g + col), sv = *(const f32x4*)(sc + col), hv = *(const f32x4*)(sh + col);
            const f32x4 y = v[j] * rstd * gv * (sv + 1.f) + hv;
            u32x2 w; w.x = pk2(y[0], y[1]); w.y = pk2(y[2], y[3]); *(u32x2*)(U + (size_t)m * D + col) = w; }
    }
}

constexpr int KP = 132;
__device__ __attribute__((noinline)) void gdn_solve(const LAS float* src, const LAS float* scl, const LAS float* A, bf16_t* dst, int base, int stride) {
    float x[64];
#pragma unroll
    for (int i = 0; i < 64; ++i) x[i] = 0.f;
#pragma unroll
    for (int i = 0; i < 64; ++i) {
        float s0 = src[base + i * stride] * scl[i], s1 = 0.f, s2 = 0.f, s3 = 0.f;
#pragma unroll
        for (int j4 = 0; j4 < (i + 3) / 4; ++j4) { const f32x4 av = *(const LAS f32x4*)(A + i * 64 + 4 * j4);
            s0 -= av[0] * x[4 * j4]; s1 -= av[1] * x[4 * j4 + 1]; s2 -= av[2] * x[4 * j4 + 2]; s3 -= av[3] * x[4 * j4 + 3]; }
        x[i] = (s0 + s1) + (s2 + s3);
        dst[i * 128] = (bf16_t)f2bf(x[i]);
    }
}
__device__ __forceinline__ void gdn_prep_item(const Ptrs& P, unsigned char* lds, int item, int tid, int lane, int wave) {
    const int b = item / (4 * NCH), h = (item / NCH) & 3, cn = item % NCH;
    const bool isctx = cn < 4; const int cl = isctx ? cn : cn - 4, L = isctx ? CTXL : SEQ;
    const int rowbase = isctx ? M_LAT + b * CTXL : b * SEQ;
    const bf16_t* PA = (const bf16_t*)(P.ws + WS_PA); const float* BA = (const float*)(P.ws + WS_BA);
    int lo_ = 0; asm volatile("" : "+v"(lo_));
    float* KF = (float*)(lds + lo_); float* QF = (float*)(lds + lo_ + 33792); float* VF = (float*)(lds + lo_ + 67584);
    float* KKN = (float*)(lds + lo_ + 101376); float* QKN = (float*)(lds + lo_ + 118016);
    float* GS = (float*)(lds + lo_ + 134656);
    float* RB = GS + 128;
    float* RBE = GS + 256;
    float* AD = QF;
    {
        const int c = tid & 127, tg = tid >> 7;
#pragma unroll
        for (int mat = 0; mat < 3; ++mat) {
            const int ch = mat * 512 + h * 128 + c;
            const float w0 = P.gconv[ch], w1 = P.gconv[1536 + ch], w2 = P.gconv[2 * 1536 + ch], w3 = P.gconv[3 * 1536 + ch];
            const int t0 = cl * 64 + tg * 16;
            const bf16_t* src = PA + (size_t)rowbase * 1536 + ch;
            float xm2 = (t0 - 2 >= 0) ? bf2f(src[(size_t)(t0 - 2) * 1536]) : 0.f;
            float xm1 = (t0 - 1 >= 0) ? bf2f(src[(size_t)(t0 - 1) * 1536]) : 0.f;
            float x0 = bf2f(src[(size_t)t0 * 1536]);
            float* dst = (mat == 0 ? QF : (mat == 1 ? KF : VF)) + (tg * 16) * KP + c;
#pragma unroll 4
            for (int i = 0; i < 16; ++i) { const int t = t0 + i; const float xp1 = (t + 1 < L) ? bf2f(src[(size_t)(t + 1) * 1536]) : 0.f;
                const float y = w0 * xm2 + w1 * xm1 + w2 * x0 + w3 * xp1; dst[i * KP] = siluf_(y); xm2 = xm1; xm1 = x0; x0 = xp1; }
        }
    }
    if (tid < 128) {
        const int d = tid >> 6, i = lane, r = d ? 63 - i : i;
        const float* ba = BA + (size_t)(rowbase + cl * 64 + r) * 16;
        const float beta = sigmoidf_(ba[d * 4 + h]);
        float gg = -__expf(P.galog[d * 4 + h]) * softplusf_(ba[(2 + d) * 4 + h] + P.gdtb[d * 4 + h]);
#pragma unroll
        for (int o = 1; o < 64; o <<= 1) { const float t = __shfl_up(gg, o); if (lane >= o) gg += t; }
        GS[d * 64 + i] = gg; RB[d * 64 + i] = beta; RBE[d * 64 + i] = beta * __expf(gg);
        ((float*)(P.ws + WS_GC))[((size_t)((d * 4 + b) * 4 + h) * NCH + cn) * 64 + i] = gg;
    }
    __syncthreads();
    {
        bf16_t* QG = (bf16_t*)(P.ws + WS_QG) + ((size_t)((b * 4 + h) * NCH + cn) * 64) * 128;
        bf16_t* KG = (bf16_t*)(P.ws + WS_KG) + ((size_t)((b * 4 + h) * NCH + cn) * 64) * 128;
#pragma unroll
        for (int tt = 0; tt < 8; ++tt) { const int tok = wave * 8 + tt;
            f32x2 q = *(f32x2*)(QF + tok * KP + 2 * lane), k = *(f32x2*)(KF + tok * KP + 2 * lane);
            const float sq = wave_sum(q[0] * q[0] + q[1] * q[1]), sk = wave_sum(k[0] * k[0] + k[1] * k[1]);
            q = q * (rsqrtf(sq + EPS) * 0.08838834764831845f); k = k * rsqrtf(sk + EPS);
            *(f32x2*)(QF + tok * KP + 2 * lane) = q; *(f32x2*)(KF + tok * KP + 2 * lane) = k;
            *(unsigned*)(QG + tok * 128 + 2 * lane) = pk2(q[0], q[1]); *(unsigned*)(KG + tok * 128 + 2 * lane) = pk2(k[0], k[1]); }
    }
    __syncthreads();
    {
        const int tp = tid & 255, ti = tp >> 4, tj = tp & 15; const float* X = (tid < 256) ? KF : QF; float* OUT = (tid < 256) ? KKN : QKN;
        float acc[4][4];
#pragma unroll
        for (int a = 0; a < 4; ++a)
#pragma unroll
            for (int c = 0; c < 4; ++c) acc[a][c] = 0.f;
#pragma unroll 2
        for (int kq = 0; kq < 32; ++kq) {
            f32x4 av[4], bv[4];
#pragma unroll
            for (int a = 0; a < 4; ++a) { av[a] = *(const f32x4*)(X + (ti + 16 * a) * KP + 4 * kq); bv[a] = *(const f32x4*)(KF + (tj + 16 * a) * KP + 4 * kq); }
#pragma unroll
            for (int a = 0; a < 4; ++a)
#pragma unroll
                for (int c = 0; c < 4; ++c) acc[a][c] += (av[a][0] * bv[c][0] + av[a][1] * bv[c][1]) + (av[a][2] * bv[c][2] + av[a][3] * bv[c][3]);
        }
#pragma unroll
        for (int a = 0; a < 4; ++a)
#pragma unroll
            for (int c = 0; c < 4; ++c) OUT[(ti + 16 * a) * 65 + tj + 16 * c] = acc[a][c];
    }
    __syncthreads();
    {
        const int d = tid >> 8, tp = tid & 255;
        bf16_t* ATT = (bf16_t*)(P.ws + WS_ATT) + ((size_t)((d * 4 + b) * 4 + h) * NCH + cn) * 4096;
#pragma unroll 4
        for (int e = 0; e < 16; ++e) { const int idx = tp + 256 * e, i = idx >> 6, j = idx & 63, ri = d ? 63 - i : i, rj = d ? 63 - j : j;
            const float dec = (i >= j) ? __expf(GS[d * 64 + i] - GS[d * 64 + j]) : 0.f;
            AD[d * 4096 + idx] = (i > j) ? RB[d * 64 + i] * KKN[ri * 65 + rj] * dec : 0.f;
            ATT[idx] = (bf16_t)f2bf(QKN[ri * 65 + rj] * dec); }
    }
    __syncthreads();
    {
        const int d = tid >> 8, c = tid & 255;
        const float* src = (c < 128) ? VF + c : KF + (c - 128); const float* scl = ((c < 128) ? RB : RBE) + d * 64;
        bf16_t* dst = (bf16_t*)(P.ws + (c < 128 ? WS_UB : WS_WB)) + ((size_t)((d * 4 + b) * 4 + h) * NCH + cn) * 64 * 128 + (c & 127);
        int sb_ = d ? 63 * KP : 0, ss_ = d ? -KP : KP; asm volatile("" : "+v"(sb_), "+v"(ss_));
        gdn_solve((const LAS float*)src, (const LAS float*)scl, (const LAS float*)(AD + d * 4096), dst, sb_, ss_);
    }
    __syncthreads();
}

__device__ __forceinline__ int chunk_of(int d, int s) { return d ? (s < 4 ? 3 - s : 67 - (s - 4)) : s; }
constexpr int TP = 272, AP = 144;
__device__ __forceinline__ bf16x8 ldfrag(const unsigned char* base, int row, int pitch, int kbyte) { return *(const bf16x8*)(base + row * pitch + kbyte); }
__device__ __forceinline__ void gdn_scan_item(const Ptrs& P, unsigned char* lds, int item, int tid, int lane, int wave) {
    const int chain = item & 31, slice = item >> 5, d = chain >> 4, b = (chain >> 2) & 3, h = chain & 3, e0 = slice * 32;
    unsigned char* Wl = lds; unsigned char* Ql = lds + 17408; unsigned char* Kl = lds + 34816; unsigned char* ATl = lds + 52224;
    unsigned char* St = lds + 61440; unsigned char* Vt = lds + 70144; unsigned char* Vdt = lds + 74752; float* gcs = (float*)(lds + 79360);
    const bf16_t* WBp = (const bf16_t*)(P.ws + WS_WB) + (size_t)((d * 4 + b) * 4 + h) * NCH * 8192;
    const bf16_t* UBp = (const bf16_t*)(P.ws + WS_UB) + (size_t)((d * 4 + b) * 4 + h) * NCH * 8192;
    const bf16_t* ATp = (const bf16_t*)(P.ws + WS_ATT) + (size_t)((d * 4 + b) * 4 + h) * NCH * 4096;
    const float* GCp = (const float*)(P.ws + WS_GC) + (size_t)((d * 4 + b) * 4 + h) * NCH * 64;
    const bf16_t* QGp = (const bf16_t*)(P.ws + WS_QG) + (size_t)(b * 4 + h) * NCH * 8192;
    const bf16_t* KGp = (const bf16_t*)(P.ws + WS_KG) + (size_t)(b * 4 + h) * NCH * 8192;
    bf16_t* Op = (bf16_t*)(P.ws + (d ? WS_OB : WS_OF));
    const int fr = lane & 15, fq = lane >> 4, mt = wave & 3, nt = wave >> 2;
    for (int i = tid; i < 8704 / 4; i += 512) ((unsigned*)St)[i] = 0u;
    f32x4 Sacc[2] = {(f32x4){0.f, 0.f, 0.f, 0.f}, (f32x4){0.f, 0.f, 0.f, 0.f}};
    u32x4 rw[2], rq[2], rk[2], ra; float rg = 0.f; bf16_t ru[4];
#define SCAN_PREFETCH(s_) do { const int cn_ = chunk_of(d, s_); \
        const u32x4* w4 = (const u32x4*)(WBp + (size_t)cn_ * 8192); const u32x4* q4 = (const u32x4*)(QGp + (size_t)cn_ * 8192); const u32x4* k4 = (const u32x4*)(KGp + (size_t)cn_ * 8192); \
        rw[0] = w4[tid]; rw[1] = w4[tid + 512]; rq[0] = q4[tid]; rq[1] = q4[tid + 512]; rk[0] = k4[tid]; rk[1] = k4[tid + 512]; \
        ra = ((const u32x4*)(ATp + (size_t)cn_ * 4096))[tid]; if (tid < 64) rg = GCp[cn_ * 64 + tid]; \
        { const bf16_t* up_ = UBp + (size_t)cn_ * 8192 + (mt * 16 + fq * 4) * 128 + e0 + nt * 16 + fr; ru[0] = up_[0]; ru[1] = up_[128]; ru[2] = up_[256]; ru[3] = up_[384]; } } while (0)
    SCAN_PREFETCH(0);
    for (int s = 0; s < NCH; ++s) {
        const int cn = chunk_of(d, s); const bool lat = cn >= 4;
#pragma unroll
        for (int i = 0; i < 2; ++i) { const int idx = tid + 512 * i, row = idx >> 4, cc = idx & 15;
            *(u32x4*)(Wl + row * TP + cc * 16) = rw[i]; *(u32x4*)(Ql + row * TP + cc * 16) = rq[i]; *(u32x4*)(Kl + row * TP + cc * 16) = rk[i]; }
        *(u32x4*)(ATl + (tid >> 3) * AP + (tid & 7) * 16) = ra;
        if (tid < 64) gcs[tid] = rg;
        float uv[4];
#pragma unroll
        for (int jj = 0; jj < 4; ++jj) uv[jj] = bf2f(ru[jj]);
        BAR_LDS();
        if (s + 1 < NCH) SCAN_PREFETCH(s + 1);
        const float glast = gcs[63];
        f32x4 acc_a = (f32x4){0.f, 0.f, 0.f, 0.f}, acc_b = (f32x4){0.f, 0.f, 0.f, 0.f};
        { const int qrow = d ? 63 - (mt * 16 + fr) : (mt * 16 + fr);
#pragma unroll
          for (int ks = 0; ks < 4; ++ks) { const bf16x8 bs = ldfrag(St, nt * 16 + fr, TP, ks * 64 + fq * 16);
              const bf16x8 aw = ldfrag(Wl, mt * 16 + fr, TP, ks * 64 + fq * 16);
              acc_a = __builtin_amdgcn_mfma_f32_16x16x32_bf16(aw, bs, acc_a, 0, 0, 0);
              if (lat) { const bf16x8 aq = ldfrag(Ql, qrow, TP, ks * 64 + fq * 16); acc_b = __builtin_amdgcn_mfma_f32_16x16x32_bf16(aq, bs, acc_b, 0, 0, 0); } } }
        { float vn[4], vd[4];
#pragma unroll
          for (int jj = 0; jj < 4; ++jj) { const float gi = gcs[mt * 16 + fq * 4 + jj]; vn[jj] = uv[jj] - acc_a[jj]; vd[jj] = vn[jj] * __expf(glast - gi); acc_b[jj] *= __expf(gi); }
          u32x2 w; w.x = pk2(vn[0], vn[1]); w.y = pk2(vn[2], vn[3]); *(u32x2*)(Vt + (nt * 16 + fr) * AP + (mt * 16 + fq * 4) * 2) = w;
          w.x = pk2(vd[0], vd[1]); w.y = pk2(vd[2], vd[3]); *(u32x2*)(Vdt + (nt * 16 + fr) * AP + (mt * 16 + fq * 4) * 2) = w; }
        BAR_LDS();
        if (lat) {
#pragma unroll
            for (int ks = 0; ks < 2; ++ks) { const bf16x8 aa = ldfrag(ATl, mt * 16 + fr, AP, ks * 64 + fq * 16); const bf16x8 bv = ldfrag(Vt, nt * 16 + fr, AP, ks * 64 + fq * 16);
                acc_b = __builtin_amdgcn_mfma_f32_16x16x32_bf16(aa, bv, acc_b, 0, 0, 0); }
            bf16_t* op = Op + (size_t)(b * SEQ + (cn - 4) * 64) * 512 + h * 128 + e0 + nt * 16 + fr;
#pragma unroll
            for (int jj = 0; jj < 4; ++jj) { const int i = mt * 16 + fq * 4 + jj, tok = d ? 63 - i : i; op[(size_t)tok * 512] = (bf16_t)f2bf(acc_b[jj]); }
        }
        { const float eg = __expf(glast);
          bf16x8 ak[2];
#pragma unroll
          for (int ks = 0; ks < 2; ++ks)
#pragma unroll
              for (int jj = 0; jj < 8; ++jj) { const int i = ks * 32 + fq * 8 + jj, row = d ? 63 - i : i; ak[ks][jj] = (short)*(const bf16_t*)(Kl + row * TP + (16 * wave + fr) * 2); }
#pragma unroll
          for (int n2 = 0; n2 < 2; ++n2) { f32x4 a = Sacc[n2] * eg;
#pragma unroll
              for (int ks = 0; ks < 2; ++ks) { const bf16x8 bv = ldfrag(Vdt, n2 * 16 + fr, AP, ks * 64 + fq * 16); a = __builtin_amdgcn_mfma_f32_16x16x32_bf16(ak[ks], bv, a, 0, 0, 0); }
              Sacc[n2] = a;
              u32x2 w; w.x = pk2(a[0], a[1]); w.y = pk2(a[2], a[3]); *(u32x2*)(St + (n2 * 16 + fr) * TP + (16 * wave + fq * 4) * 2) = w; } }
        BAR_LDS();
    }
#undef SCAN_PREFETCH
}

__device__ __forceinline__ void gdn_prep_phase(const Ptrs& P, unsigned char* lds, int tid, int lane, int wave, int bid, int G) {
    const bf16_t* PA = (const bf16_t*)(P.ws + WS_PA); const float* BA = (const float*)(P.ws + WS_BA);
    unsigned char* RAW = lds;
    float* QF = (float*)lds;
    unsigned char* Kb = lds + 33792;
    unsigned char* ATs = lds;
    float* AD = (float*)(lds + 18432);
    float* KF = (float*)(lds + 51456); float* VF = (float*)(lds + 85248);
    unsigned char* Qb = lds + 119040;
    float* GS = (float*)(lds + 136448); float* RB = GS + 128; float* RBE = GS + 256;
    const int fr = lane & 15, fq = lane >> 4;
    u32x4 pr[7]; float pba0 = 0.f, pba1 = 0.f;
#define PREP_DECODE(it_, b_, h_, cn_) const int b_ = (it_) / (4 * NCH), h_ = ((it_) / NCH) & 3, cn_ = (it_) % NCH;
#define PREP_PREFETCH(it_) do { PREP_DECODE(it_, pb_, ph_, pcn_) const bool pctx_ = pcn_ < 4; const int pcl_ = pctx_ ? pcn_ : pcn_ - 4, pL_ = pctx_ ? CTXL : SEQ, prb_ = pctx_ ? M_LAT + pb_ * CTXL : pb_ * SEQ; \
        _Pragma("unroll") for (int e_ = 0; e_ < 7; ++e_) { const int q_ = tid + 512 * e_, mat_ = q_ / 1072, rem_ = q_ - mat_ * 1072, row_ = rem_ >> 4, t_ = pcl_ * 64 - 2 + row_; \
            pr[e_] = (q_ < 3216 && t_ >= 0 && t_ < pL_) ? *(const u32x4*)(PA + (size_t)(prb_ + t_) * 1536 + mat_ * 512 + ph_ * 128 + (rem_ & 15) * 8) : (u32x4){0u, 0u, 0u, 0u}; } \
        if (tid < 128) { const int d_ = tid >> 6, r_ = d_ ? 63 - lane : lane; const float* ba_ = BA + (size_t)(prb_ + pcl_ * 64 + r_) * 16; pba0 = ba_[d_ * 4 + ph_]; pba1 = ba_[(2 + d_) * 4 + ph_]; } } while (0)
    if (bid < NB * 4 * NCH) PREP_PREFETCH(bid);
    for (int it = bid; it < NB * 4 * NCH; it += G) {
        PREP_DECODE(it, b, h, cn)
        int lo_ = 0; asm volatile("" : "+v"(lo_));
        const int c = tid & 127, tg = tid >> 7;
        float cw[3][4];
#pragma unroll
        for (int mat = 0; mat < 3; ++mat)
#pragma unroll
            for (int k = 0; k < 4; ++k) cw[mat][k] = P.gconv[k * 1536 + mat * 512 + h * 128 + c];
#pragma unroll
        for (int e = 0; e < 7; ++e) { const int q = tid + 512 * e; if (q < 3216) { const int mat = q / 1072, rem = q - mat * 1072; *(u32x4*)(RAW + lo_ + (mat * 67 + (rem >> 4)) * 256 + (rem & 15) * 16) = pr[e]; } }
        const float ba0 = pba0, ba1 = pba1;
        BAR_LDS();
        if (it + G < NB * 4 * NCH) PREP_PREFETCH(it + G);
        if (tid < 128) {
            const int d = tid >> 6, i = lane;
            const float beta = sigmoidf_(ba0);
            float gg = -__expf(P.galog[d * 4 + h]) * softplusf_(ba1 + P.gdtb[d * 4 + h]);
#pragma unroll
            for (int o = 1; o < 64; o <<= 1) { const float t = __shfl_up(gg, o); if (lane >= o) gg += t; }
            GS[lo_ + d * 64 + i] = gg; RB[lo_ + d * 64 + i] = beta; RBE[lo_ + d * 64 + i] = beta * __expf(gg);
            ((float*)(P.ws + WS_GC))[((size_t)((d * 4 + b) * 4 + h) * NCH + cn) * 64 + i] = gg;
        }
        float yq[16];
        {
#pragma unroll
            for (int mat = 0; mat < 3; ++mat) {
                const bf16_t* rp = (const bf16_t*)(RAW + lo_ + (mat * 67 + tg * 16) * 256) + c;
                float xm2 = bf2f(rp[0]), xm1 = bf2f(rp[128]), x0 = bf2f(rp[256]);
#pragma unroll
                for (int i = 0; i < 16; ++i) { const float xp1 = bf2f(rp[(i + 3) * 128]);
                    const float y = siluf_(cw[mat][0] * xm2 + cw[mat][1] * xm1 + cw[mat][2] * x0 + cw[mat][3] * xp1);
                    if (mat == 0) yq[i] = y; else if (mat == 1) KF[lo_ + (tg * 16 + i) * KP + c] = y; else VF[lo_ + (tg * 16 + i) * KP + c] = y;
                    xm2 = xm1; xm1 = x0; x0 = xp1; }
            }
        }
        BAR_LDS();
#pragma unroll
        for (int i = 0; i < 16; ++i) QF[lo_ + (tg * 16 + i) * KP + c] = yq[i];
        BAR_LDS();
        {
            bf16_t* QG = (bf16_t*)(P.ws + WS_QG) + ((size_t)((b * 4 + h) * NCH + cn) * 64) * 128;
            bf16_t* KG = (bf16_t*)(P.ws + WS_KG) + ((size_t)((b * 4 + h) * NCH + cn) * 64) * 128;
#pragma unroll
            for (int tt = 0; tt < 8; ++tt) { const int tok = wave * 8 + tt;
                f32x2 q = *(f32x2*)(QF + lo_ + tok * KP + 2 * lane), k = *(f32x2*)(KF + lo_ + tok * KP + 2 * lane);
                const float sq = wave_sum(q[0] * q[0] + q[1] * q[1]), sk = wave_sum(k[0] * k[0] + k[1] * k[1]);
                q = q * (rsqrtf(sq + EPS) * 0.08838834764831845f); k = k * rsqrtf(sk + EPS);
                *(f32x2*)(KF + lo_ + tok * KP + 2 * lane) = k;
                const unsigned qp = pk2(q[0], q[1]), kp = pk2(k[0], k[1]);
                *(unsigned*)(Qb + lo_ + tok * TP + 4 * lane) = qp; *(unsigned*)(Kb + lo_ + tok * TP + 4 * lane) = kp;
                *(unsigned*)(QG + tok * 128 + 2 * lane) = qp; *(unsigned*)(KG + tok * 128 + 2 * lane) = kp; }
        }
        BAR_LDS();
        const int mi = wave & 3, njp = wave >> 2;
        f32x4 ckk[2], cqk[2];
        ckk[0] = ckk[1] = cqk[0] = cqk[1] = (f32x4){0.f, 0.f, 0.f, 0.f};
#pragma unroll
        for (int ks = 0; ks < 4; ++ks) { const bf16x8 aK = ldfrag(Kb + lo_, mi * 16 + fr, TP, ks * 64 + fq * 16), aQ = ldfrag(Qb + lo_, mi * 16 + fr, TP, ks * 64 + fq * 16);
#pragma unroll
            for (int n2 = 0; n2 < 2; ++n2) { const bf16x8 bK = ldfrag(Kb + lo_, (njp * 2 + n2) * 16 + fr, TP, ks * 64 + fq * 16);
                ckk[n2] = __builtin_amdgcn_mfma_f32_16x16x32_bf16(aK, bK, ckk[n2], 0, 0, 0); cqk[n2] = __builtin_amdgcn_mfma_f32_16x16x32_bf16(aQ, bK, cqk[n2], 0, 0, 0); } }
        BAR_LDS();
#pragma unroll
        for (int n2 = 0; n2 < 2; ++n2)
#pragma unroll
            for (int jj = 0; jj < 4; ++jj) { const int r = mi * 16 + fq * 4 + jj, sc = (njp * 2 + n2) * 16 + fr;
                const float e0 = __expf(GS[lo_ + r] - GS[lo_ + sc]), e1 = __expf(GS[lo_ + 64 + 63 - r] - GS[lo_ + 64 + 63 - sc]);
                const float kkv = ckk[n2][jj], qkv = cqk[n2][jj];
                AD[lo_ + r * 64 + sc] = (r > sc) ? RB[lo_ + r] * kkv * e0 : 0.f;
                AD[lo_ + 4096 + (63 - r) * 64 + (63 - sc)] = (r < sc) ? RB[lo_ + 64 + 63 - r] * kkv * e1 : 0.f;
                *(bf16_t*)(ATs + lo_ + r * 144 + sc * 2) = (bf16_t)f2bf((r >= sc) ? qkv * e0 : 0.f);
                *(bf16_t*)(ATs + lo_ + 9216 + (63 - r) * 144 + (63 - sc) * 2) = (bf16_t)f2bf((r <= sc) ? qkv * e1 : 0.f); }
        BAR_LDS();
#pragma unroll
        for (int e = 0; e < 2; ++e) { const int idx = tid + 512 * e, d = idx >> 9, row = (idx >> 3) & 63, cc = idx & 7;
            bf16_t* ATT = (bf16_t*)(P.ws + WS_ATT) + ((size_t)((d * 4 + b) * 4 + h) * NCH + cn) * 4096;
            *(u32x4*)(ATT + row * 64 + cc * 8) = *(const u32x4*)(ATs + lo_ + d * 9216 + row * 144 + cc * 16); }
        {
            const int d = tid >> 8, cc = tid & 255;
            const float* src = (cc < 128) ? VF + lo_ + cc : KF + lo_ + (cc - 128); const float* scl = ((cc < 128) ? RB : RBE) + lo_ + d * 64;
            bf16_t* dst = (bf16_t*)(P.ws + (cc < 128 ? WS_UB : WS_WB)) + ((size_t)((d * 4 + b) * 4 + h) * NCH + cn) * 64 * 128 + (cc & 127);
            int sb_ = d ? 63 * KP : 0, ss_ = d ? -KP : KP; asm volatile("" : "+v"(sb_), "+v"(ss_));
            gdn_solve((const LAS float*)src, (const LAS float*)scl, (const LAS float*)(AD + lo_ + d * 4096), dst, sb_, ss_);
        }
        BAR_LDS();
    }
#undef PREP_DECODE
#undef PREP_PREFETCH
}

template <int MODE>
__device__ __forceinline__ void lru_item(const Ptrs& P, unsigned char* lds, int b, int cn, int nb, int tid, int lane, int wave) {
    const bool isctx = cn < 4; const int cl = isctx ? cn : cn - 4, L = isctx ? CTXL : SEQ, s0 = cl * 64;
    const bf16_t* PB = (const bf16_t*)(P.ws + WS_PB);
    float* xin = (float*)lds;
    float* xT = (float*)(lds + 17408);
    float* wg = (float*)(lds + 34816);
    f32x2* seg = (f32x2*)(lds + 100352);
#define rowof(s_) (isctx ? (size_t)(M_LAT + b * CTXL + (s_)) : (size_t)(b * SEQ + ((s_) & 63) * 64 + ((s_) >> 6)))
    for (int idx = tid; idx < 67 * 64; idx += 512) { const int si = idx >> 6, c = idx & 63, s = s0 - 2 + si;
        xin[idx] = (s >= 0 && s < L) ? bf2f(PB[rowof(s) * 1536 + 512 + nb * 64 + c]) : 0.f; }
    for (int idx = tid; idx < 4 * 4096; idx += 512) { const int dg = idx >> 12; wg[idx] = P.lwg[((size_t)dg * 8 + nb) * 4096 + (idx & 4095)]; }
    __syncthreads();
    { const int c = tid & 63, ig = tid >> 6, ch = nb * 64 + c;
      const float w0 = P.lconv[ch], w1 = P.lconv[512 + ch], w2 = P.lconv[1024 + ch], w3 = P.lconv[1536 + ch], bias = P.lconvb[ch];
#pragma unroll
      for (int ii = 0; ii < 8; ++ii) { const int i = ig * 8 + ii; xT[c * 68 + i] = bias + w0 * xin[i * 64 + c] + w1 * xin[(i + 1) * 64 + c] + w2 * xin[(i + 2) * 64 + c] + w3 * xin[(i + 3) * 64 + c]; } }
    __syncthreads();
    const int co = tid & 63, ig = tid >> 6, ch = nb * 64 + co;
    float acc[4][8];
#pragma unroll
    for (int q = 0; q < 4; ++q)
#pragma unroll
        for (int ii = 0; ii < 8; ++ii) acc[q][ii] = 0.f;
#pragma unroll 4
    for (int ci = 0; ci < 64; ++ci) { const f32x4 xa = *(const f32x4*)(xT + ci * 68 + ig * 8), xb = *(const f32x4*)(xT + ci * 68 + ig * 8 + 4);
        float wv[4];
#pragma unroll
        for (int q = 0; q < 4; ++q) wv[q] = wg[q * 4096 + ci * 64 + co];
#pragma unroll
        for (int q = 0; q < 4; ++q) {
#pragma unroll
            for (int ii = 0; ii < 4; ++ii) { acc[q][ii] += wv[q] * xa[ii]; acc[q][ii + 4] += wv[q] * xb[ii]; } } }
    float av[2][8], bv[2][8];
#pragma unroll
    for (int d = 0; d < 2; ++d) { const float bgr = P.lbg[(d * 2 + 0) * 512 + ch], bgi = P.lbg[(d * 2 + 1) * 512 + ch], sp = softplusf_(-P.llam[d * 512 + ch]);
#pragma unroll
        for (int ii = 0; ii < 8; ++ii) { const int i = ig * 8 + ii; const float xv = xT[co * 68 + i];
            const float r = sigmoidf_(acc[d * 2][ii] + bgr), ing = sigmoidf_(acc[d * 2 + 1][ii] + bgi), la = -8.f * sp * r;
            float mult = sqrtf(-expm1f(2.f * la));
            if (isctx && ((d == 0 && cn == 0 && i == 0) || (d == 1 && cn == 3 && i == 63))) mult = 1.f;
            av[d][ii] = __expf(la); bv[d][ii] = mult * ing * xv; } }
    { float A0 = 1.f, B0 = 0.f, A1 = 1.f, B1 = 0.f;
#pragma unroll
      for (int ii = 0; ii < 8; ++ii) { B0 = av[0][ii] * B0 + bv[0][ii]; A0 *= av[0][ii]; B1 = av[1][7 - ii] * B1 + bv[1][7 - ii]; A1 *= av[1][7 - ii]; }
      seg[(ig * 2 + 0) * 64 + co] = (f32x2){A0, B0}; seg[(ig * 2 + 1) * 64 + co] = (f32x2){A1, B1}; }
    __syncthreads();
    if constexpr (MODE == 0) {
        if (tid < 128) { const int d = tid >> 6; float At = 1.f, Bt = 0.f;
#pragma unroll
            for (int k = 0; k < 8; ++k) { const int sg = d ? 7 - k : k; const f32x2 v = seg[(sg * 2 + d) * 64 + co]; Bt = v[0] * Bt + v[1]; At *= v[0]; }
            ((f32x2*)(P.ws + WS_LSUM))[((size_t)(b * 2 + d) * NCH + cn) * 512 + ch] = (f32x2){At, Bt}; }
    } else {
        const float* CAR = (const float*)(P.ws + WS_LCAR);
        float hf = CAR[((size_t)(b * 2 + 0) * NCH + cn) * 512 + ch], hb = CAR[((size_t)(b * 2 + 1) * NCH + cn) * 512 + ch];
        for (int k = 0; k < ig; ++k) { const f32x2 v = seg[(k * 2 + 0) * 64 + co]; hf = v[0] * hf + v[1]; }
        for (int k = 7; k > ig; --k) { const f32x2 v = seg[(k * 2 + 1) * 64 + co]; hb = v[0] * hb + v[1]; }
        float o[8];
#pragma unroll
        for (int ii = 0; ii < 8; ++ii) { hf = av[0][ii] * hf + bv[0][ii]; o[ii] = hf; }
#pragma unroll
        for (int ii = 7; ii >= 0; --ii) { hb = av[1][ii] * hb + bv[1][ii]; o[ii] += hb; }
        bf16_t* MIX = (bf16_t*)(P.ws + WS_MIX);
#pragma unroll
        for (int ii = 0; ii < 8; ++ii) { const size_t row = rowof(s0 + ig * 8 + ii); const float gt = bf2f(PB[row * 1536 + 1024 + ch]);
            MIX[row * D + 512 + ch] = (bf16_t)f2bf(o[ii] * geluf_(gt)); }
    }
    __syncthreads();
#undef rowof
}
template <int MODE>
__device__ __forceinline__ void lru_phase(const Ptrs& P, unsigned char* lds, int tid, int lane, int wave, int nb, int slot, int nslots) {
    const bf16_t* PB = (const bf16_t*)(P.ws + WS_PB);
    unsigned char* Wt = lds;
    float* xin = (float*)(lds + 36864);
    unsigned char* xb = lds + 54016;
    float* xc = (float*)(lds + 63232);
    f32x2* seg = (f32x2*)(lds + 80640);
    unsigned char* gtl = lds + 97024;
    unsigned char* otl = lds + 106240;
    for (int idx = tid; idx < 4 * 4096; idx += 512) { const int dg = idx >> 12, ci = (idx >> 6) & 63, co = idx & 63;
        *(bf16_t*)(Wt + dg * 9216 + co * 144 + ci * 2) = (bf16_t)f2bf(P.lwg[((size_t)dg * 8 + nb) * 4096 + (idx & 4095)]); }
    const int fr = lane & 15, fq = lane >> 4, nt = wave & 3, mh = wave >> 2;
    const int cch = nb * 64 + (tid & 63);
    const float cw0 = P.lconv[cch], cw1 = P.lconv[512 + cch], cw2 = P.lconv[1024 + cch], cw3 = P.lconv[1536 + cch], cbias = P.lconvb[cch];
    const int co = nt * 16 + fr, ch = nb * 64 + co;
    float bgr[2], bgi[2], sp[2];
#pragma unroll
    for (int d = 0; d < 2; ++d) { bgr[d] = P.lbg[(d * 2 + 0) * 512 + ch]; bgi[d] = P.lbg[(d * 2 + 1) * 512 + ch]; sp[d] = -8.f * softplusf_(-P.llam[d * 512 + ch]); }
    const int nitems = (MODE == 0) ? NB * NCH : NB * 64;
    u32x4 px[2], pg; px[0] = px[1] = pg = (u32x4){0u, 0u, 0u, 0u};
#define LRU_DECODE(j_, b_, cn_) const int b_ = (MODE == 0) ? (j_) / NCH : (j_) >> 6; const int cn_ = (MODE == 0) ? (j_) % NCH : 4 + ((j_) & 63);
#define LRU_ROW(b_, cn_, s_) ((cn_) < 4 ? (size_t)(M_LAT + (b_) * CTXL + (s_)) : (size_t)((b_) * SEQ + ((s_) & 63) * 64 + ((s_) >> 6)))
#define LRU_PREFETCH(j_) do { LRU_DECODE(j_, pb_, pcn_) const int pL_ = pcn_ < 4 ? CTXL : SEQ, ps0_ = (pcn_ < 4 ? pcn_ : pcn_ - 4) * 64; \
        _Pragma("unroll") for (int e_ = 0; e_ < 2; ++e_) { const int q_ = tid + 512 * e_, si_ = q_ >> 3, s_ = ps0_ - 2 + si_; \
            px[e_] = (q_ < 536 && s_ >= 0 && s_ < pL_) ? *(const u32x4*)(PB + LRU_ROW(pb_, pcn_, s_) * 1536 + 512 + nb * 64 + (q_ & 7) * 8) : (u32x4){0u, 0u, 0u, 0u}; } \
        if (MODE == 1) { const int i_ = tid >> 3; pg = *(const u32x4*)(PB + LRU_ROW(pb_, pcn_, ps0_ + i_) * 1536 + 1024 + nb * 64 + (tid & 7) * 8); } } while (0)
    if (slot < nitems) LRU_PREFETCH(slot);
    BAR_LDS();
    for (int j = slot; j < nitems; j += nslots) {
        LRU_DECODE(j, b, cn)
        const bool isctx = cn < 4; const int s0 = (isctx ? cn : cn - 4) * 64;
#pragma unroll
        for (int e = 0; e < 2; ++e) { const int q = tid + 512 * e; if (q < 536) { float* dst = xin + (q >> 3) * 64 + (q & 7) * 8;
#pragma unroll
            for (int k = 0; k < 4; ++k) { dst[2 * k] = bf2f(px[e][k] & 0xffffu); dst[2 * k + 1] = bf2f(px[e][k] >> 16); } } }
        if (MODE == 1) *(u32x4*)(gtl + (tid >> 3) * 144 + (tid & 7) * 16) = pg;
        BAR_LDS();
        if (j + nslots < nitems) LRU_PREFETCH(j + nslots);
        { const int c = tid & 63, ig = tid >> 6;
#pragma unroll
          for (int ii = 0; ii < 8; ++ii) { const int i = ig * 8 + ii; const float v = cbias + cw0 * xin[i * 64 + c] + cw1 * xin[(i + 1) * 64 + c] + cw2 * xin[(i + 2) * 64 + c] + cw3 * xin[(i + 3) * 64 + c];
              xc[i * 68 + c] = v; *(bf16_t*)(xb + i * 144 + c * 2) = (bf16_t)f2bf(v); } }
        BAR_LDS();
        f32x4 acc[2][4];
#pragma unroll
        for (int m2 = 0; m2 < 2; ++m2)
#pragma unroll
            for (int dg = 0; dg < 4; ++dg) acc[m2][dg] = (f32x4){0.f, 0.f, 0.f, 0.f};
#pragma unroll
        for (int ks = 0; ks < 2; ++ks) { bf16x8 af[2];
#pragma unroll
            for (int m2 = 0; m2 < 2; ++m2) af[m2] = ldfrag(xb, (mh * 2 + m2) * 16 + fr, 144, ks * 64 + fq * 16);
#pragma unroll
            for (int dg = 0; dg < 4; ++dg) { const bf16x8 bfr = ldfrag(Wt + dg * 9216, nt * 16 + fr, 144, ks * 64 + fq * 16);
#pragma unroll
                for (int m2 = 0; m2 < 2; ++m2) acc[m2][dg] = __builtin_amdgcn_mfma_f32_16x16x32_bf16(af[m2], bfr, acc[m2][dg], 0, 0, 0); } }
        float av[2][2][4], bv[2][2][4];
#pragma unroll
        for (int m2 = 0; m2 < 2; ++m2)
#pragma unroll
            for (int jj = 0; jj < 4; ++jj) { const int i = (mh * 2 + m2) * 16 + fq * 4 + jj; const float xv = xc[i * 68 + co];
#pragma unroll
                for (int d = 0; d < 2; ++d) { const float r = sigmoidf_(acc[m2][d * 2][jj] + bgr[d]), ing = sigmoidf_(acc[m2][d * 2 + 1][jj] + bgi[d]), la = sp[d] * r;
                    const float aa = __expf(la);
                    float mult = __builtin_amdgcn_sqrtf(fmaxf(1.f - aa * aa, 0.f));
                    if (isctx && ((d == 0 && cn == 0 && i == 0) || (d == 1 && cn == 3 && i == 63))) mult = 1.f;
                    av[d][m2][jj] = aa; bv[d][m2][jj] = mult * ing * xv; } }
#pragma unroll
        for (int m2 = 0; m2 < 2; ++m2) { const int sg = (mh * 2 + m2) * 4 + fq; float A0 = 1.f, B0 = 0.f, A1 = 1.f, B1 = 0.f;
#pragma unroll
            for (int jj = 0; jj < 4; ++jj) { B0 = av[0][m2][jj] * B0 + bv[0][m2][jj]; A0 *= av[0][m2][jj]; B1 = av[1][m2][3 - jj] * B1 + bv[1][m2][3 - jj]; A1 *= av[1][m2][3 - jj]; }
            seg[(sg * 2 + 0) * 64 + co] = (f32x2){A0, B0}; seg[(sg * 2 + 1) * 64 + co] = (f32x2){A1, B1}; }
        BAR_LDS();
        if constexpr (MODE == 0) {
            if (tid < 128) { const int d = tid >> 6, c2 = tid & 63; float At = 1.f, Bt = 0.f;
#pragma unroll
                for (int k = 0; k < 16; ++k) { const int sg = d ? 15 - k : k; const f32x2 v = seg[(sg * 2 + d) * 64 + c2]; Bt = v[0] * Bt + v[1]; At *= v[0]; }
                ((f32x2*)(P.ws + WS_LSUM))[((size_t)(b * 2 + d) * NCH + cn) * 512 + nb * 64 + c2] = (f32x2){At, Bt}; }
        } else {
            const float* CAR = (const float*)(P.ws + WS_LCAR);
            float hf = CAR[((size_t)(b * 2 + 0) * NCH + cn) * 512 + ch], hb = CAR[((size_t)(b * 2 + 1) * NCH + cn) * 512 + ch];
            const int sg0 = (mh * 2) * 4 + fq;
            for (int k = 0; k < sg0; ++k) { const f32x2 v = seg[(k * 2 + 0) * 64 + co]; hf = v[0] * hf + v[1]; }
            for (int k = 15; k > sg0 + 4; --k) { const f32x2 v = seg[(k * 2 + 1) * 64 + co]; hb = v[0] * hb + v[1]; }
            float o[2][4];
#pragma unroll
            for (int jj = 0; jj < 4; ++jj) { hf = av[0][0][jj] * hf + bv[0][0][jj]; o[0][jj] = hf; }
#pragma unroll
            for (int k = 1; k < 4; ++k) { const f32x2 v = seg[((sg0 + k) * 2 + 0) * 64 + co]; hf = v[0] * hf + v[1]; }
#pragma unroll
            for (int jj = 0; jj < 4; ++jj) { hf = av[0][1][jj] * hf + bv[0][1][jj]; o[1][jj] = hf; }
#pragma unroll
            for (int jj = 3; jj >= 0; --jj) { hb = av[1][1][jj] * hb + bv[1][1][jj]; o[1][jj] += hb; }
#pragma unroll
            for (int k = 3; k >= 1; --k) { const f32x2 v = seg[((sg0 + k) * 2 + 1) * 64 + co]; hb = v[0] * hb + v[1]; }
#pragma unroll
            for (int jj = 3; jj >= 0; --jj) { hb = av[1][0][jj] * hb + bv[1][0][jj]; o[0][jj] += hb; }
#pragma unroll
            for (int m2 = 0; m2 < 2; ++m2)
#pragma unroll
                for (int jj = 0; jj < 4; ++jj) { const int i = (mh * 2 + m2) * 16 + fq * 4 + jj; const float gt = bf2f(*(const bf16_t*)(gtl + i * 144 + co * 2));
                    *(bf16_t*)(otl + i * 144 + co * 2) = (bf16_t)f2bf(o[m2][jj] * geluf_(gt)); }
            BAR_LDS();
            { const int i = tid >> 3; bf16_t* PBw = (bf16_t*)(P.ws + WS_PB);
              *(u32x4*)(PBw + LRU_ROW(b, cn, s0 + i) * 1536 + 1024 + nb * 64 + (tid & 7) * 8) = *(const u32x4*)(otl + i * 144 + (tid & 7) * 16); }
        }
        BAR_LDS();
    }
#undef LRU_DECODE
#undef LRU_ROW
#undef LRU_PREFETCH
}
__device__ __forceinline__ void lru_carry(const Ptrs& P, int gt) {
    const int b = gt >> 10, d = (gt >> 9) & 1, ch = gt & 511;
    const f32x2* SUM = (const f32x2*)(P.ws + WS_LSUM) + (size_t)(b * 2 + d) * NCH * 512 + ch; float* CAR = (float*)(P.ws + WS_LCAR) + (size_t)(b * 2 + d) * NCH * 512 + ch;
    float carry = 0.f;
    for (int s0 = 0; s0 < NCH; s0 += 17) {
        f32x2 v[17];
#pragma unroll
        for (int k = 0; k < 17; ++k) v[k] = SUM[(size_t)chunk_of(d, s0 + k) * 512];
#pragma unroll
        for (int k = 0; k < 17; ++k) { CAR[(size_t)chunk_of(d, s0 + k) * 512] = carry; carry = v[k][0] * carry + v[k][1]; }
    }
}

__device__ __forceinline__ void gdn_combine(const Ptrs& P, int gw, int NGW, int lane) {
    const bf16_t* OF = (const bf16_t*)(P.ws + WS_OF); const bf16_t* OB = (const bf16_t*)(P.ws + WS_OB); const bf16_t* PB = (const bf16_t*)(P.ws + WS_PB); bf16_t* MIX = (bf16_t*)(P.ws + WS_MIX);
    float nw[8];
#pragma unroll
    for (int j = 0; j < 8; ++j) nw[j] = P.gnormw[(lane * 8 + j) & 127];
    for (int m = gw; m < M_LAT; m += NGW) {
        const u32x4 a = *(const u32x4*)(OF + (size_t)m * 512 + lane * 8), c = *(const u32x4*)(OB + (size_t)m * 512 + lane * 8), z = *(const u32x4*)(PB + (size_t)m * 1536 + lane * 8);
        float o[8], zz[8]; float ss = 0.f;
#pragma unroll
        for (int j = 0; j < 4; ++j) { o[2 * j] = bf2f(a[j] & 0xffffu) + bf2f(c[j] & 0xffffu); o[2 * j + 1] = bf2f(a[j] >> 16) + bf2f(c[j] >> 16); zz[2 * j] = bf2f(z[j] & 0xffffu); zz[2 * j + 1] = bf2f(z[j] >> 16); }
#pragma unroll
        for (int j = 0; j < 8; ++j) ss += o[j] * o[j];
        ss += __shfl_xor(ss, 1); ss += __shfl_xor(ss, 2); ss += __shfl_xor(ss, 4); ss += __shfl_xor(ss, 8);
        const float rs = rsqrtf(ss * (1.f / 128.f) + EPS);
        u32x4 w;
        w.x = pk2(o[0] * rs * nw[0] * siluf_(zz[0]), o[1] * rs * nw[1] * siluf_(zz[1])); w.y = pk2(o[2] * rs * nw[2] * siluf_(zz[2]), o[3] * rs * nw[3] * siluf_(zz[3]));
        w.z = pk2(o[4] * rs * nw[4] * siluf_(zz[4]), o[5] * rs * nw[5] * siluf_(zz[5])); w.w = pk2(o[6] * rs * nw[6] * siluf_(zz[6]), o[7] * rs * nw[7] * siluf_(zz[7]));
        *(u32x4*)(MIX + (size_t)m * D + lane * 8) = w;
        *(u32x4*)(MIX + (size_t)m * D + 512 + lane * 8) = *(const u32x4*)(PB + (size_t)m * 1536 + 1024 + lane * 8);
    }
}

#define RLX_AGENT __ATOMIC_RELAXED, __HIP_MEMORY_SCOPE_AGENT
#define XB_TMO      128
#define XB_XCNT(j)  (256  + 64 * (j))
#define XB_XSUB(j)  (1280 + 64 * (j))
#define XB_XGEN(j)  (2304 + 64 * (j))
#define XB_TOP      3328
#define XB_TOPGEN   3392
#define XCD_BAR_WORDS 3456
#define XB_SPIN_CAP (1u << 18)

__device__ __forceinline__ unsigned xb_ld(unsigned* p)              { return __hip_atomic_load(p, __ATOMIC_RELAXED, __HIP_MEMORY_SCOPE_AGENT); }
__device__ __forceinline__ unsigned xb_add(unsigned* p, unsigned v) { return __hip_atomic_fetch_add(p, v, __ATOMIC_RELAXED, __HIP_MEMORY_SCOPE_AGENT); }
__device__ __forceinline__ unsigned xb_xcc_id() { return (unsigned)__builtin_amdgcn_s_getreg((3 << 11) | 20) & 0xFu; }
#define XB_SPIN(cond, bar) do { unsigned _sp = 0; while (cond) { __builtin_amdgcn_s_sleep(1); \
    if ((++_sp & 255u) == 0u) { if (xb_ld(&(bar)[XB_TMO])) break; if (_sp > XB_SPIN_CAP) { atomicAdd(&(bar)[XB_TMO], 1u); break; } } } } while (0)

struct XcdBarrier {
    unsigned* bar; unsigned x;
    volatile LAS unsigned* st;
};

__device__ __forceinline__ XcdBarrier xcd_barrier_post(unsigned* bar, volatile LAS unsigned* st) {
    XcdBarrier b; b.bar = bar; b.x = xb_xcc_id(); b.st = st;
    if (threadIdx.x == 0) (void)xb_add(&bar[XB_XCNT(b.x)], 1u);
    return b;
}
__device__ __forceinline__ void xcd_barrier_complete(unsigned* bar, unsigned x, unsigned& nloc, unsigned& nx) {
    const unsigned G = gridDim.x * gridDim.y * gridDim.z;
    unsigned sum, cnt, mine, sp = 0u;
    for (;;) {
        sum = 0u; cnt = 0u; mine = 0u;
#pragma unroll
        for (unsigned j = 0; j < 16; ++j) { const unsigned c = xb_ld(&bar[XB_XCNT(j)]); sum += c; cnt += (c > 0u) ? 1u : 0u; mine = (j == x) ? c : mine; }
        if (sum == G) break;
        __builtin_amdgcn_s_sleep(1);
        if ((++sp & 255u) == 0u) { if (xb_ld(&bar[XB_TMO])) break; if (sp > XB_SPIN_CAP) { atomicAdd(&bar[XB_TMO], 1u); break; } }
    }
    nloc = mine > 0u ? mine : 1u; nx = cnt > 0u ? cnt : 1u;
}

__device__ __forceinline__ void xcd_barrier(const XcdBarrier& b) {
    asm volatile("s_waitcnt vmcnt(0)" ::: "memory");
    __syncthreads();
    if (threadIdx.x == 0) {
        unsigned* bar = b.bar;
        __builtin_amdgcn_s_waitcnt(0);
        unsigned nloc = b.st[0], nx = b.st[1];
        if (nloc == 0u) { xcd_barrier_complete(bar, b.x, nloc, nx); b.st[0] = nloc; b.st[1] = nx; }
        const unsigned old = xb_add(&bar[XB_XSUB(b.x)], 1u);
        const unsigned gen = old / nloc;
        if (old + 1u == (gen + 1u) * nloc) {
            __builtin_amdgcn_fence(__ATOMIC_RELEASE, "agent");
            asm volatile("s_waitcnt vmcnt(0)" ::: "memory");
            const unsigned og = xb_add(&bar[XB_TOP], 1u);
            const unsigned tg = og / nx;
            if (og + 1u == (tg + 1u) * nx) xb_add(&bar[XB_TOPGEN], 1u);
            else XB_SPIN(xb_ld(&bar[XB_TOPGEN]) == tg, bar);
            __builtin_amdgcn_fence(__ATOMIC_ACQUIRE, "agent");
            xb_add(&bar[XB_XGEN(b.x)], 1u);
            asm volatile("s_waitcnt vmcnt(0)" ::: "memory");
        } else {
            XB_SPIN(xb_ld(&bar[XB_XGEN(b.x)]) == gen, bar);
            __builtin_amdgcn_fence(__ATOMIC_ACQUIRE, "agent");
            asm volatile("s_waitcnt vmcnt(0)" ::: "memory");
        }
    }
    __syncthreads();
}


__device__ __forceinline__ void sub_barrier(unsigned* cnt, unsigned target) {
    asm volatile("s_waitcnt vmcnt(0)" ::: "memory");
    __syncthreads();
    if (threadIdx.x == 0) {
        __builtin_amdgcn_fence(__ATOMIC_RELEASE, "agent");
        asm volatile("s_waitcnt vmcnt(0)" ::: "memory");
        (void)__hip_atomic_fetch_add(cnt, 1u, __ATOMIC_RELAXED, __HIP_MEMORY_SCOPE_AGENT);
        unsigned sp = 0u;
        while (__hip_atomic_load(cnt, __ATOMIC_RELAXED, __HIP_MEMORY_SCOPE_AGENT) < target) { __builtin_amdgcn_s_sleep(1); if (++sp > (1u << 22)) break; }
        __builtin_amdgcn_fence(__ATOMIC_ACQUIRE, "agent");
        asm volatile("s_waitcnt vmcnt(0)" ::: "memory");
    }
    __syncthreads();
}

struct Args { const float* in[22]; float* out; unsigned char* ws; int ph_lo, ph_hi; };
constexpr int N_PHASES = 14;

__global__ void __launch_bounds__(512, 2) fwd_kernel(Args args) {
    extern __shared__ __attribute__((aligned(16))) unsigned char lds[];
    const int tid = threadIdx.x, lane = tid & 63, wave = __builtin_amdgcn_readfirstlane(tid >> 6);
    const int G = gridDim.x, bid = blockIdx.x, gw = bid * 8 + wave, NGW = G * 8;
    Ptrs P;
    P.x = args.in[0]; P.c = args.in[1]; P.ctx = args.in[2]; P.cctx = args.in[3]; P.w_ada = args.in[4]; P.b_ada = args.in[5]; P.norm_g = args.in[6];
    P.w1 = args.in[7]; P.w3 = args.in[8]; P.w2 = args.in[9]; P.w_in = args.in[10]; P.w_out = args.in[11]; P.gconv = args.in[12]; P.galog = args.in[13]; P.gdtb = args.in[14];
    P.gnormw = args.in[15]; P.lconv = args.in[16]; P.lconvb = args.in[17]; P.lwg = args.in[18]; P.lbg = args.in[19]; P.llam = args.in[20]; P.fng = args.in[21];
    P.out = args.out; P.ws = args.ws;
    unsigned char* ws = args.ws;
    const float* mods = (const float*)(ws + WS_MODS);
    bf16_t* U = (bf16_t*)(ws + WS_U); bf16_t* HID = (bf16_t*)(ws + WS_HID); float* H1CTX = (float*)(ws + WS_H1CTX);
    LAS unsigned char* ldsl = (LAS unsigned char*)lds;
    const int lo = args.ph_lo, hi = args.ph_hi;
#ifndef REP_MASK
#define REP_MASK 0
#endif
#ifndef SKIP_MASK
#define SKIP_MASK 0
#endif
#define IN(k) (!((SKIP_MASK >> (k)) & 1) && lo <= (k) && (k) < hi)
#define SEAM(k) do { if (IN(k) && IN((k) + 1)) { xcd_barrier(bar); } } while (0)
    volatile LAS unsigned* MISC = (volatile LAS unsigned*)(ldsl + LDS_BYTES - 64);
    if (tid == 0) { MISC[0] = 0u; MISC[1] = 0u; }
    __syncthreads();
    XcdBarrier bar = xcd_barrier_post((unsigned*)ws + 4096, MISC);

    if (hi > N_PHASES) cg::this_grid().sync();
    if (IN(0)) for (int rep_ = 0; rep_ < 1 + ((REP_MASK >> 0) & 1); ++rep_) { if (rep_) __syncthreads(); phase_prologue(P, lds, tid, lane, wave, bid, G); } SEAM(0);
    if (IN(1)) for (int rep_ = 0; rep_ < 1 + ((REP_MASK >> 1) & 1); ++rep_) { if (rep_) __syncthreads(); phase_norm_mod(P.x, P.ctx, M_TOT, P.norm_g, mods, 0, 1, U, gw, NGW, lane); } SEAM(1);
    if (IN(2)) for (int rep_ = 0; rep_ < 1 + ((REP_MASK >> 2) & 1); ++rep_) { if (rep_) __syncthreads(); pg8::Gemm g{U, (const bf16_t*)(ws + WS_W1A), M_TOT, 2 * FF, D}; pg8::StaticOrder S; S.init(M_TOT, 2 * FF, G, bid); pg8::EpiSwiglu E{HID};
        pg8::gemm_phase<pg8::EpiSwiglu, true>(ldsl, g, S, E); } SEAM(2);
    if (IN(3)) for (int rep_ = 0; rep_ < 1 + ((REP_MASK >> 3) & 1); ++rep_) { if (rep_) __syncthreads(); pg8::Gemm g{HID, (const bf16_t*)(ws + WS_W2A), M_TOT, D, FF}; pg8::StaticOrder S; S.init(M_TOT, D, G, bid);
        pg8::EpiRes E{P.x, P.ctx, P.out, H1CTX, mods + 2 * D, 0.5f}; pg8::gemm_phase<pg8::EpiRes, true>(ldsl, g, S, E); } SEAM(3);
    if (IN(4)) for (int rep_ = 0; rep_ < 1 + ((REP_MASK >> 4) & 1); ++rep_) { if (rep_) __syncthreads(); phase_norm_mod(P.out, H1CTX, M_TOT, P.norm_g + D, mods, 3, 4, U, gw, NGW, lane); } SEAM(4);
    if (IN(5)) for (int rep_ = 0; rep_ < 1 + ((REP_MASK >> 5) & 1); ++rep_) { if (rep_) __syncthreads(); pg8::Gemm g{U, (const bf16_t*)(ws + WS_WIN), M_TOT, NIN, D}; pg8::StaticOrder S; S.init(M_TOT, NIN, G, bid);
        pg8::EpiIn E{(bf16_t*)(ws + WS_PA), (bf16_t*)(ws + WS_PB), (float*)(ws + WS_BA)}; pg8::gemm_phase<pg8::EpiIn, true>(ldsl, g, S, E); } SEAM(5);
    if (IN(6)) for (int rep_ = 0; rep_ < 1 + ((REP_MASK >> 6) & 1); ++rep_) { if (rep_) __syncthreads();
        gdn_prep_phase(P, lds, tid, lane, wave, bid, G);
    } SEAM(6);
    if (IN(7)) for (int rep_ = 0; rep_ < 1 + ((REP_MASK >> 7) & 1); ++rep_) { if (rep_) __syncthreads();
        if (bid < 128) { gdn_scan_item(P, lds, bid, tid, lane, wave); }
        else {
            unsigned* cnt = (unsigned*)ws + 8192;
            const int nb = bid & 7, slot = (bid - 128) >> 3;
            lru_phase<0>(P, lds, tid, lane, wave, nb, slot, 16);
            sub_barrier(cnt, 128u);
            if (slot == 0) lru_carry(P, nb * 512 + tid);
            sub_barrier(cnt + 64, 128u);
            lru_phase<1>(P, lds, tid, lane, wave, nb, slot, 16);
        }
    } SEAM(7);
    if (IN(8)) for (int rep_ = 0; rep_ < 1 + ((REP_MASK >> 8) & 1); ++rep_) { if (rep_) __syncthreads();
        gdn_combine(P, gw, NGW, lane);
    } SEAM(8);
    if (IN(9)) for (int rep_ = 0; rep_ < 1 + ((REP_MASK >> 9) & 1); ++rep_) { if (rep_) __syncthreads(); pg8::Gemm g{(const bf16_t*)(ws + WS_MIX), (const bf16_t*)(ws + WS_WOUT), M_LAT, D, D}; pg8::StaticOrder S; S.init(M_LAT, D, G, bid);
        pg8::EpiRes E{P.out, P.out, P.out, P.out, mods + 5 * D, 1.0f}; pg8::gemm_phase<pg8::EpiRes, true>(ldsl, g, S, E); } SEAM(9);
    if (IN(10)) for (int rep_ = 0; rep_ < 1 + ((REP_MASK >> 10) & 1); ++rep_) { if (rep_) __syncthreads(); phase_norm_mod(P.out, P.out, M_LAT, P.norm_g + 2 * D, mods, 6, 7, U, gw, NGW, lane); } SEAM(10);
    if (IN(11)) for (int rep_ = 0; rep_ < 1 + ((REP_MASK >> 11) & 1); ++rep_) { if (rep_) __syncthreads(); pg8::Gemm g{U, (const bf16_t*)(ws + WS_W1B), M_LAT, 2 * FF, D}; pg8::StaticOrder S; S.init(M_LAT, 2 * FF, G, bid); pg8::EpiSwiglu E{HID};
        pg8::gemm_phase<pg8::EpiSwiglu, true>(ldsl, g, S, E); } SEAM(11);
    if (IN(12)) for (int rep_ = 0; rep_ < 1 + ((REP_MASK >> 12) & 1); ++rep_) { if (rep_) __syncthreads(); pg8::Gemm g{HID, (const bf16_t*)(ws + WS_W2B), M_LAT, D, FF}; pg8::StaticOrder S; S.init(M_LAT, D, G, bid);
        pg8::EpiRes E{P.out, P.out, P.out, P.out, mods + 8 * D, 0.5f}; pg8::gemm_phase<pg8::EpiRes, true>(ldsl, g, S, E); } SEAM(12);
    if (IN(13)) for (int rep_ = 0; rep_ < 1 + ((REP_MASK >> 13) & 1); ++rep_) { if (rep_) __syncthreads();
        for (int m = gw; m < M_LAT; m += NGW) { float* row = P.out + (size_t)m * D; f32x4 v[4]; float ss = 0.f;
#pragma unroll
            for (int j = 0; j < 4; ++j) { v[j] = *(const f32x4*)(row + 4 * lane + 256 * j); ss += (v[j][0] * v[j][0] + v[j][1] * v[j][1]) + (v[j][2] * v[j][2] + v[j][3] * v[j][3]); }
            const float rstd = rsqrtf(wave_sum(ss) * (1.f / D) + EPS);
#pragma unroll
            for (int j = 0; j < 4; ++j) { const f32x4 gv = *(const f32x4*)(P.fng + 4 * lane + 256 * j); *(f32x4*)(row + 4 * lane + 256 * j) = v[j] * rstd * gv; } }
    }
#undef IN
#undef SEAM
}

extern "C" void kernel_launch(void* const* d_in, const int* in_sizes, int n_in, void* d_out, int out_size, void* d_ws, size_t ws_size, hipStream_t stream) {
    static int grid = 0;
    if (grid == 0) {
        if (n_in != 22 || out_size != M_LAT * D || ws_size < WS_END) { fprintf(stderr, "kernel_launch: unexpected shapes (n_in %d, out %d, ws %zu)\n", n_in, out_size, ws_size); grid = -1; return; }
        int dev = 0, cus = 0, per_cu = 0;
        hipGetDevice(&dev); hipDeviceGetAttribute(&cus, hipDeviceAttributeMultiprocessorCount, dev);
        if (hipFuncSetAttribute((const void*)fwd_kernel, hipFuncAttributeMaxDynamicSharedMemorySize, LDS_BYTES) != hipSuccess) { fprintf(stderr, "kernel_launch: hipFuncSetAttribute failed\n"); grid = -1; return; }
        if (hipOccupancyMaxActiveBlocksPerMultiprocessor(&per_cu, (const void*)fwd_kernel, 512, LDS_BYTES) != hipSuccess || per_cu < 1) { fprintf(stderr, "kernel_launch: occupancy query gives %d\n", per_cu); per_cu = 1; }
        (void)hipGetLastError();
        grid = 256;
        if (cus * per_cu < 256) { fprintf(stderr, "kernel_launch: device too small (%d x %d)\n", cus, per_cu); grid = -1; return; }
        fprintf(stderr, "kernel_launch: grid %d (cus %d, per_cu %d)\n", grid, cus, per_cu);
    }
    if (grid < 0) return;
    Args a{};
    for (int i = 0; i < 22; ++i) a.in[i] = (const float*)d_in[i];
    a.out = (float*)d_out; a.ws = (unsigned char*)d_ws;
    if (hipMemsetAsync(d_ws, 0, 65536, stream) != hipSuccess) { fprintf(stderr, "kernel_launch: memset failed\n"); return; }
#if ONE_LAUNCH
    a.ph_lo = 0; a.ph_hi = N_PHASES;
    void* kargs[] = {&a};
    hipError_t e = hipLaunchCooperativeKernel((const void*)fwd_kernel, dim3(grid), dim3(512), kargs, LDS_BYTES, stream);
    if (e != hipSuccess) fprintf(stderr, "kernel_launch: cooperative launch failed: %s\n", hipGetErrorString(e));
#else
    for (int p = 0; p < N_PHASES; ++p) { a.ph_lo = p; a.ph_hi = p + 1; hipLaunchKernelGGL(fwd_kernel, dim3(grid), dim3(512), LDS_BYTES, stream, a); }
#endif
}
```

```cpp
#include <hip/hip_runtime.h>
#include <hip/hip_cooperative_groups.h>
#include <cstdio>
#include <cstdint>
namespace cg = cooperative_groups;

#ifndef ONE_LAUNCH
#define ONE_LAUNCH 1
#endif

#define LAS __attribute__((address_space(3)))
typedef unsigned short bf16_t;
typedef short bf16x8 __attribute__((ext_vector_type(8)));
typedef float f32x4 __attribute__((ext_vector_type(4)));
typedef float f32x2 __attribute__((ext_vector_type(2)));
typedef unsigned u32x4 __attribute__((ext_vector_type(4)));
typedef unsigned u32x2 __attribute__((ext_vector_type(2)));

constexpr int D = 1024, NB = 4, SEQ = 4096, CTXL = 256, FF = 2816;
constexpr int M_LAT = NB * SEQ, M_CTX = NB * CTXL, M_TOT = M_LAT + M_CTX;
constexpr int NMOD = 9 * D;
constexpr int IN_COLS = 3088, NIN = 3328;
constexpr int NCH = 68;
constexpr float EPS = 1e-6f;

constexpr size_t MiB = 1u << 20;
constexpr size_t WS_MODS = 1 * MiB, WS_BA = 2 * MiB, WS_GC = 4 * MiB, WS_LSUM = 5 * MiB, WS_LCAR = 7 * MiB + MiB / 2;
constexpr size_t WS_WOUT = 10 * MiB, WS_W1B = 12 * MiB, WS_W2B = 23 * MiB;
constexpr size_t WS_PA = 29 * MiB, WS_PB = 80 * MiB, WS_HID = 29 * MiB, WS_OF = 29 * MiB, WS_OB = 45 * MiB;
constexpr size_t WS_U = 131 * MiB, WS_W1A = 165 * MiB, WS_W2A = 176 * MiB, WS_WIN = 182 * MiB, WS_H1CTX = 189 * MiB, WS_H1CTX2 = 193 * MiB;
constexpr size_t WS_QG = 131 * MiB, WS_KG = 148 * MiB, WS_WB = 165 * MiB, WS_UB = 199 * MiB, WS_ATT = 233 * MiB, WS_MIX = 131 * MiB;
constexpr size_t WS_END = 256 * MiB;
constexpr int LDS_BYTES = 147456;

__device__ __forceinline__ unsigned f2bf(float f) { unsigned u = __builtin_bit_cast(unsigned, f); return (u + 0x7fffu + ((u >> 16) & 1u)) >> 16; }
__device__ __forceinline__ unsigned pk2(float lo, float hi) { return f2bf(lo) | (f2bf(hi) << 16); }
__device__ __forceinline__ float bf2f(unsigned h) { return __builtin_bit_cast(float, h << 16); }
__device__ __forceinline__ float wave_sum(float v) {
#pragma unroll
    for (int o = 1; o < 64; o <<= 1) v += __shfl_xor(v, o);
    return v;
}
__device__ __forceinline__ float sigmoidf_(float x) { return __builtin_amdgcn_rcpf(1.f + __expf(-x)); }
__device__ __forceinline__ float siluf_(float x) { return x * __builtin_amdgcn_rcpf(1.f + __expf(-x)); }
__device__ __forceinline__ float softplusf_(float x) { return x > 20.f ? x : log1pf(__expf(x)); }
__device__ __forceinline__ float geluf_(float x) { const float t = 0.7978845608f * (x + 0.044715f * x * x * x); return x * __builtin_amdgcn_rcpf(1.f + __expf(-2.f * t)); }
#define LDS_WAIT() asm volatile("s_waitcnt lgkmcnt(0)" ::: "memory")
#define BAR_LDS() do { asm volatile("s_waitcnt lgkmcnt(0)" ::: "memory"); __builtin_amdgcn_s_barrier(); asm volatile("" ::: "memory"); } while (0)

namespace pg8 {
constexpr int BM = 256, BK = 64, HALF = 128, HTB = HALF * BK * 2, NXCD = 8, WGM = 8;
__host__ __device__ __forceinline__ int lds_byte(int r, int c) { const int st = (r >> 4) * 2 + (c >> 5), rr = r & 15, cc = c & 31, ob = rr * 64 + cc * 2; return st * 1024 + (ob ^ (((ob >> 9) & 1) << 5)); }
__host__ __device__ __forceinline__ void stage_rc(int b, int& R, int& C) { const int st = b / 1024, sb = b % 1024, swz = sb ^ (((sb >> 9) & 1) << 5); R = (st >> 1) * 16 + swz / 64; C = (st & 1) * 32 + (swz % 64) / 2; }
struct Unit { int pm, pn, pk; };
struct Gemm { const bf16_t* A; const bf16_t* Bt; int M, N, K; int Kp, nt; };
struct StaticOrder {
    int nM, nN, nwg, G, c;
    __device__ void init(int M, int N, int G_, int c_) { nM = M / BM; nN = N / BM; nwg = nM * nN; G = G_; c = c_; }
    __device__ bool next(int i, Unit& u) const {
        const long L = (long)i * G + c; if (L >= nwg) return false;
        int wgid = (int)L; { const int q = nwg / NXCD, r = nwg % NXCD, xcd = wgid % NXCD, off = wgid / NXCD; wgid = (xcd < r ? xcd * (q + 1) : r * (q + 1) + (xcd - r) * q) + off; }
        const int nig = WGM * nN, gid = wgid / nig, fm = gid * WGM, gsz = (nM - fm) < WGM ? (nM - fm) : WGM;
        u.pm = fm + ((wgid % nig) % gsz); u.pn = (wgid % nig) / gsz; u.pk = 0; return true;
    }
};
struct CtxSplitOrder {
    int G, c;
    __device__ bool next(int i, Unit& u) const { const int L = i * G + c; if (L >= 32) return false; u.pk = L & 1; u.pn = (L >> 1) & 3; u.pm = L >> 3; return true; }
};
template <class Epi, bool ALIGN_EPI, class Sched>
__device__ __forceinline__ void gemm_phase(LAS unsigned char* lds, const Gemm g, const Sched& S, const Epi& E) {
    const int tid = threadIdx.x, wid = __builtin_amdgcn_readfirstlane(tid >> 6), lane = tid & 63, wr = wid >> 2, wc = wid & 3, fr = lane & 15, fq = lane >> 4;
    const int K = g.Kp, nt = g.nt;
    unsigned voffA[2];
#pragma unroll
    for (int i = 0; i < 2; ++i) { int R, C; stage_rc(tid * 16 + i * 8192, R, C); voffA[i] = (unsigned)(R * K + C) * 2u; }
    const size_t kstep = (size_t)(BK * 2);
    const size_t hstep = (size_t)HALF * K * 2;
    const size_t tstep = 2 * hstep;
    const unsigned ldsw = (unsigned)wid * 1024u;
    const int aoff = lds_byte(wr * 64 + fr, fq * 8), boff = lds_byte(wc * 32 + fr, fq * 8);
#define PG8_SA(b, h) (((b) * 2 + (h)) * HTB)
#define PG8_SB(b, h) ((4 + (b) * 2 + (h)) * HTB)
#define PG8_STAGE(bufoff, gbase, voff) do { _Pragma("unroll") for (int _i = 0; _i < 2; ++_i) \
        __builtin_amdgcn_global_load_lds((const unsigned*)((const char*)(gbase) + (voff)[_i]), (LAS unsigned*)(lds + (bufoff) + ldsw + _i * 8192), 16, 0, 0); } while (0)
#define PG8_LDA(dst, b, h) do { _Pragma("unroll") for (int m = 0; m < 4; ++m) _Pragma("unroll") for (int k = 0; k < 2; ++k) dst[m][k] = *(const LAS bf16x8*)(lds + PG8_SA(b, h) + aoff + m * 2048 + k * 1024); } while (0)
#define PG8_LDB(dst, b, h) do { _Pragma("unroll") for (int n = 0; n < 2; ++n) _Pragma("unroll") for (int k = 0; k < 2; ++k) dst[n][k] = *(const LAS bf16x8*)(lds + PG8_SB(b, h) + boff + n * 2048 + k * 1024); } while (0)
#define PG8_MMA(ai, bj, At, Bt) do { __builtin_amdgcn_s_setprio(1); _Pragma("unroll") for (int m = 0; m < 4; ++m) _Pragma("unroll") for (int n = 0; n < 2; ++n) _Pragma("unroll") for (int k = 0; k < 2; ++k) \
        acc[ai][bj][m][n] = __builtin_amdgcn_mfma_f32_16x16x32_bf16(Bt[n][k], At[m][k], acc[ai][bj][m][n], 0, 0, 0); __builtin_amdgcn_s_setprio(0); } while (0)
#define PG8_WAIT_V(n) asm volatile("s_waitcnt vmcnt(" #n ")" ::: "memory")
#define PG8_WAIT_L(n) asm volatile("s_waitcnt lgkmcnt(" #n ")" ::: "memory")
#define PG8_BAR __builtin_amdgcn_s_barrier()
#define PG8_SCHED __builtin_amdgcn_sched_barrier(0)
    Unit cur, nxt; int ui = 0;
    if (!S.next(0, cur)) return;
    f32x4 acc[2][2][4][2];
#pragma unroll
    for (int a = 0; a < 2; ++a)
#pragma unroll
        for (int b = 0; b < 2; ++b)
#pragma unroll
            for (int m = 0; m < 4; ++m)
#pragma unroll
                for (int n = 0; n < 2; ++n) acc[a][b][m][n] = (f32x4){0.f, 0.f, 0.f, 0.f};
    bf16x8 At[4][2], B0[2][2], B1[2][2];
    const char* cA = (const char*)g.A + (size_t)cur.pm * tstep + (size_t)cur.pk * nt * kstep; const char* cB = (const char*)g.Bt + (size_t)cur.pn * tstep + (size_t)cur.pk * nt * kstep;
    PG8_STAGE(PG8_SB(0, 0), cB, voffA); PG8_STAGE(PG8_SB(0, 1), cB + hstep, voffA); PG8_STAGE(PG8_SA(0, 0), cA, voffA); PG8_STAGE(PG8_SA(0, 1), cA + hstep, voffA);
    if (wr == 1) PG8_BAR;
    PG8_WAIT_V(2); PG8_BAR;
    PG8_STAGE(PG8_SB(1, 0), cB + kstep, voffA); PG8_STAGE(PG8_SA(1, 0), cA + kstep, voffA); PG8_STAGE(PG8_SB(1, 1), cB + hstep + kstep, voffA);
    PG8_WAIT_V(6); PG8_BAR;
    for (;;) {
        const bool has_next = S.next(ui + 1, nxt);
        const char* nA = has_next ? (const char*)g.A + (size_t)nxt.pm * tstep + (size_t)nxt.pk * nt * kstep : cA; const char* nB = has_next ? (const char*)g.Bt + (size_t)nxt.pn * tstep + (size_t)nxt.pk * nt * kstep : cB;
        for (int t = 0; t < nt; t += 2) {
            const bool last = (t == nt - 2);
            const char* a1 = cA + (size_t)(t + 1) * kstep;
            const char* a2 = last ? nA : cA + (size_t)(t + 2) * kstep; const char* b2 = last ? nB : cB + (size_t)(t + 2) * kstep;
            const char* a3 = a2 + kstep; const char* b3 = b2 + kstep;
            PG8_LDB(B0, 0, 0); PG8_LDB(B1, 0, 1); PG8_SCHED; PG8_LDA(At, 0, 0); PG8_STAGE(PG8_SA(1, 1), a1 + hstep, voffA);
            PG8_WAIT_V(8); PG8_WAIT_L(0); PG8_BAR; PG8_MMA(0, 0, At, B0); PG8_MMA(0, 1, At, B1); PG8_BAR; PG8_SCHED;
            PG8_LDA(At, 0, 1); PG8_STAGE(PG8_SB(0, 0), b2, voffA); PG8_STAGE(PG8_SB(0, 1), b2 + hstep, voffA); PG8_STAGE(PG8_SA(0, 0), a2, voffA);
            PG8_WAIT_V(8); PG8_WAIT_L(0); PG8_BAR; PG8_MMA(1, 0, At, B0); PG8_MMA(1, 1, At, B1); PG8_BAR; PG8_SCHED;
            PG8_LDB(B0, 1, 0); PG8_LDB(B1, 1, 1); PG8_SCHED; PG8_LDA(At, 1, 0); PG8_STAGE(PG8_SA(0, 1), a2 + hstep, voffA);
            PG8_WAIT_V(8); PG8_WAIT_L(0); PG8_BAR; PG8_MMA(0, 0, At, B0); PG8_MMA(0, 1, At, B1); PG8_BAR; PG8_SCHED;
            PG8_LDA(At, 1, 1); PG8_STAGE(PG8_SB(1, 0), b3, voffA); PG8_STAGE(PG8_SB(1, 1), b3 + hstep, voffA); PG8_STAGE(PG8_SA(1, 0), a3, voffA);
            PG8_WAIT_V(8); PG8_WAIT_L(0); PG8_BAR; PG8_MMA(1, 0, At, B0); PG8_MMA(1, 1, At, B1); PG8_BAR; PG8_SCHED;
        }
        if constexpr (ALIGN_EPI) { if (wr == 0) PG8_BAR; }
        E(acc, cur, wr, wc, fr, fq);
        if (!has_next) break;
#pragma unroll
        for (int a = 0; a < 2; ++a)
#pragma unroll
            for (int b = 0; b < 2; ++b)
#pragma unroll
                for (int m = 0; m < 4; ++m)
#pragma unroll
                    for (int n = 0; n < 2; ++n) acc[a][b][m][n] = (f32x4){0.f, 0.f, 0.f, 0.f};
        cur = nxt; cA = nA; cB = nB; ++ui;
        if constexpr (ALIGN_EPI) { if (wr == 1) PG8_BAR; }
    }
    PG8_WAIT_V(0);
    if constexpr (!ALIGN_EPI) { if (wr == 0) PG8_BAR; }
    PG8_BAR;
#undef PG8_SA
#undef PG8_SB
#undef PG8_STAGE
#undef PG8_LDA
#undef PG8_LDB
#undef PG8_MMA
#undef PG8_WAIT_V
#undef PG8_WAIT_L
#undef PG8_BAR
#undef PG8_SCHED
}

struct EpiSwiglu {
    bf16_t* H;
    __device__ __forceinline__ void operator()(const f32x4 (&acc)[2][2][4][2], const Unit& u, int wr, int wc, int fr, int fq) const {
        const int row0 = u.pm * BM + wr * 64 + fr, col0 = u.pn * 128 + wc * 32 + 4 * fq;
#pragma unroll
        for (int ai = 0; ai < 2; ++ai)
#pragma unroll
            for (int m = 0; m < 4; ++m) { bf16_t* rowp = H + (size_t)(row0 + ai * HALF + m * 16) * FF + col0;
#pragma unroll
                for (int n = 0; n < 2; ++n) { const f32x4 gt = acc[ai][0][m][n], up = acc[ai][1][m][n];
                    u32x2 w; w.x = pk2(siluf_(gt[0]) * up[0], siluf_(gt[1]) * up[1]); w.y = pk2(siluf_(gt[2]) * up[2], siluf_(gt[3]) * up[3]);
                    *(u32x2*)(rowp + n * 16) = w; } }
    }
};
struct EpiRes {
    const float* res_lat; const float* res_ctx; float* out_lat; float* out_ctx; const float* gate; float coef;
    __device__ __forceinline__ void operator()(const f32x4 (&acc)[2][2][4][2], const Unit& u, int wr, int wc, int fr, int fq) const {
        const bool isctx = u.pm >= 64; const int mr = isctx ? 4 : (u.pm >> 4);
        const int lrow0 = (isctx ? (u.pm - 64) : u.pm) * BM + wr * 64 + fr, col0 = u.pn * BM + wc * 32 + 4 * fq;
        const float* res = isctx ? res_ctx : res_lat; float* out = isctx ? out_ctx : out_lat;
        const float* gp = gate + (size_t)mr * NMOD + col0;
        f32x4 gv[2][2];
#pragma unroll
        for (int bj = 0; bj < 2; ++bj)
#pragma unroll
            for (int n = 0; n < 2; ++n) gv[bj][n] = *(const f32x4*)(gp + bj * HALF + n * 16) * coef;
#pragma unroll
        for (int ai = 0; ai < 2; ++ai)
#pragma unroll
            for (int m = 0; m < 4; ++m) { const size_t ro = (size_t)(lrow0 + ai * HALF + m * 16) * D + col0;
#pragma unroll
                for (int bj = 0; bj < 2; ++bj)
#pragma unroll
                    for (int n = 0; n < 2; ++n) { const f32x4 r = *(const f32x4*)(res + ro + bj * HALF + n * 16);
                        *(f32x4*)(out + ro + bj * HALF + n * 16) = r + gv[bj][n] * acc[ai][bj][m][n]; } }
    }
};
struct EpiResCtxSplit {
    const float* res; float* out0; float* out1; const float* gate; float coef;
    __device__ __forceinline__ void operator()(const f32x4 (&acc)[2][2][4][2], const Unit& u, int wr, int wc, int fr, int fq) const {
        const int lrow0 = u.pm * BM + wr * 64 + fr, col0 = u.pn * BM + wc * 32 + 4 * fq;
        const float* gp = gate + (size_t)4 * NMOD + col0;
        float* out = u.pk ? out1 : out0;
        f32x4 gv[2][2];
#pragma unroll
        for (int bj = 0; bj < 2; ++bj)
#pragma unroll
            for (int n = 0; n < 2; ++n) gv[bj][n] = *(const f32x4*)(gp + bj * HALF + n * 16) * coef;
#pragma unroll
        for (int ai = 0; ai < 2; ++ai)
#pragma unroll
            for (int m = 0; m < 4; ++m) { const size_t ro = (size_t)(lrow0 + ai * HALF + m * 16) * D + col0;
#pragma unroll
                for (int bj = 0; bj < 2; ++bj)
#pragma unroll
                    for (int n = 0; n < 2; ++n) { f32x4 v = gv[bj][n] * acc[ai][bj][m][n]; if (u.pk == 0) v = v + *(const f32x4*)(res + ro + bj * HALF + n * 16);
                        *(f32x4*)(out + ro + bj * HALF + n * 16) = v; } }
    }
};
struct EpiIn {
    bf16_t* PA; bf16_t* PB; float* BA;
    __device__ __forceinline__ void operator()(const f32x4 (&acc)[2][2][4][2], const Unit& u, int wr, int wc, int fr, int fq) const {
        const int row0 = u.pm * BM + wr * 64 + fr;
        if (u.pn == 12) {
            if (wc == 0) {
#pragma unroll
                for (int ai = 0; ai < 2; ++ai)
#pragma unroll
                    for (int m = 0; m < 4; ++m) *(f32x4*)(BA + (size_t)(row0 + ai * HALF + m * 16) * 16 + 4 * fq) = acc[ai][0][m][0];
            }
            return;
        }
        bf16_t* base = (u.pn < 6) ? PA : PB; const int col0 = (u.pn % 6) * BM + wc * 32 + 4 * fq;
#pragma unroll
        for (int ai = 0; ai < 2; ++ai)
#pragma unroll
            for (int m = 0; m < 4; ++m) { bf16_t* rowp = base + (size_t)(row0 + ai * HALF + m * 16) * 1536 + col0;
#pragma unroll
                for (int bj = 0; bj < 2; ++bj)
#pragma unroll
                    for (int n = 0; n < 2; ++n) { const f32x4 v = acc[ai][bj][m][n]; u32x2 w; w.x = pk2(v[0], v[1]); w.y = pk2(v[2], v[3]); *(u32x2*)(rowp + bj * HALF + n * 16) = w; } }
    }
};
}

__device__ __forceinline__ void transpose_item(const float* W, int N, int k0, int src_col0, int nvalid, bf16_t* WT, int Kp, int dst_row0, float* scr, int lane) {
#pragma unroll 8
    for (int i = 0; i < 32; ++i) { const int kk = 2 * i + (lane >> 5), n = lane & 31; scr[kk * 33 + n] = (n < nvalid) ? W[(size_t)(k0 + kk) * N + src_col0 + n] : 0.f; }
    LDS_WAIT();
    const int c = lane & 7;
#pragma unroll
    for (int j = 0; j < 4; ++j) { const int n = (lane >> 3) + 8 * j; const float* s = scr + (8 * c) * 33 + n;
        u32x4 o; o.x = pk2(s[0 * 33], s[1 * 33]); o.y = pk2(s[2 * 33], s[3 * 33]); o.z = pk2(s[4 * 33], s[5 * 33]); o.w = pk2(s[6 * 33], s[7 * 33]);
        *(u32x4*)(WT + (size_t)(dst_row0 + n) * Kp + k0 + 8 * c) = o; }
    LDS_WAIT();
}

struct Ptrs {
    const float *x, *c, *ctx, *cctx, *w_ada, *b_ada, *norm_g, *w1, *w3, *w2, *w_in, *w_out, *gconv, *galog, *gdtb, *gnormw, *lconv, *lconvb, *lwg, *lbg, *llam, *fng;
    float* out; unsigned char* ws;
};

constexpr int CV_UP = 16 * 88, CV_IN = 16 * 97, CV_OUT = 16 * 32, CV_EARLY = 3 * CV_UP, CV_ALL = 6 * CV_UP + CV_IN + CV_OUT;
__device__ __forceinline__ void convert_weights(const Ptrs& P, unsigned char* lds, int it_lo, int it_hi, int widx, int nw, int wave, int lane, bool with_pad) {
    float* scr = (float*)(lds + wave * 16384);
    bf16_t* W1A = (bf16_t*)(P.ws + WS_W1A); bf16_t* W2A = (bf16_t*)(P.ws + WS_W2A); bf16_t* W1B = (bf16_t*)(P.ws + WS_W1B); bf16_t* W2B = (bf16_t*)(P.ws + WS_W2B);
    bf16_t* WIN = (bf16_t*)(P.ws + WS_WIN); bf16_t* WOUT = (bf16_t*)(P.ws + WS_WOUT);
    for (int it = it_lo + widx; it < it_hi; it += nw) {
        int r = it;
        if (r < 6 * CV_UP) {
            const int seg = r / CV_UP; r -= seg * CV_UP; const int layer = seg / 3, kind = seg % 3;
            if (kind < 2) { const int kb = r / 88, nbk = r % 88, sc0 = 32 * nbk; const float* W = (kind == 0 ? P.w1 : P.w3) + (size_t)layer * D * FF;
                transpose_item(W, FF, 64 * kb, sc0, 32, layer ? W1B : W1A, D, 256 * (sc0 / 128) + (sc0 % 128) + (kind ? 128 : 0), scr, lane); }
            else { const int kb = r / 32, nbk = r % 32; transpose_item(P.w2 + (size_t)layer * FF * D, D, 64 * kb, 32 * nbk, 32, layer ? W2B : W2A, FF, 32 * nbk, scr, lane); }
            continue;
        }
        r -= 6 * CV_UP;
        if (r < CV_IN) { const int kb = r / 97, g = r % 97;
            if (g < 64) transpose_item(P.w_in, IN_COLS, 64 * kb, 32 * g, 32, WIN, D, 32 * g, scr, lane);
            else if (g < 96) transpose_item(P.w_in, IN_COLS, 64 * kb, 2064 + 32 * (g - 64), 32, WIN, D, 2048 + 32 * (g - 64), scr, lane);
            else transpose_item(P.w_in, IN_COLS, 64 * kb, 2048, 16, WIN, D, 3072, scr, lane);
            continue; }
        r -= CV_IN;
        { const int kb = r / 32, nbk = r % 32; transpose_item(P.w_out, D, 64 * kb, 32 * nbk, 32, WOUT, D, 32 * nbk, scr, lane); }
    }
    if (with_pad) { u32x4* z = (u32x4*)(WIN + (size_t)3104 * D);
        for (int i = widx * 64 + lane; i < 224 * D * 2 / 16; i += nw * 64) z[i] = (u32x4){0u, 0u, 0u, 0u}; }
}


__device__ __forceinline__ void phase_prologue(const Ptrs& P, unsigned char* lds, int tid, int lane, int wave, int bid, int G) {
    float* mods = (float*)(P.ws + WS_MODS);
    {
        float* sc = (float*)lds;
        for (int i = tid; i < 5 * D; i += 512) { const int r = i >> 10, k = i & 1023; const float v = (r < 4) ? P.c[r * D + k] : P.cctx[k]; sc[i] = siluf_(v); }
        __syncthreads();
        float* red = (float*)(lds + 20480);
        for (int it = bid; it < NMOD / 64; it += G) {
            const int n0 = it * 64, cq = tid & 15, kl = tid >> 4;
            float acc[5][4];
#pragma unroll
            for (int r = 0; r < 5; ++r)
#pragma unroll
                for (int j = 0; j < 4; ++j) acc[r][j] = 0.f;
#pragma unroll 4
            for (int i = 0; i < 32; ++i) { const int k = kl + 32 * i; const f32x4 w = *(const f32x4*)(P.w_ada + (size_t)k * NMOD + n0 + 4 * cq);
#pragma unroll
                for (int r = 0; r < 5; ++r) { const float s = sc[r * D + k];
#pragma unroll
                    for (int j = 0; j < 4; ++j) acc[r][j] += s * w[j]; } }
#pragma unroll
            for (int r = 0; r < 5; ++r)
#pragma unroll
                for (int j = 0; j < 4; ++j) red[(kl * 16 + cq) * 20 + r * 4 + j] = acc[r][j];
            __syncthreads();
            if (tid < 320) { const int cq2 = tid / 20, rj = tid % 20; float s = 0.f;
                for (int k2 = 0; k2 < 32; ++k2) s += red[(k2 * 16 + cq2) * 20 + rj];
                const int r = rj >> 2, n = n0 + 4 * cq2 + (rj & 3); mods[r * NMOD + n] = s + P.b_ada[n]; }
            __syncthreads();
        }
        __syncthreads();
    }
    convert_weights(P, lds, 0, CV_EARLY, bid * 8 + wave, G * 8, wave, lane, false);
}

__device__ __forceinline__ void phase_norm_mod(const float* src_lat, const float* src_ctx, const float* src_ctx2, int nrows, const float* g, const float* mods, int shift_idx, int scale_idx, bf16_t* U, int gw, int NGW, int lane) {
    for (int m = gw; m < nrows; m += NGW) {
        const float* xrow = (m < M_LAT) ? src_lat + (size_t)m * D : src_ctx + (size_t)(m - M_LAT) * D;
        const int mr = (m < M_LAT) ? (m >> 12) : 4;
        const float* sh = mods + (size_t)mr * NMOD + shift_idx * D; const float* sc = mods + (size_t)mr * NMOD + scale_idx * D;
        f32x4 v[4]; float ss = 0.f;
#pragma unroll
        for (int j = 0; j < 4; ++j) { v[j] = *(const f32x4*)(xrow + 4 * lane + 256 * j); if (src_ctx2 && m >= M_LAT) v[j] = v[j] + *(const f32x4*)(src_ctx2 + (size_t)(m - M_LAT) * D + 4 * lane + 256 * j);
            ss += (v[j][0] * v[j][0] + v[j][1] * v[j][1]) + (v[j][2] * v[j][2] + v[j][3] * v[j][3]); }
        const float rstd = rsqrtf(wave_sum(ss) * (1.f / D) + EPS);
#pragma unroll
        for (int j = 0; j < 4; ++j) { const int col = 4 * lane + 256 * j;
            const f32x4 gv = *(const f32x4*)(g + col), sv = *(const f32x4*)(sc + col), hv = *(const f32x4*)(sh + col);
            const f32x4 y = v[j] * rstd * gv * (sv + 1.f) + hv;
            u32x2 w; w.x = pk2(y[0], y[1]); w.y = pk2(y[2], y[3]); *(u32x2*)(U + (size_t)m * D + col) = w; }
    }
}

constexpr int KP = 132;
__device__ __attribute__((noinline)) void gdn_solve(const LAS float* src, const LAS float* scl, const LAS float* A, bf16_t* dst, int base, int stride) {
    float x[64];
#pragma unroll
    for (int i = 0; i < 64; ++i) x[i] = 0.f;
#pragma unroll
    for (int i = 0; i < 64; ++i) {
        float s0 = src[base + i * stride] * scl[i], s1 = 0.f, s2 = 0.f, s3 = 0.f;
#pragma unroll
        for (int j4 = 0; j4 < (i + 3) / 4; ++j4) { const f32x4 av = *(const LAS f32x4*)(A + i * 64 + 4 * j4);
            s0 -= av[0] * x[4 * j4]; s1 -= av[1] * x[4 * j4 + 1]; s2 -= av[2] * x[4 * j4 + 2]; s3 -= av[3] * x[4 * j4 + 3]; }
        x[i] = (s0 + s1) + (s2 + s3);
        dst[i * 128] = (bf16_t)f2bf(x[i]);
    }
}
__device__ __forceinline__ void gdn_prep_item(const Ptrs& P, unsigned char* lds, int item, int tid, int lane, int wave) {
    const int b = item / (4 * NCH), h = (item / NCH) & 3, cn = item % NCH;
    const bool isctx = cn < 4; const int cl = isctx ? cn : cn - 4, L = isctx ? CTXL : SEQ;
    const int rowbase = isctx ? M_LAT + b * CTXL : b * SEQ;
    const bf16_t* PA = (const bf16_t*)(P.ws + WS_PA); const float* BA = (const float*)(P.ws + WS_BA);
    int lo_ = 0; asm volatile("" : "+v"(lo_));
    float* KF = (float*)(lds + lo_); float* QF = (float*)(lds + lo_ + 33792); float* VF = (float*)(lds + lo_ + 67584);
    float* KKN = (float*)(lds + lo_ + 101376); float* QKN = (float*)(lds + lo_ + 118016);
    float* GS = (float*)(lds + lo_ + 134656);
    float* RB = GS + 128;
    float* RBE = GS + 256;
    float* AD = QF;
    {
        const int c = tid & 127, tg = tid >> 7;
#pragma unroll
        for (int mat = 0; mat < 3; ++mat) {
            const int ch = mat * 512 + h * 128 + c;
            const float w0 = P.gconv[ch], w1 = P.gconv[1536 + ch], w2 = P.gconv[2 * 1536 + ch], w3 = P.gconv[3 * 1536 + ch];
            const int t0 = cl * 64 + tg * 16;
            const bf16_t* src = PA + (size_t)rowbase * 1536 + ch;
            float xm2 = (t0 - 2 >= 0) ? bf2f(src[(size_t)(t0 - 2) * 1536]) : 0.f;
            float xm1 = (t0 - 1 >= 0) ? bf2f(src[(size_t)(t0 - 1) * 1536]) : 0.f;
            float x0 = bf2f(src[(size_t)t0 * 1536]);
            float* dst = (mat == 0 ? QF : (mat == 1 ? KF : VF)) + (tg * 16) * KP + c;
#pragma unroll 4
            for (int i = 0; i < 16; ++i) { const int t = t0 + i; const float xp1 = (t + 1 < L) ? bf2f(src[(size_t)(t + 1) * 1536]) : 0.f;
                const float y = w0 * xm2 + w1 * xm1 + w2 * x0 + w3 * xp1; dst[i * KP] = siluf_(y); xm2 = xm1; xm1 = x0; x0 = xp1; }
        }
    }
    if (tid < 128) {
        const int d = tid >> 6, i = lane, r = d ? 63 - i : i;
        const float* ba = BA + (size_t)(rowbase + cl * 64 + r) * 16;
        const float beta = sigmoidf_(ba[d * 4 + h]);
        float gg = -__expf(P.galog[d * 4 + h]) * softplusf_(ba[(2 + d) * 4 + h] + P.gdtb[d * 4 + h]);
#pragma unroll
        for (int o = 1; o < 64; o <<= 1) { const float t = __shfl_up(gg, o); if (lane >= o) gg += t; }
        GS[d * 64 + i] = gg; RB[d * 64 + i] = beta; RBE[d * 64 + i] = beta * __expf(gg);
        ((float*)(P.ws + WS_GC))[((size_t)((d * 4 + b) * 4 + h) * NCH + cn) * 64 + i] = gg;
    }
    __syncthreads();
    {
        bf16_t* QG = (bf16_t*)(P.ws + WS_QG) + ((size_t)((b * 4 + h) * NCH + cn) * 64) * 128;
        bf16_t* KG = (bf16_t*)(P.ws + WS_KG) + ((size_t)((b * 4 + h) * NCH + cn) * 64) * 128;
#pragma unroll
        for (int tt = 0; tt < 8; ++tt) { const int tok = wave * 8 + tt;
            f32x2 q = *(f32x2*)(QF + tok * KP + 2 * lane), k = *(f32x2*)(KF + tok * KP + 2 * lane);
            const float sq = wave_sum(q[0] * q[0] + q[1] * q[1]), sk = wave_sum(k[0] * k[0] + k[1] * k[1]);
            q = q * (rsqrtf(sq + EPS) * 0.08838834764831845f); k = k * rsqrtf(sk + EPS);
            *(f32x2*)(QF + tok * KP + 2 * lane) = q; *(f32x2*)(KF + tok * KP + 2 * lane) = k;
            *(unsigned*)(QG + tok * 128 + 2 * lane) = pk2(q[0], q[1]); *(unsigned*)(KG + tok * 128 + 2 * lane) = pk2(k[0], k[1]); }
    }
    __syncthreads();
    {
        const int tp = tid & 255, ti = tp >> 4, tj = tp & 15; const float* X = (tid < 256) ? KF : QF; float* OUT = (tid < 256) ? KKN : QKN;
        float acc[4][4];
#pragma unroll
        for (int a = 0; a < 4; ++a)
#pragma unroll
            for (int c = 0; c < 4; ++c) acc[a][c] = 0.f;
#pragma unroll 2
        for (int kq = 0; kq < 32; ++kq) {
            f32x4 av[4], bv[4];
#pragma unroll
            for (int a = 0; a < 4; ++a) { av[a] = *(const f32x4*)(X + (ti + 16 * a) * KP + 4 * kq); bv[a] = *(const f32x4*)(KF + (tj + 16 * a) * KP + 4 * kq); }
#pragma unroll
            for (int a = 0; a < 4; ++a)
#pragma unroll
                for (int c = 0; c < 4; ++c) acc[a][c] += (av[a][0] * bv[c][0] + av[a][1] * bv[c][1]) + (av[a][2] * bv[c][2] + av[a][3] * bv[c][3]);
        }
#pragma unroll
        for (int a = 0; a < 4; ++a)
#pragma unroll
            for (int c = 0; c < 4; ++c) OUT[(ti + 16 * a) * 65 + tj + 16 * c] = acc[a][c];
    }
    __syncthreads();
    {
        const int d = tid >> 8, tp = tid & 255;
        bf16_t* ATT = (bf16_t*)(P.ws + WS_ATT) + ((size_t)((d * 4 + b) * 4 + h) * NCH + cn) * 4096;
#pragma unroll 4
        for (int e = 0; e < 16; ++e) { const int idx = tp + 256 * e, i = idx >> 6, j = idx & 63, ri = d ? 63 - i : i, rj = d ? 63 - j : j;
            const float dec = (i >= j) ? __expf(GS[d * 64 + i] - GS[d * 64 + j]) : 0.f;
            AD[d * 4096 + idx] = (i > j) ? RB[d * 64 + i] * KKN[ri * 65 + rj] * dec : 0.f;
            ATT[idx] = (bf16_t)f2bf(QKN[ri * 65 + rj] * dec); }
    }
    __syncthreads();
    {
        const int d = tid >> 8, c = tid & 255;
        const float* src = (c < 128) ? VF + c : KF + (c - 128); const float* scl = ((c < 128) ? RB : RBE) + d * 64;
        bf16_t* dst = (bf16_t*)(P.ws + (c < 128 ? WS_UB : WS_WB)) + ((size_t)((d * 4 + b) * 4 + h) * NCH + cn) * 64 * 128 + (c & 127);
        int sb_ = d ? 63 * KP : 0, ss_ = d ? -KP : KP; asm volatile("" : "+v"(sb_), "+v"(ss_));
        gdn_solve((const LAS float*)src, (const LAS float*)scl, (const LAS float*)(AD + d * 4096), dst, sb_, ss_);
    }
    __syncthreads();
}

__device__ __forceinline__ int chunk_of(int d, int s) { return d ? (s < 4 ? 3 - s : 67 - (s - 4)) : s; }
constexpr int TP = 272, AP = 144;
__device__ __forceinline__ bf16x8 ldfrag(const unsigned char* base, int row, int pitch, int kbyte) { return *(const bf16x8*)(base + row * pitch + kbyte); }
__device__ __forceinline__ void gdn_scan_item(const Ptrs& P, unsigned char* lds, int item, int tid, int lane, int wave) {
    const int chain = item & 31, slice = item >> 5, d = chain >> 4, b = (chain >> 2) & 3, h = chain & 3, e0 = slice * 32;
    unsigned char* Wl = lds; unsigned char* Ql = lds + 17408; unsigned char* Kl = lds + 34816; unsigned char* ATl = lds + 52224;
    unsigned char* St = lds + 61440; unsigned char* Vt = lds + 70144; unsigned char* Vdt = lds + 74752; float* gcs = (float*)(lds + 79360);
    const bf16_t* WBp = (const bf16_t*)(P.ws + WS_WB) + (size_t)((d * 4 + b) * 4 + h) * NCH * 8192;
    const bf16_t* UBp = (const bf16_t*)(P.ws + WS_UB) + (size_t)((d * 4 + b) * 4 + h) * NCH * 8192;
    const bf16_t* ATp = (const bf16_t*)(P.ws + WS_ATT) + (size_t)((d * 4 + b) * 4 + h) * NCH * 4096;
    const float* GCp = (const float*)(P.ws + WS_GC) + (size_t)((d * 4 + b) * 4 + h) * NCH * 64;
    const bf16_t* QGp = (const bf16_t*)(P.ws + WS_QG) + (size_t)(b * 4 + h) * NCH * 8192;
    const bf16_t* KGp = (const bf16_t*)(P.ws + WS_KG) + (size_t)(b * 4 + h) * NCH * 8192;
    bf16_t* Op = (bf16_t*)(P.ws + (d ? WS_OB : WS_OF));
    const int fr = lane & 15, fq = lane >> 4, mt = wave & 3, nt = wave >> 2;
    for (int i = tid; i < 8704 / 4; i += 512) ((unsigned*)St)[i] = 0u;
    f32x4 Sacc[2] = {(f32x4){0.f, 0.f, 0.f, 0.f}, (f32x4){0.f, 0.f, 0.f, 0.f}};
    u32x4 rw[2], rq[2], rk[2], ra; float rg = 0.f; bf16_t ru[4];
#define SCAN_PREFETCH(s_) do { const int cn_ = chunk_of(d, s_); \
        const u32x4* w4 = (const u32x4*)(WBp + (size_t)cn_ * 8192); const u32x4* q4 = (const u32x4*)(QGp + (size_t)cn_ * 8192); const u32x4* k4 = (const u32x4*)(KGp + (size_t)cn_ * 8192); \
        rw[0] = w4[tid]; rw[1] = w4[tid + 512]; rq[0] = q4[tid]; rq[1] = q4[tid + 512]; rk[0] = k4[tid]; rk[1] = k4[tid + 512]; \
        ra = ((const u32x4*)(ATp + (size_t)cn_ * 4096))[tid]; if (tid < 64) rg = GCp[cn_ * 64 + tid]; \
        { const bf16_t* up_ = UBp + (size_t)cn_ * 8192 + (mt * 16 + fq * 4) * 128 + e0 + nt * 16 + fr; ru[0] = up_[0]; ru[1] = up_[128]; ru[2] = up_[256]; ru[3] = up_[384]; } } while (0)
    SCAN_PREFETCH(0);
    for (int s = 0; s < NCH; ++s) {
        const int cn = chunk_of(d, s); const bool lat = cn >= 4;
#pragma unroll
        for (int i = 0; i < 2; ++i) { const int idx = tid + 512 * i, row = idx >> 4, cc = idx & 15;
            *(u32x4*)(Wl + row * TP + cc * 16) = rw[i]; *(u32x4*)(Ql + row * TP + cc * 16) = rq[i]; *(u32x4*)(Kl + row * TP + cc * 16) = rk[i]; }
        *(u32x4*)(ATl + (tid >> 3) * AP + (tid & 7) * 16) = ra;
        if (tid < 64) gcs[tid] = rg;
        float uv[4];
#pragma unroll
        for (int jj = 0; jj < 4; ++jj) uv[jj] = bf2f(ru[jj]);
        BAR_LDS();
        if (s + 1 < NCH) SCAN_PREFETCH(s + 1);
        const float glast = gcs[63];
        f32x4 acc_a = (f32x4){0.f, 0.f, 0.f, 0.f}, acc_b = (f32x4){0.f, 0.f, 0.f, 0.f};
        { const int qrow = d ? 63 - (mt * 16 + fr) : (mt * 16 + fr);
#pragma unroll
          for (int ks = 0; ks < 4; ++ks) { const bf16x8 bs = ldfrag(St, nt * 16 + fr, TP, ks * 64 + fq * 16);
              const bf16x8 aw = ldfrag(Wl, mt * 16 + fr, TP, ks * 64 + fq * 16);
              acc_a = __builtin_amdgcn_mfma_f32_16x16x32_bf16(aw, bs, acc_a, 0, 0, 0);
              if (lat) { const bf16x8 aq = ldfrag(Ql, qrow, TP, ks * 64 + fq * 16); acc_b = __builtin_amdgcn_mfma_f32_16x16x32_bf16(aq, bs, acc_b, 0, 0, 0); } } }
        { float vn[4], vd[4];
#pragma unroll
          for (int jj = 0; jj < 4; ++jj) { const float gi = gcs[mt * 16 + fq * 4 + jj]; vn[jj] = uv[jj] - acc_a[jj]; vd[jj] = vn[jj] * __expf(glast - gi); acc_b[jj] *= __expf(gi); }
          u32x2 w; w.x = pk2(vn[0], vn[1]); w.y = pk2(vn[2], vn[3]); *(u32x2*)(Vt + (nt * 16 + fr) * AP + (mt * 16 + fq * 4) * 2) = w;
          w.x = pk2(vd[0], vd[1]); w.y = pk2(vd[2], vd[3]); *(u32x2*)(Vdt + (nt * 16 + fr) * AP + (mt * 16 + fq * 4) * 2) = w; }
        BAR_LDS();
        if (lat) {
#pragma unroll
            for (int ks = 0; ks < 2; ++ks) { const bf16x8 aa = ldfrag(ATl, mt * 16 + fr, AP, ks * 64 + fq * 16); const bf16x8 bv = ldfrag(Vt, nt * 16 + fr, AP, ks * 64 + fq * 16);
                acc_b = __builtin_amdgcn_mfma_f32_16x16x32_bf16(aa, bv, acc_b, 0, 0, 0); }
            bf16_t* op = Op + (size_t)(b * SEQ + (cn - 4) * 64) * 512 + h * 128 + e0 + nt * 16 + fr;
#pragma unroll
            for (int jj = 0; jj < 4; ++jj) { const int i = mt * 16 + fq * 4 + jj, tok = d ? 63 - i : i; op[(size_t)tok * 512] = (bf16_t)f2bf(acc_b[jj]); }
        }
        { const float eg = __expf(glast);
          bf16x8 ak[2];
#pragma unroll
          for (int ks = 0; ks < 2; ++ks)
#pragma unroll
              for (int jj = 0; jj < 8; ++jj) { const int i = ks * 32 + fq * 8 + jj, row = d ? 63 - i : i; ak[ks][jj] = (short)*(const bf16_t*)(Kl + row * TP + (16 * wave + fr) * 2); }
#pragma unroll
          for (int n2 = 0; n2 < 2; ++n2) { f32x4 a = Sacc[n2] * eg;
#pragma unroll
              for (int ks = 0; ks < 2; ++ks) { const bf16x8 bv = ldfrag(Vdt, n2 * 16 + fr, AP, ks * 64 + fq * 16); a = __builtin_amdgcn_mfma_f32_16x16x32_bf16(ak[ks], bv, a, 0, 0, 0); }
              Sacc[n2] = a;
              u32x2 w; w.x = pk2(a[0], a[1]); w.y = pk2(a[2], a[3]); *(u32x2*)(St + (n2 * 16 + fr) * TP + (16 * wave + fq * 4) * 2) = w; } }
        BAR_LDS();
    }
#undef SCAN_PREFETCH
}

__device__ __forceinline__ void gdn_prep_phase(const Ptrs& P, unsigned char* lds, int tid, int lane, int wave, int bid, int G) {
    const bf16_t* PA = (const bf16_t*)(P.ws + WS_PA); const float* BA = (const float*)(P.ws + WS_BA);
    unsigned char* RAW = lds;
    float* QF = (float*)lds;
    unsigned char* Kb = lds + 33792;
    unsigned char* ATs = lds;
    unsigned char* NL = lds + 18432;
    unsigned char* TD = lds + 36864;
    float* DG = (float*)(lds + 119040);
    float* KF = (float*)(lds + 51456); float* VF = (float*)(lds + 85248);
    unsigned char* Qb = lds + 119040;
    float* GS = (float*)(lds + 136448); float* RB = GS + 128; float* RBE = GS + 256;
    const int fr = lane & 15, fq = lane >> 4;
    u32x4 pr[7]; float pba0 = 0.f, pba1 = 0.f;
#define PREP_DECODE(it_, b_, h_, cn_) const int b_ = (it_) / (4 * NCH), h_ = ((it_) / NCH) & 3, cn_ = (it_) % NCH;
#define PREP_PREFETCH(it_) do { PREP_DECODE(it_, pb_, ph_, pcn_) const bool pctx_ = pcn_ < 4; const int pcl_ = pctx_ ? pcn_ : pcn_ - 4, pL_ = pctx_ ? CTXL : SEQ, prb_ = pctx_ ? M_LAT + pb_ * CTXL : pb_ * SEQ; \
        _Pragma("unroll") for (int e_ = 0; e_ < 7; ++e_) { const int q_ = tid + 512 * e_, mat_ = q_ / 1072, rem_ = q_ - mat_ * 1072, row_ = rem_ >> 4, t_ = pcl_ * 64 - 2 + row_; \
            pr[e_] = (q_ < 3216 && t_ >= 0 && t_ < pL_) ? *(const u32x4*)(PA + (size_t)(prb_ + t_) * 1536 + mat_ * 512 + ph_ * 128 + (rem_ & 15) * 8) : (u32x4){0u, 0u, 0u, 0u}; } \
        if (tid < 128) { const int d_ = tid >> 6, r_ = d_ ? 63 - lane : lane; const float* ba_ = BA + (size_t)(prb_ + pcl_ * 64 + r_) * 16; pba0 = ba_[d_ * 4 + ph_]; pba1 = ba_[(2 + d_) * 4 + ph_]; } } while (0)
    if (bid < NB * 4 * NCH) PREP_PREFETCH(bid);
    for (int it = bid; it < NB * 4 * NCH; it += G) {
        PREP_DECODE(it, b, h, cn)
        int lo_ = 0; asm volatile("" : "+v"(lo_));
        const int c = tid & 127, tg = tid >> 7;
        float cw[3][4];
#pragma unroll
        for (int mat = 0; mat < 3; ++mat)
#pragma unroll
            for (int k = 0; k < 4; ++k) cw[mat][k] = P.gconv[k * 1536 + mat * 512 + h * 128 + c];
#pragma unroll
        for (int e = 0; e < 7; ++e) { const int q = tid + 512 * e; if (q < 3216) { const int mat = q / 1072, rem = q - mat * 1072; *(u32x4*)(RAW + lo_ + (mat * 67 + (rem >> 4)) * 256 + (rem & 15) * 16) = pr[e]; } }
        const float ba0 = pba0, ba1 = pba1;
        BAR_LDS();
        if (it + G < NB * 4 * NCH) PREP_PREFETCH(it + G);
        if (tid < 128) {
            const int d = tid >> 6, i = lane;
            const float beta = sigmoidf_(ba0);
            float gg = -__expf(P.galog[d * 4 + h]) * softplusf_(ba1 + P.gdtb[d * 4 + h]);
#pragma unroll
            for (int o = 1; o < 64; o <<= 1) { const float t = __shfl_up(gg, o); if (lane >= o) gg += t; }
            GS[lo_ + d * 64 + i] = gg; RB[lo_ + d * 64 + i] = beta; RBE[lo_ + d * 64 + i] = beta * __expf(gg);
            ((float*)(P.ws + WS_GC))[((size_t)((d * 4 + b) * 4 + h) * NCH + cn) * 64 + i] = gg;
        }
        float yq[16];
        {
#pragma unroll
            for (int mat = 0; mat < 3; ++mat) {
                const bf16_t* rp = (const bf16_t*)(RAW + lo_ + (mat * 67 + tg * 16) * 256) + c;
                float xm2 = bf2f(rp[0]), xm1 = bf2f(rp[128]), x0 = bf2f(rp[256]);
#pragma unroll
                for (int i = 0; i < 16; ++i) { const float xp1 = bf2f(rp[(i + 3) * 128]);
                    const float y = siluf_(cw[mat][0] * xm2 + cw[mat][1] * xm1 + cw[mat][2] * x0 + cw[mat][3] * xp1);
                    if (mat == 0) yq[i] = y; else if (mat == 1) KF[lo_ + (tg * 16 + i) * KP + c] = y; else VF[lo_ + (tg * 16 + i) * KP + c] = y;
                    xm2 = xm1; xm1 = x0; x0 = xp1; }
            }
        }
        BAR_LDS();
#pragma unroll
        for (int i = 0; i < 16; ++i) QF[lo_ + (tg * 16 + i) * KP + c] = yq[i];
        BAR_LDS();
        {
            bf16_t* QG = (bf16_t*)(P.ws + WS_QG) + ((size_t)((b * 4 + h) * NCH + cn) * 64) * 128;
            bf16_t* KG = (bf16_t*)(P.ws + WS_KG) + ((size_t)((b * 4 + h) * NCH + cn) * 64) * 128;
#pragma unroll
            for (int tt = 0; tt < 8; ++tt) { const int tok = wave * 8 + tt;
                f32x2 q = *(f32x2*)(QF + lo_ + tok * KP + 2 * lane), k = *(f32x2*)(KF + lo_ + tok * KP + 2 * lane);
                const float sq = wave_sum(q[0] * q[0] + q[1] * q[1]), sk = wave_sum(k[0] * k[0] + k[1] * k[1]);
                q = q * (rsqrtf(sq + EPS) * 0.08838834764831845f); k = k * rsqrtf(sk + EPS);
                *(f32x2*)(KF + lo_ + tok * KP + 2 * lane) = k;
                const unsigned qp = pk2(q[0], q[1]), kp = pk2(k[0], k[1]);
                *(unsigned*)(Qb + lo_ + tok * TP + 4 * lane) = qp; *(unsigned*)(Kb + lo_ + tok * TP + 4 * lane) = kp;
                *(unsigned*)(QG + tok * 128 + 2 * lane) = qp; *(unsigned*)(KG + tok * 128 + 2 * lane) = kp; }
        }
        BAR_LDS();
        const int mi = wave & 3, njp = wave >> 2;
        f32x4 ckk[2], cqk[2];
        ckk[0] = ckk[1] = cqk[0] = cqk[1] = (f32x4){0.f, 0.f, 0.f, 0.f};
#pragma unroll
        for (int ks = 0; ks < 4; ++ks) { const bf16x8 aK = ldfrag(Kb + lo_, mi * 16 + fr, TP, ks * 64 + fq * 16), aQ = ldfrag(Qb + lo_, mi * 16 + fr, TP, ks * 64 + fq * 16);
#pragma unroll
            for (int n2 = 0; n2 < 2; ++n2) { const bf16x8 bK = ldfrag(Kb + lo_, (njp * 2 + n2) * 16 + fr, TP, ks * 64 + fq * 16);
                ckk[n2] = __builtin_amdgcn_mfma_f32_16x16x32_bf16(aK, bK, ckk[n2], 0, 0, 0); cqk[n2] = __builtin_amdgcn_mfma_f32_16x16x32_bf16(aQ, bK, cqk[n2], 0, 0, 0); } }
        BAR_LDS();
#pragma unroll
        for (int n2 = 0; n2 < 2; ++n2)
#pragma unroll
            for (int jj = 0; jj < 4; ++jj) { const int r = mi * 16 + fq * 4 + jj, sc = (njp * 2 + n2) * 16 + fr;
                const float e0 = __expf(GS[lo_ + r] - GS[lo_ + sc]), e1 = __expf(GS[lo_ + 64 + 63 - r] - GS[lo_ + 64 + 63 - sc]);
                const float kkv = ckk[n2][jj], qkv = cqk[n2][jj];
                { const float a0 = (r > sc) ? RB[lo_ + r] * kkv * e0 : 0.f, a1 = (r < sc) ? RB[lo_ + 64 + 63 - r] * kkv * e1 : 0.f; const int r1 = 63 - r, c1 = 63 - sc;
                  *(bf16_t*)(NL + lo_ + r * 144 + sc * 2) = (bf16_t)f2bf(-a0); *(bf16_t*)(NL + lo_ + 9216 + r1 * 144 + c1 * 2) = (bf16_t)f2bf(-a1);
                  if ((r >> 4) == (sc >> 4)) { DG[lo_ + (r >> 4) * 256 + (r & 15) * 16 + (sc & 15)] = a0; DG[lo_ + 1024 + (r1 >> 4) * 256 + (r1 & 15) * 16 + (c1 & 15)] = a1; } }
                *(bf16_t*)(ATs + lo_ + r * 144 + sc * 2) = (bf16_t)f2bf((r >= sc) ? qkv * e0 : 0.f);
                *(bf16_t*)(ATs + lo_ + 9216 + (63 - r) * 144 + (63 - sc) * 2) = (bf16_t)f2bf((r <= sc) ? qkv * e1 : 0.f); }
        BAR_LDS();
#pragma unroll
        for (int e = 0; e < 2; ++e) { const int idx = tid + 512 * e, d = idx >> 9, row = (idx >> 3) & 63, cc = idx & 7;
            bf16_t* ATT = (bf16_t*)(P.ws + WS_ATT) + ((size_t)((d * 4 + b) * 4 + h) * NCH + cn) * 4096;
            *(u32x4*)(ATT + row * 64 + cc * 8) = *(const u32x4*)(ATs + lo_ + d * 9216 + row * 144 + cc * 16); }
        if (tid < 128) { const int d = tid >> 6, ii = (tid >> 4) & 3, c2 = tid & 15; const float* Lb = DG + lo_ + d * 1024 + ii * 256;
            float x[16];
#pragma unroll
            for (int r = 0; r < 16; ++r) { float sv = (r == c2) ? 1.f : 0.f;
#pragma unroll
                for (int j = 0; j < r; ++j) sv -= Lb[r * 16 + j] * x[j];
                x[r] = sv; *(bf16_t*)(TD + lo_ + d * 5120 + (ii * 16 + r) * 80 + c2 * 2) = (bf16_t)f2bf(sv); *(bf16_t*)(TD + lo_ + d * 5120 + (ii * 16 + r) * 80 + (16 + c2) * 2) = (bf16_t)0; } }
        BAR_LDS();
        {
            const int d = wave >> 2;
            unsigned char* XT = lds + lo_ + (wave < 4 ? 127232 + wave * 2304 : 137984 + (wave - 4) * 2304);
            const unsigned char* NLd = NL + lo_ + d * 9216; const unsigned char* TDd = TD + lo_ + d * 5120;
            const float* rb = RB + lo_ + d * 64; const float* rbe = RBE + lo_ + d * 64;
            for (int t4 = 0; t4 < 4; ++t4) {
                const int tile = (wave & 3) * 4 + t4, cc = tile * 16 + fr;
                const float* src = (cc < 128) ? VF + lo_ + cc : KF + lo_ + (cc - 128); const float* scl = (cc < 128) ? rb : rbe;
                bf16_t* dst = (bf16_t*)(P.ws + (cc < 128 ? WS_UB : WS_WB)) + ((size_t)((d * 4 + b) * 4 + h) * NCH + cn) * 64 * 128 + (cc & 127);
                { u32x4 z4 = (u32x4){0u, 0u, 0u, 0u}; *(u32x4*)(XT + lane * 16) = z4; *(u32x4*)(XT + 1024 + lane * 16) = z4; if (lane < 16) *(u32x4*)(XT + 2048 + lane * 16) = z4; }
                asm volatile("s_waitcnt lgkmcnt(0)" ::: "memory");
#pragma unroll
                for (int i = 0; i < 4; ++i) {
                    f32x4 acc;
#pragma unroll
                    for (int jj = 0; jj < 4; ++jj) { const int ip = i * 16 + fq * 4 + jj, ri = d ? 63 - ip : ip; acc[jj] = src[ri * KP] * scl[ip]; }
#pragma unroll
                    for (int p = 0; p < (i + 1) / 2; ++p) { const bf16x8 a = ldfrag(NLd, i * 16 + fr, 144, p * 64 + fq * 16), bb = ldfrag(XT, fr, 144, p * 64 + fq * 16);
                        acc = __builtin_amdgcn_mfma_f32_16x16x32_bf16(a, bb, acc, 0, 0, 0); }
                    { u32x2 w2; w2.x = pk2(acc[0], acc[1]); w2.y = pk2(acc[2], acc[3]); *(u32x2*)(XT + fr * 144 + (i * 16 + fq * 4) * 2) = w2; }
                    asm volatile("s_waitcnt lgkmcnt(0)" ::: "memory");
                    bf16x8 yb = ldfrag(XT, fr, 144, i * 32 + (fq & 1) * 16);
                    if (fq >= 2) yb = (bf16x8){0, 0, 0, 0, 0, 0, 0, 0};
                    const bf16x8 ta = ldfrag(TDd, i * 16 + fr, 80, fq * 16);
                    const f32x4 xv = __builtin_amdgcn_mfma_f32_16x16x32_bf16(ta, yb, (f32x4){0.f, 0.f, 0.f, 0.f}, 0, 0, 0);
                    { u32x2 w2; w2.x = pk2(xv[0], xv[1]); w2.y = pk2(xv[2], xv[3]); *(u32x2*)(XT + fr * 144 + (i * 16 + fq * 4) * 2) = w2; }
#pragma unroll
                    for (int jj = 0; jj < 4; ++jj) dst[(i * 16 + fq * 4 + jj) * 128] = (bf16_t)f2bf(xv[jj]);
                    asm volatile("s_waitcnt lgkmcnt(0)" ::: "memory");
                }
            }
        }
        BAR_LDS();
    }
#undef PREP_DECODE
#undef PREP_PREFETCH
}

template <int MODE>
__device__ __forceinline__ void lru_item(const Ptrs& P, unsigned char* lds, int b, int cn, int nb, int tid, int lane, int wave) {
    const bool isctx = cn < 4; const int cl = isctx ? cn : cn - 4, L = isctx ? CTXL : SEQ, s0 = cl * 64;
    const bf16_t* PB = (const bf16_t*)(P.ws + WS_PB);
    float* xin = (float*)lds;
    float* xT = (float*)(lds + 17408);
    float* wg = (float*)(lds + 34816);
    f32x2* seg = (f32x2*)(lds + 100352);
#define rowof(s_) (isctx ? (size_t)(M_LAT + b * CTXL + (s_)) : (size_t)(b * SEQ + ((s_) & 63) * 64 + ((s_) >> 6)))
    for (int idx = tid; idx < 67 * 64; idx += 512) { const int si = idx >> 6, c = idx & 63, s = s0 - 2 + si;
        xin[idx] = (s >= 0 && s < L) ? bf2f(PB[rowof(s) * 1536 + 512 + nb * 64 + c]) : 0.f; }
    for (int idx = tid; idx < 4 * 4096; idx += 512) { const int dg = idx >> 12; wg[idx] = P.lwg[((size_t)dg * 8 + nb) * 4096 + (idx & 4095)]; }
    __syncthreads();
    { const int c = tid & 63, ig = tid >> 6, ch = nb * 64 + c;
      const float w0 = P.lconv[ch], w1 = P.lconv[512 + ch], w2 = P.lconv[1024 + ch], w3 = P.lconv[1536 + ch], bias = P.lconvb[ch];
#pragma unroll
      for (int ii = 0; ii < 8; ++ii) { const int i = ig * 8 + ii; xT[c * 68 + i] = bias + w0 * xin[i * 64 + c] + w1 * xin[(i + 1) * 64 + c] + w2 * xin[(i + 2) * 64 + c] + w3 * xin[(i + 3) * 64 + c]; } }
    __syncthreads();
    const int co = tid & 63, ig = tid >> 6, ch = nb * 64 + co;
    float acc[4][8];
#pragma unroll
    for (int q = 0; q < 4; ++q)
#pragma unroll
        for (int ii = 0; ii < 8; ++ii) acc[q][ii] = 0.f;
#pragma unroll 4
    for (int ci = 0; ci < 64; ++ci) { const f32x4 xa = *(const f32x4*)(xT + ci * 68 + ig * 8), xb = *(const f32x4*)(xT + ci * 68 + ig * 8 + 4);
        float wv[4];
#pragma unroll
        for (int q = 0; q < 4; ++q) wv[q] = wg[q * 4096 + ci * 64 + co];
#pragma unroll
        for (int q = 0; q < 4; ++q) {
#pragma unroll
            for (int ii = 0; ii < 4; ++ii) { acc[q][ii] += wv[q] * xa[ii]; acc[q][ii + 4] += wv[q] * xb[ii]; } } }
    float av[2][8], bv[2][8];
#pragma unroll
    for (int d = 0; d < 2; ++d) { const float bgr = P.lbg[(d * 2 + 0) * 512 + ch], bgi = P.lbg[(d * 2 + 1) * 512 + ch], sp = softplusf_(-P.llam[d * 512 + ch]);
#pragma unroll
        for (int ii = 0; ii < 8; ++ii) { const int i = ig * 8 + ii; const float xv = xT[co * 68 + i];
            const float r = sigmoidf_(acc[d * 2][ii] + bgr), ing = sigmoidf_(acc[d * 2 + 1][ii] + bgi), la = -8.f * sp * r;
            float mult = sqrtf(-expm1f(2.f * la));
            if (isctx && ((d == 0 && cn == 0 && i == 0) || (d == 1 && cn == 3 && i == 63))) mult = 1.f;
            av[d][ii] = __expf(la); bv[d][ii] = mult * ing * xv; } }
    { float A0 = 1.f, B0 = 0.f, A1 = 1.f, B1 = 0.f;
#pragma unroll
      for (int ii = 0; ii < 8; ++ii) { B0 = av[0][ii] * B0 + bv[0][ii]; A0 *= av[0][ii]; B1 = av[1][7 - ii] * B1 + bv[1][7 - ii]; A1 *= av[1][7 - ii]; }
      seg[(ig * 2 + 0) * 64 + co] = (f32x2){A0, B0}; seg[(ig * 2 + 1) * 64 + co] = (f32x2){A1, B1}; }
    __syncthreads();
    if constexpr (MODE == 0) {
        if (tid < 128) { const int d = tid >> 6; float At = 1.f, Bt = 0.f;
#pragma unroll
            for (int k = 0; k < 8; ++k) { const int sg = d ? 7 - k : k; const f32x2 v = seg[(sg * 2 + d) * 64 + co]; Bt = v[0] * Bt + v[1]; At *= v[0]; }
            ((f32x2*)(P.ws + WS_LSUM))[((size_t)(b * 2 + d) * NCH + cn) * 512 + ch] = (f32x2){At, Bt}; }
    } else {
        const float* CAR = (const float*)(P.ws + WS_LCAR);
        float hf = CAR[((size_t)(b * 2 + 0) * NCH + cn) * 512 + ch], hb = CAR[((size_t)(b * 2 + 1) * NCH + cn) * 512 + ch];
        for (int k = 0; k < ig; ++k) { const f32x2 v = seg[(k * 2 + 0) * 64 + co]; hf = v[0] * hf + v[1]; }
        for (int k = 7; k > ig; --k) { const f32x2 v = seg[(k * 2 + 1) * 64 + co]; hb = v[0] * hb + v[1]; }
        float o[8];
#pragma unroll
        for (int ii = 0; ii < 8; ++ii) { hf = av[0][ii] * hf + bv[0][ii]; o[ii] = hf; }
#pragma unroll
        for (int ii = 7; ii >= 0; --ii) { hb = av[1][ii] * hb + bv[1][ii]; o[ii] += hb; }
        bf16_t* MIX = (bf16_t*)(P.ws + WS_MIX);
#pragma unroll
        for (int ii = 0; ii < 8; ++ii) { const size_t row = rowof(s0 + ig * 8 + ii); const float gt = bf2f(PB[row * 1536 + 1024 + ch]);
            MIX[row * D + 512 + ch] = (bf16_t)f2bf(o[ii] * geluf_(gt)); }
    }
    __syncthreads();
#undef rowof
}
template <int MODE>
__device__ __forceinline__ void lru_phase(const Ptrs& P, unsigned char* lds, int tid, int lane, int wave, int nb, int slot, int nslots) {
    const bf16_t* PB = (const bf16_t*)(P.ws + WS_PB);
    unsigned char* Wt = lds;
    float* xin = (float*)(lds + 36864);
    unsigned char* xb = lds + 54016;
    float* xc = (float*)(lds + 63232);
    f32x2* seg = (f32x2*)(lds + 80640);
    unsigned char* gtl = lds + 97024;
    unsigned char* otl = lds + 106240;
    for (int idx = tid; idx < 4 * 4096; idx += 512) { const int dg = idx >> 12, ci = (idx >> 6) & 63, co = idx & 63;
        *(bf16_t*)(Wt + dg * 9216 + co * 144 + ci * 2) = (bf16_t)f2bf(P.lwg[((size_t)dg * 8 + nb) * 4096 + (idx & 4095)]); }
    const int fr = lane & 15, fq = lane >> 4, nt = wave & 3, mh = wave >> 2;
    const int cch = nb * 64 + (tid & 63);
    const float cw0 = P.lconv[cch], cw1 = P.lconv[512 + cch], cw2 = P.lconv[1024 + cch], cw3 = P.lconv[1536 + cch], cbias = P.lconvb[cch];
    const int co = nt * 16 + fr, ch = nb * 64 + co;
    float bgr[2], bgi[2], sp[2];
#pragma unroll
    for (int d = 0; d < 2; ++d) { bgr[d] = P.lbg[(d * 2 + 0) * 512 + ch]; bgi[d] = P.lbg[(d * 2 + 1) * 512 + ch]; sp[d] = -8.f * softplusf_(-P.llam[d * 512 + ch]); }
    const int nitems = (MODE == 0) ? NB * NCH : NB * 64;
    u32x4 px[2], pg; px[0] = px[1] = pg = (u32x4){0u, 0u, 0u, 0u};
#define LRU_DECODE(j_, b_, cn_) const int b_ = (MODE == 0) ? (j_) / NCH : (j_) >> 6; const int cn_ = (MODE == 0) ? (j_) % NCH : 4 + ((j_) & 63);
#define LRU_ROW(b_, cn_, s_) ((cn_) < 4 ? (size_t)(M_LAT + (b_) * CTXL + (s_)) : (size_t)((b_) * SEQ + ((s_) & 63) * 64 + ((s_) >> 6)))
#define LRU_PREFETCH(j_) do { LRU_DECODE(j_, pb_, pcn_) const int pL_ = pcn_ < 4 ? CTXL : SEQ, ps0_ = (pcn_ < 4 ? pcn_ : pcn_ - 4) * 64; \
        _Pragma("unroll") for (int e_ = 0; e_ < 2; ++e_) { const int q_ = tid + 512 * e_, si_ = q_ >> 3, s_ = ps0_ - 2 + si_; \
            px[e_] = (q_ < 536 && s_ >= 0 && s_ < pL_) ? *(const u32x4*)(PB + LRU_ROW(pb_, pcn_, s_) * 1536 + 512 + nb * 64 + (q_ & 7) * 8) : (u32x4){0u, 0u, 0u, 0u}; } \
        if (MODE == 1) { const int i_ = tid >> 3; pg = *(const u32x4*)(PB + LRU_ROW(pb_, pcn_, ps0_ + i_) * 1536 + 1024 + nb * 64 + (tid & 7) * 8); } } while (0)
    if (slot < nitems) LRU_PREFETCH(slot);
    BAR_LDS();
    for (int j = slot; j < nitems; j += nslots) {
        LRU_DECODE(j, b, cn)
        const bool isctx = cn < 4; const int s0 = (isctx ? cn : cn - 4) * 64;
#pragma unroll
        for (int e = 0; e < 2; ++e) { const int q = tid + 512 * e; if (q < 536) { float* dst = xin + (q >> 3) * 64 + (q & 7) * 8;
#pragma unroll
            for (int k = 0; k < 4; ++k) { dst[2 * k] = bf2f(px[e][k] & 0xffffu); dst[2 * k + 1] = bf2f(px[e][k] >> 16); } } }
        if (MODE == 1) *(u32x4*)(gtl + (tid >> 3) * 144 + (tid & 7) * 16) = pg;
        BAR_LDS();
        if (j + nslots < nitems) LRU_PREFETCH(j + nslots);
        { const int c = tid & 63, ig = tid >> 6;
#pragma unroll
          for (int ii = 0; ii < 8; ++ii) { const int i = ig * 8 + ii; const float v = cbias + cw0 * xin[i * 64 + c] + cw1 * xin[(i + 1) * 64 + c] + cw2 * xin[(i + 2) * 64 + c] + cw3 * xin[(i + 3) * 64 + c];
              xc[i * 68 + c] = v; *(bf16_t*)(xb + i * 144 + c * 2) = (bf16_t)f2bf(v); } }
        BAR_LDS();
        f32x4 acc[2][4];
#pragma unroll
        for (int m2 = 0; m2 < 2; ++m2)
#pragma unroll
            for (int dg = 0; dg < 4; ++dg) acc[m2][dg] = (f32x4){0.f, 0.f, 0.f, 0.f};
#pragma unroll
        for (int ks = 0; ks < 2; ++ks) { bf16x8 af[2];
#pragma unroll
            for (int m2 = 0; m2 < 2; ++m2) af[m2] = ldfrag(xb, (mh * 2 + m2) * 16 + fr, 144, ks * 64 + fq * 16);
#pragma unroll
            for (int dg = 0; dg < 4; ++dg) { const bf16x8 bfr = ldfrag(Wt + dg * 9216, nt * 16 + fr, 144, ks * 64 + fq * 16);
#pragma unroll
                for (int m2 = 0; m2 < 2; ++m2) acc[m2][dg] = __builtin_amdgcn_mfma_f32_16x16x32_bf16(af[m2], bfr, acc[m2][dg], 0, 0, 0); } }
        float av[2][2][4], bv[2][2][4];
#pragma unroll
        for (int m2 = 0; m2 < 2; ++m2)
#pragma unroll
            for (int jj = 0; jj < 4; ++jj) { const int i = (mh * 2 + m2) * 16 + fq * 4 + jj; const float xv = xc[i * 68 + co];
#pragma unroll
                for (int d = 0; d < 2; ++d) { const float r = sigmoidf_(acc[m2][d * 2][jj] + bgr[d]), ing = sigmoidf_(acc[m2][d * 2 + 1][jj] + bgi[d]), la = sp[d] * r;
                    const float aa = __expf(la);
                    float mult = __builtin_amdgcn_sqrtf(fmaxf(1.f - aa * aa, 0.f));
                    if (isctx && ((d == 0 && cn == 0 && i == 0) || (d == 1 && cn == 3 && i == 63))) mult = 1.f;
                    av[d][m2][jj] = aa; bv[d][m2][jj] = mult * ing * xv; } }
#pragma unroll
        for (int m2 = 0; m2 < 2; ++m2) { const int sg = (mh * 2 + m2) * 4 + fq; float A0 = 1.f, B0 = 0.f, A1 = 1.f, B1 = 0.f;
#pragma unroll
            for (int jj = 0; jj < 4; ++jj) { B0 = av[0][m2][jj] * B0 + bv[0][m2][jj]; A0 *= av[0][m2][jj]; B1 = av[1][m2][3 - jj] * B1 + bv[1][m2][3 - jj]; A1 *= av[1][m2][3 - jj]; }
            seg[(sg * 2 + 0) * 64 + co] = (f32x2){A0, B0}; seg[(sg * 2 + 1) * 64 + co] = (f32x2){A1, B1}; }
        BAR_LDS();
        if constexpr (MODE == 0) {
            if (tid < 128) { const int d = tid >> 6, c2 = tid & 63; float At = 1.f, Bt = 0.f;
#pragma unroll
                for (int k = 0; k < 16; ++k) { const int sg = d ? 15 - k : k; const f32x2 v = seg[(sg * 2 + d) * 64 + c2]; Bt = v[0] * Bt + v[1]; At *= v[0]; }
                ((f32x2*)(P.ws + WS_LSUM))[((size_t)(b * 2 + d) * NCH + cn) * 512 + nb * 64 + c2] = (f32x2){At, Bt}; }
        } else {
            const float* CAR = (const float*)(P.ws + WS_LCAR);
            float hf = CAR[((size_t)(b * 2 + 0) * NCH + cn) * 512 + ch], hb = CAR[((size_t)(b * 2 + 1) * NCH + cn) * 512 + ch];
            const int sg0 = (mh * 2) * 4 + fq;
            for (int k = 0; k < sg0; ++k) { const f32x2 v = seg[(k * 2 + 0) * 64 + co]; hf = v[0] * hf + v[1]; }
            for (int k = 15; k > sg0 + 4; --k) { const f32x2 v = seg[(k * 2 + 1) * 64 + co]; hb = v[0] * hb + v[1]; }
            float o[2][4];
#pragma unroll
            for (int jj = 0; jj < 4; ++jj) { hf = av[0][0][jj] * hf + bv[0][0][jj]; o[0][jj] = hf; }
#pragma unroll
            for (int k = 1; k < 4; ++k) { const f32x2 v = seg[((sg0 + k) * 2 + 0) * 64 + co]; hf = v[0] * hf + v[1]; }
#pragma unroll
            for (int jj = 0; jj < 4; ++jj) { hf = av[0][1][jj] * hf + bv[0][1][jj]; o[1][jj] = hf; }
#pragma unroll
            for (int jj = 3; jj >= 0; --jj) { hb = av[1][1][jj] * hb + bv[1][1][jj]; o[1][jj] += hb; }
#pragma unroll
            for (int k = 3; k >= 1; --k) { const f32x2 v = seg[((sg0 + k) * 2 + 1) * 64 + co]; hb = v[0] * hb + v[1]; }
#pragma unroll
            for (int jj = 3; jj >= 0; --jj) { hb = av[1][0][jj] * hb + bv[1][0][jj]; o[0][jj] += hb; }
#pragma unroll
            for (int m2 = 0; m2 < 2; ++m2)
#pragma unroll
                for (int jj = 0; jj < 4; ++jj) { const int i = (mh * 2 + m2) * 16 + fq * 4 + jj; const float gt = bf2f(*(const bf16_t*)(gtl + i * 144 + co * 2));
                    *(bf16_t*)(otl + i * 144 + co * 2) = (bf16_t)f2bf(o[m2][jj] * geluf_(gt)); }
            BAR_LDS();
            { const int i = tid >> 3; bf16_t* PBw = (bf16_t*)(P.ws + WS_PB);
              *(u32x4*)(PBw + LRU_ROW(b, cn, s0 + i) * 1536 + 1024 + nb * 64 + (tid & 7) * 8) = *(const u32x4*)(otl + i * 144 + (tid & 7) * 16); }
        }
        BAR_LDS();
    }
#undef LRU_DECODE
#undef LRU_ROW
#undef LRU_PREFETCH
}
__device__ __forceinline__ void lru_carry(const Ptrs& P, int gt) {
    const int b = gt >> 10, d = (gt >> 9) & 1, ch = gt & 511;
    const f32x2* SUM = (const f32x2*)(P.ws + WS_LSUM) + (size_t)(b * 2 + d) * NCH * 512 + ch; float* CAR = (float*)(P.ws + WS_LCAR) + (size_t)(b * 2 + d) * NCH * 512 + ch;
    float carry = 0.f;
    for (int s0 = 0; s0 < NCH; s0 += 17) {
        f32x2 v[17];
#pragma unroll
        for (int k = 0; k < 17; ++k) v[k] = SUM[(size_t)chunk_of(d, s0 + k) * 512];
#pragma unroll
        for (int k = 0; k < 17; ++k) { CAR[(size_t)chunk_of(d, s0 + k) * 512] = carry; carry = v[k][0] * carry + v[k][1]; }
    }
}

__device__ __forceinline__ void gdn_combine(const Ptrs& P, int gw, int NGW, int lane) {
    const bf16_t* OF = (const bf16_t*)(P.ws + WS_OF); const bf16_t* OB = (const bf16_t*)(P.ws + WS_OB); const bf16_t* PB = (const bf16_t*)(P.ws + WS_PB); bf16_t* MIX = (bf16_t*)(P.ws + WS_MIX);
    float nw[8];
#pragma unroll
    for (int j = 0; j < 8; ++j) nw[j] = P.gnormw[(lane * 8 + j) & 127];
    for (int m = gw; m < M_LAT; m += NGW) {
        const u32x4 a = *(const u32x4*)(OF + (size_t)m * 512 + lane * 8), c = *(const u32x4*)(OB + (size_t)m * 512 + lane * 8), z = *(const u32x4*)(PB + (size_t)m * 1536 + lane * 8);
        float o[8], zz[8]; float ss = 0.f;
#pragma unroll
        for (int j = 0; j < 4; ++j) { o[2 * j] = bf2f(a[j] & 0xffffu) + bf2f(c[j] & 0xffffu); o[2 * j + 1] = bf2f(a[j] >> 16) + bf2f(c[j] >> 16); zz[2 * j] = bf2f(z[j] & 0xffffu); zz[2 * j + 1] = bf2f(z[j] >> 16); }
#pragma unroll
        for (int j = 0; j < 8; ++j) ss += o[j] * o[j];
        ss += __shfl_xor(ss, 1); ss += __shfl_xor(ss, 2); ss += __shfl_xor(ss, 4); ss += __shfl_xor(ss, 8);
        const float rs = rsqrtf(ss * (1.f / 128.f) + EPS);
        u32x4 w;
        w.x = pk2(o[0] * rs * nw[0] * siluf_(zz[0]), o[1] * rs * nw[1] * siluf_(zz[1])); w.y = pk2(o[2] * rs * nw[2] * siluf_(zz[2]), o[3] * rs * nw[3] * siluf_(zz[3]));
        w.z = pk2(o[4] * rs * nw[4] * siluf_(zz[4]), o[5] * rs * nw[5] * siluf_(zz[5])); w.w = pk2(o[6] * rs * nw[6] * siluf_(zz[6]), o[7] * rs * nw[7] * siluf_(zz[7]));
        *(u32x4*)(MIX + (size_t)m * D + lane * 8) = w;
        *(u32x4*)(MIX + (size_t)m * D + 512 + lane * 8) = *(const u32x4*)(PB + (size_t)m * 1536 + 1024 + lane * 8);
    }
}

#define RLX_AGENT __ATOMIC_RELAXED, __HIP_MEMORY_SCOPE_AGENT
#define XB_TMO      128
#define XB_XCNT(j)  (256  + 64 * (j))
#define XB_XSUB(j)  (1280 + 64 * (j))
#define XB_XGEN(j)  (2304 + 64 * (j))
#define XB_TOP      3328
#define XB_TOPGEN   3392
#define XCD_BAR_WORDS 3456
#define XB_SPIN_CAP (1u << 18)

__device__ __forceinline__ unsigned xb_ld(unsigned* p)              { return __hip_atomic_load(p, __ATOMIC_RELAXED, __HIP_MEMORY_SCOPE_AGENT); }
__device__ __forceinline__ unsigned xb_add(unsigned* p, unsigned v) { return __hip_atomic_fetch_add(p, v, __ATOMIC_RELAXED, __HIP_MEMORY_SCOPE_AGENT); }
__device__ __forceinline__ unsigned xb_xcc_id() { return (unsigned)__builtin_amdgcn_s_getreg((3 << 11) | 20) & 0xFu; }
#define XB_SPIN(cond, bar) do { unsigned _sp = 0; while (cond) { __builtin_amdgcn_s_sleep(1); \
    if ((++_sp & 255u) == 0u) { if (xb_ld(&(bar)[XB_TMO])) break; if (_sp > XB_SPIN_CAP) { atomicAdd(&(bar)[XB_TMO], 1u); break; } } } } while (0)

struct XcdBarrier {
    unsigned* bar; unsigned x;
    volatile LAS unsigned* st;
};

__device__ __forceinline__ XcdBarrier xcd_barrier_post(unsigned* bar, volatile LAS unsigned* st) {
    XcdBarrier b; b.bar = bar; b.x = xb_xcc_id(); b.st = st;
    if (threadIdx.x == 0) (void)xb_add(&bar[XB_XCNT(b.x)], 1u);
    return b;
}
__device__ __forceinline__ void xcd_barrier_complete(unsigned* bar, unsigned x, unsigned& nloc, unsigned& nx) {
    const unsigned G = gridDim.x * gridDim.y * gridDim.z;
    unsigned sum, cnt, mine, sp = 0u;
    for (;;) {
        sum = 0u; cnt = 0u; mine = 0u;
#pragma unroll
        for (unsigned j = 0; j < 16; ++j) { const unsigned c = xb_ld(&bar[XB_XCNT(j)]); sum += c; cnt += (c > 0u) ? 1u : 0u; mine = (j == x) ? c : mine; }
        if (sum == G) break;
        __builtin_amdgcn_s_sleep(1);
        if ((++sp & 255u) == 0u) { if (xb_ld(&bar[XB_TMO])) break; if (sp > XB_SPIN_CAP) { atomicAdd(&bar[XB_TMO], 1u); break; } }
    }
    nloc = mine > 0u ? mine : 1u; nx = cnt > 0u ? cnt : 1u;
}

__device__ __forceinline__ void xcd_barrier(const XcdBarrier& b) {
    asm volatile("s_waitcnt vmcnt(0)" ::: "memory");
    __syncthreads();
    if (threadIdx.x == 0) {
        unsigned* bar = b.bar;
        __builtin_amdgcn_s_waitcnt(0);
        unsigned nloc = b.st[0], nx = b.st[1];
        if (nloc == 0u) { xcd_barrier_complete(bar, b.x, nloc, nx); b.st[0] = nloc; b.st[1] = nx; }
        const unsigned old = xb_add(&bar[XB_XSUB(b.x)], 1u);
        const unsigned gen = old / nloc;
        if (old + 1u == (gen + 1u) * nloc) {
            __builtin_amdgcn_fence(__ATOMIC_RELEASE, "agent");
            asm volatile("s_waitcnt vmcnt(0)" ::: "memory");
            const unsigned og = xb_add(&bar[XB_TOP], 1u);
            const unsigned tg = og / nx;
            if (og + 1u == (tg + 1u) * nx) xb_add(&bar[XB_TOPGEN], 1u);
            else XB_SPIN(xb_ld(&bar[XB_TOPGEN]) == tg, bar);
            __builtin_amdgcn_fence(__ATOMIC_ACQUIRE, "agent");
            xb_add(&bar[XB_XGEN(b.x)], 1u);
            asm volatile("s_waitcnt vmcnt(0)" ::: "memory");
        } else {
            XB_SPIN(xb_ld(&bar[XB_XGEN(b.x)]) == gen, bar);
            __builtin_amdgcn_fence(__ATOMIC_ACQUIRE, "agent");
            asm volatile("s_waitcnt vmcnt(0)" ::: "memory");
        }
    }
    __syncthreads();
}


__device__ __forceinline__ void sub_barrier(unsigned* cnt, unsigned target) {
    asm volatile("s_waitcnt vmcnt(0)" ::: "memory");
    __syncthreads();
    if (threadIdx.x == 0) {
        __builtin_amdgcn_fence(__ATOMIC_RELEASE, "agent");
        asm volatile("s_waitcnt vmcnt(0)" ::: "memory");
        (void)__hip_atomic_fetch_add(cnt, 1u, __ATOMIC_RELAXED, __HIP_MEMORY_SCOPE_AGENT);
        unsigned sp = 0u;
        while (__hip_atomic_load(cnt, __ATOMIC_RELAXED, __HIP_MEMORY_SCOPE_AGENT) < target) { __builtin_amdgcn_s_sleep(1); if (++sp > (1u << 22)) break; }
        __builtin_amdgcn_fence(__ATOMIC_ACQUIRE, "agent");
        asm volatile("s_waitcnt vmcnt(0)" ::: "memory");
    }
    __syncthreads();
}

struct Args { const float* in[22]; float* out; unsigned char* ws; int ph_lo, ph_hi; };
constexpr int N_PHASES = 14;

__global__ void __launch_bounds__(512, 2) fwd_kernel(Args args) {
    extern __shared__ __attribute__((aligned(16))) unsigned char lds[];
    const int tid = threadIdx.x, lane = tid & 63, wave = __builtin_amdgcn_readfirstlane(tid >> 6);
    const int G = gridDim.x, bid = blockIdx.x, gw = bid * 8 + wave, NGW = G * 8;
    Ptrs P;
    P.x = args.in[0]; P.c = args.in[1]; P.ctx = args.in[2]; P.cctx = args.in[3]; P.w_ada = args.in[4]; P.b_ada = args.in[5]; P.norm_g = args.in[6];
    P.w1 = args.in[7]; P.w3 = args.in[8]; P.w2 = args.in[9]; P.w_in = args.in[10]; P.w_out = args.in[11]; P.gconv = args.in[12]; P.galog = args.in[13]; P.gdtb = args.in[14];
    P.gnormw = args.in[15]; P.lconv = args.in[16]; P.lconvb = args.in[17]; P.lwg = args.in[18]; P.lbg = args.in[19]; P.llam = args.in[20]; P.fng = args.in[21];
    P.out = args.out; P.ws = args.ws;
    unsigned char* ws = args.ws;
    const float* mods = (const float*)(ws + WS_MODS);
    bf16_t* U = (bf16_t*)(ws + WS_U); bf16_t* HID = (bf16_t*)(ws + WS_HID); float* H1CTX = (float*)(ws + WS_H1CTX); float* H1CTX2 = (float*)(ws + WS_H1CTX2);
    LAS unsigned char* ldsl = (LAS unsigned char*)lds;
    const int lo = args.ph_lo, hi = args.ph_hi;
#ifndef REP_MASK
#define REP_MASK 0
#endif
#ifndef SKIP_MASK
#define SKIP_MASK 0
#endif
#define IN(k) (!((SKIP_MASK >> (k)) & 1) && lo <= (k) && (k) < hi)
#define SEAM(k) do { if (IN(k) && IN((k) + 1)) { xcd_barrier(bar); } } while (0)
    volatile LAS unsigned* MISC = (volatile LAS unsigned*)(ldsl + LDS_BYTES - 64);
    if (tid == 0) { MISC[0] = 0u; MISC[1] = 0u; }
    __syncthreads();
    XcdBarrier bar = xcd_barrier_post((unsigned*)ws + 4096, MISC);

    if (hi > N_PHASES) cg::this_grid().sync();
    if (IN(0)) for (int rep_ = 0; rep_ < 1 + ((REP_MASK >> 0) & 1); ++rep_) { if (rep_) __syncthreads(); phase_prologue(P, lds, tid, lane, wave, bid, G); } SEAM(0);
    if (IN(1)) for (int rep_ = 0; rep_ < 1 + ((REP_MASK >> 1) & 1); ++rep_) { if (rep_) __syncthreads(); phase_norm_mod(P.x, P.ctx, nullptr, M_TOT, P.norm_g, mods, 0, 1, U, gw, NGW, lane); } SEAM(1);
    if (IN(2)) for (int rep_ = 0; rep_ < 1 + ((REP_MASK >> 2) & 1); ++rep_) { if (rep_) __syncthreads(); pg8::Gemm g{U, (const bf16_t*)(ws + WS_W1A), M_TOT, 2 * FF, D, D, (D) / 64}; pg8::StaticOrder S; S.init(M_TOT, 2 * FF, G, bid); pg8::EpiSwiglu E{HID};
        pg8::gemm_phase<pg8::EpiSwiglu, true, pg8::StaticOrder>(ldsl, g, S, E); } SEAM(2);
    if (IN(3)) for (int rep_ = 0; rep_ < 1 + ((REP_MASK >> 3) & 1); ++rep_) { if (rep_) __syncthreads();
        { pg8::Gemm g{HID, (const bf16_t*)(ws + WS_W2A), M_LAT, D, FF, FF, FF / 64}; pg8::StaticOrder S; S.init(M_LAT, D, G, bid);
          pg8::EpiRes E{P.x, P.ctx, P.out, H1CTX, mods + 2 * D, 0.5f}; pg8::gemm_phase<pg8::EpiRes, true, pg8::StaticOrder>(ldsl, g, S, E); }
        __syncthreads();
        if (bid < 32) {
            pg8::Gemm g{HID + (size_t)M_LAT * FF, (const bf16_t*)(ws + WS_W2A), M_CTX, D, FF, FF, FF / 128}; pg8::CtxSplitOrder S{G, bid};
            pg8::EpiResCtxSplit E{P.ctx, H1CTX, H1CTX2, mods + 2 * D, 0.5f}; pg8::gemm_phase<pg8::EpiResCtxSplit, true, pg8::CtxSplitOrder>(ldsl, g, S, E);
        } else convert_weights(P, lds, CV_EARLY, CV_ALL, (bid - 32) * 8 + wave, (G - 32) * 8, wave, lane, true);
    } SEAM(3);
    if (IN(4)) for (int rep_ = 0; rep_ < 1 + ((REP_MASK >> 4) & 1); ++rep_) { if (rep_) __syncthreads(); phase_norm_mod(P.out, H1CTX, H1CTX2, M_TOT, P.norm_g + D, mods, 3, 4, U, gw, NGW, lane); } SEAM(4);
    if (IN(5)) for (int rep_ = 0; rep_ < 1 + ((REP_MASK >> 5) & 1); ++rep_) { if (rep_) __syncthreads(); pg8::Gemm g{U, (const bf16_t*)(ws + WS_WIN), M_TOT, NIN, D, D, (D) / 64}; pg8::StaticOrder S; S.init(M_TOT, NIN, G, bid);
        pg8::EpiIn E{(bf16_t*)(ws + WS_PA), (bf16_t*)(ws + WS_PB), (float*)(ws + WS_BA)}; pg8::gemm_phase<pg8::EpiIn, true, pg8::StaticOrder>(ldsl, g, S, E); } SEAM(5);
    if (IN(6)) for (int rep_ = 0; rep_ < 1 + ((REP_MASK >> 6) & 1); ++rep_) { if (rep_) __syncthreads();
        gdn_prep_phase(P, lds, tid, lane, wave, bid, G);
    } SEAM(6);
    if (IN(7)) for (int rep_ = 0; rep_ < 1 + ((REP_MASK >> 7) & 1); ++rep_) { if (rep_) __syncthreads();
        if (bid < 128) { gdn_scan_item(P, lds, bid, tid, lane, wave); }
        else {
            unsigned* cnt = (unsigned*)ws + 8192;
            const int nb = bid & 7, slot = (bid - 128) >> 3;
            lru_phase<0>(P, lds, tid, lane, wave, nb, slot, 16);
            sub_barrier(cnt, 128u);
            if (slot == 0) lru_carry(P, nb * 512 + tid);
            sub_barrier(cnt + 64, 128u);
            lru_phase<1>(P, lds, tid, lane, wave, nb, slot, 16);
        }
    } SEAM(7);
    if (IN(8)) for (int rep_ = 0; rep_ < 1 + ((REP_MASK >> 8) & 1); ++rep_) { if (rep_) __syncthreads();
        gdn_combine(P, gw, NGW, lane);
    } SEAM(8);
    if (IN(9)) for (int rep_ = 0; rep_ < 1 + ((REP_MASK >> 9) & 1); ++rep_) { if (rep_) __syncthreads(); pg8::Gemm g{(const bf16_t*)(ws + WS_MIX), (const bf16_t*)(ws + WS_WOUT), M_LAT, D, D, D, (D) / 64}; pg8::StaticOrder S; S.init(M_LAT, D, G, bid);
        pg8::EpiRes E{P.out, P.out, P.out, P.out, mods + 5 * D, 1.0f}; pg8::gemm_phase<pg8::EpiRes, true, pg8::StaticOrder>(ldsl, g, S, E); } SEAM(9);
    if (IN(10)) for (int rep_ = 0; rep_ < 1 + ((REP_MASK >> 10) & 1); ++rep_) { if (rep_) __syncthreads(); phase_norm_mod(P.out, P.out, nullptr, M_LAT, P.norm_g + 2 * D, mods, 6, 7, U, gw, NGW, lane); } SEAM(10);
    if (IN(11)) for (int rep_ = 0; rep_ < 1 + ((REP_MASK >> 11) & 1); ++rep_) { if (rep_) __syncthreads(); pg8::Gemm g{U, (const bf16_t*)(ws + WS_W1B), M_LAT, 2 * FF, D, D, (D) / 64}; pg8::StaticOrder S; S.init(M_LAT, 2 * FF, G, bid); pg8::EpiSwiglu E{HID};
        pg8::gemm_phase<pg8::EpiSwiglu, true, pg8::StaticOrder>(ldsl, g, S, E); } SEAM(11);
    if (IN(12)) for (int rep_ = 0; rep_ < 1 + ((REP_MASK >> 12) & 1); ++rep_) { if (rep_) __syncthreads(); pg8::Gemm g{HID, (const bf16_t*)(ws + WS_W2B), M_LAT, D, FF, FF, (FF) / 64}; pg8::StaticOrder S; S.init(M_LAT, D, G, bid);
        pg8::EpiRes E{P.out, P.out, P.out, P.out, mods + 8 * D, 0.5f}; pg8::gemm_phase<pg8::EpiRes, true, pg8::StaticOrder>(ldsl, g, S, E); } SEAM(12);
    if (IN(13)) for (int rep_ = 0; rep_ < 1 + ((REP_MASK >> 13) & 1); ++rep_) { if (rep_) __syncthreads();
        for (int m = gw; m < M_LAT; m += NGW) { float* row = P.out + (size_t)m * D; f32x4 v[4]; float ss = 0.f;
#pragma unroll
            for (int j = 0; j < 4; ++j) { v[j] = *(const f32x4*)(row + 4 * lane + 256 * j); ss += (v[j][0] * v[j][0] + v[j][1] * v[j][1]) + (v[j][2] * v[j][2] + v[j][3] * v[j][3]); }
            const float rstd = rsqrtf(wave_sum(ss) * (1.f / D) + EPS);
#pragma unroll
            for (int j = 0; j < 4; ++j) { const f32x4 gv = *(const f32x4*)(P.fng + 4 * lane + 256 * j); *(f32x4*)(row + 4 * lane + 256 * j) = v[j] * rstd * gv; } }
    }
#undef IN
#undef SEAM
}

extern "C" void kernel_launch(void* const* d_in, const int* in_sizes, int n_in, void* d_out, int out_size, void* d_ws, size_t ws_size, hipStream_t stream) {
    static int grid = 0;
    if (grid == 0) {
        if (n_in != 22 || out_size != M_LAT * D || ws_size < WS_END) { fprintf(stderr, "kernel_launch: unexpected shapes (n_in %d, out %d, ws %zu)\n", n_in, out_size, ws_size); grid = -1; return; }
        int dev = 0, cus = 0, per_cu = 0;
        hipGetDevice(&dev); hipDeviceGetAttribute(&cus, hipDeviceAttributeMultiprocessorCount, dev);
        if (hipFuncSetAttribute((const void*)fwd_kernel, hipFuncAttributeMaxDynamicSharedMemorySize, LDS_BYTES) != hipSuccess) { fprintf(stderr, "kernel_launch: hipFuncSetAttribute failed\n"); grid = -1; return; }
        if (hipOccupancyMaxActiveBlocksPerMultiprocessor(&per_cu, (const void*)fwd_kernel, 512, LDS_BYTES) != hipSuccess || per_cu < 1) { fprintf(stderr, "kernel_launch: occupancy query gives %d\n", per_cu); per_cu = 1; }
        (void)hipGetLastError();
        grid = 256;
        if (cus * per_cu < 256) { fprintf(stderr, "kernel_launch: device too small (%d x %d)\n", cus, per_cu); grid = -1; return; }
        fprintf(stderr, "kernel_launch: grid %d (cus %d, per_cu %d)\n", grid, cus, per_cu);
    }
    if (grid < 0) return;
    Args a{};
    for (int i = 0; i < 22; ++i) a.in[i] = (const float*)d_in[i];
    a.out = (float*)d_out; a.ws = (unsigned char*)d_ws;
    if (hipMemsetAsync(d_ws, 0, 65536, stream) != hipSuccess) { fprintf(stderr, "kernel_launch: memset failed\n"); return; }
#if ONE_LAUNCH
    a.ph_lo = 0; a.ph_hi = N_PHASES;
    void* kargs[] = {&a};
    hipError_t e = hipLaunchCooperativeKernel((const void*)fwd_kernel, dim3(grid), dim3(512), kargs, LDS_BYTES, stream);
    if (e != hipSuccess) fprintf(stderr, "kernel_launch: cooperative launch failed: %s\n", hipGetErrorString(e));
#else
    for (int p = 0; p < N_PHASES; ++p) { a.ph_lo = p; a.ph_hi = p + 1; hipLaunchKernelGGL(fwd_kernel, dim3(grid), dim3(512), LDS_BYTES, stream, a); }
#endif
}
```
